# Optimizing an MI355X kernel written in HIP

```python
import math
import jax
import jax.numpy as jnp
from jax import lax
import numpy as np

D_MODEL = 2048
BATCH = 4
SEQ = 4096
DEPTH = 4

N_MIXERS = 2
N_HEADS = 16
HEAD_DIM = 128
Q_LORA = 512
KV_LORA = 256
IDX_HEADS = 16
IDX_DIM = 64
IDX_TOPK_MAX = 256
A_IN_COLS = Q_LORA + KV_LORA + IDX_DIM + IDX_HEADS
Q_BLOCK = 128
DILATED_PATTERNS = ((128, 1), (512, 4), (2048, 16))
BAND_BLOCK = 128
N_BUCKETS = 32
MAX_DISTANCE = 2048
N_EXPERTS = 16
N_GROUPS = 4
EXPERTS_PER_GROUP = N_EXPERTS // N_GROUPS
TOP_K = 2
D_EXPERT = 512
DEEPNORM_ALPHA = (2 * DEPTH) ** 0.25
DEEPNORM_BETA = (8 * DEPTH) ** -0.25
EPS = 1e-5

kernel_name = "hybrid_dsa_dilated_moe_deepnorm"


def t5_bucket(dist):
    n = jnp.maximum(dist, 0)
    max_exact = N_BUCKETS // 2
    nf = jnp.maximum(n, max_exact).astype(jnp.float32)
    large = max_exact + (jnp.log(nf / max_exact) / math.log(MAX_DISTANCE / max_exact)
                         * (N_BUCKETS - max_exact)).astype(jnp.int32)
    large = jnp.minimum(large, N_BUCKETS - 1)
    return jnp.where(n < max_exact, n, large)


def layer_norm(x, g, b):
    xf = x.astype(jnp.float32)
    mu = jnp.mean(xf, axis=-1, keepdims=True)
    var = jnp.mean(jnp.square(xf - mu), axis=-1, keepdims=True)
    y = (xf - mu) * lax.rsqrt(var + EPS) * g.astype(jnp.float32) + b.astype(jnp.float32)
    return y.astype(x.dtype)


def rms_norm(x, g):
    xf = x.astype(jnp.float32)
    y = xf * lax.rsqrt(jnp.mean(jnp.square(xf), axis=-1, keepdims=True) + EPS) * g.astype(jnp.float32)
    return y.astype(x.dtype)


def dsa_attention(x, w_in, q_norm, kv_norm, w_uq, w_uq_idx, w_uk, w_uv, w_o, rel_bias):
    bsz, seq, _ = x.shape
    proj = x @ w_in
    c_q, c_kv, k_idx, w_idx = jnp.split(
        proj, [Q_LORA, Q_LORA + KV_LORA, Q_LORA + KV_LORA + IDX_DIM], axis=-1)
    c_q = rms_norm(c_q, q_norm)
    c_kv = rms_norm(c_kv, kv_norm)
    q = (c_q @ w_uq).reshape(bsz, seq, N_HEADS, HEAD_DIM)
    q_lat = jnp.einsum('bthd,hdc->bthc', q, w_uk) * (HEAD_DIM ** -0.5)
    q_idx = (c_q @ w_uq_idx).reshape(bsz, seq, IDX_HEADS, IDX_DIM) * (IDX_DIM ** -0.5)
    w_idx = w_idx * (IDX_HEADS ** -0.5)
    top_k = min(IDX_TOPK_MAX, seq // 4)
    n_blk = seq // Q_BLOCK
    key_pos = jnp.arange(seq, dtype=jnp.int32)

    def blocks(a):
        return a.reshape((bsz, n_blk, Q_BLOCK) + a.shape[2:]).swapaxes(0, 1)

    def attend_block(args):
        ql, qi, wi, start = args
        t_pos = start + jnp.arange(Q_BLOCK, dtype=jnp.int32)
        rel = jax.nn.relu(jnp.einsum('bqhd,bsd->bqhs', qi, k_idx))
        score = jnp.einsum('bqh,bqhs->bqs', wi, rel).astype(jnp.float32)
        causal = key_pos[None, :] <= t_pos[:, None]
        score = jnp.where(causal[None], score, -jnp.inf)
        _, sel = lax.top_k(score, top_k)
        valid = sel <= t_pos[None, :, None]
        kv_sel = jax.vmap(lambda c, i: c[i])(c_kv, sel)
        logits = jnp.einsum('bqhc,bqkc->bqkh', ql, kv_sel).astype(jnp.float32)
        logits = logits + rel_bias[t5_bucket(t_pos[None, :, None] - sel)].astype(jnp.float32)
        logits = jnp.where(valid[..., None], logits, -jnp.inf)
        p = jax.nn.softmax(logits, axis=2).astype(kv_sel.dtype)
        return jnp.einsum('bqkh,bqkc->bqhc', p, kv_sel)

    starts = jnp.arange(n_blk, dtype=jnp.int32) * Q_BLOCK
    o_lat = lax.map(attend_block, (blocks(q_lat), blocks(q_idx), blocks(w_idx), starts))
    o_lat = o_lat.swapaxes(0, 1).reshape(bsz, seq, N_HEADS, KV_LORA)
    o = jnp.einsum('bthc,hcd->bthd', o_lat, w_uv).reshape(bsz, seq, N_HEADS * HEAD_DIM)
    return o @ w_o


def dilated_branch(q, k, v, window, dil, rel_bias):
    bsz, seq, heads, hd = q.shape
    ls = seq // dil
    look = window // dil
    nb = -(-ls // BAND_BLOCK)
    lp = nb * BAND_BLOCK

    def to_sub(a):
        return a.reshape(bsz, ls, dil, heads, hd).transpose(0, 2, 1, 3, 4)

    qs = jnp.pad(to_sub(q), ((0, 0), (0, 0), (0, lp - ls), (0, 0), (0, 0)))
    ks = jnp.pad(to_sub(k), ((0, 0), (0, 0), (look, lp - ls), (0, 0), (0, 0)))
    vs = jnp.pad(to_sub(v), ((0, 0), (0, 0), (look, lp - ls), (0, 0), (0, 0)))
    qb = qs.reshape(bsz, dil, nb, BAND_BLOCK, heads, hd)
    band = (jnp.arange(nb) * BAND_BLOCK)[:, None] + jnp.arange(BAND_BLOCK + look)[None, :]
    kb = ks[:, :, band]
    vb = vs[:, :, band]
    logits = jnp.einsum('bcnqhd,bcnkhd->bcnhqk', qb, kb).astype(jnp.float32)
    rel = jnp.arange(BAND_BLOCK)[:, None] + look - jnp.arange(BAND_BLOCK + look)[None, :]
    key_sub = band - look
    mask = ((rel >= 0) & (rel <= look))[None] & (key_sub >= 0)[:, None, :]
    bias = rel_bias[t5_bucket(dil * rel)].astype(jnp.float32).transpose(2, 0, 1)
    logits = jnp.where(mask[:, None], logits + bias, -jnp.inf)
    lse = jax.nn.logsumexp(logits, axis=-1)
    p = jnp.exp(logits - lse[..., None]).astype(v.dtype)
    o = jnp.einsum('bcnhqk,bcnkhd->bcnqhd', p, vb)
    o = o.reshape(bsz, dil, lp, heads, hd)[:, :, :ls].transpose(0, 2, 1, 3, 4).reshape(bsz, seq, heads, hd)
    lse = lse.transpose(0, 1, 2, 4, 3).reshape(bsz, dil, lp, heads)[:, :, :ls]
    lse = lse.transpose(0, 2, 1, 3).reshape(bsz, seq, heads)
    return o, lse


def dilated_attention(x, w_in, w_o, rel_bias):
    bsz, seq, _ = x.shape
    qkv = (x @ w_in).reshape(bsz, seq, 3, N_HEADS, HEAD_DIM)
    q = qkv[:, :, 0] * (HEAD_DIM ** -0.5)
    k = qkv[:, :, 1]
    v = qkv[:, :, 2]
    outs, lses = [], []
    for window, dil in DILATED_PATTERNS:
        o_i, lse_i = dilated_branch(q, k, v, window, dil, rel_bias)
        outs.append(o_i)
        lses.append(lse_i)
    wts = jax.nn.softmax(jnp.stack(lses, axis=0), axis=0)
    o = jnp.sum(wts[..., None].astype(v.dtype) * jnp.stack(outs, axis=0), axis=0)
    return o.reshape(bsz, seq, N_HEADS * HEAD_DIM) @ w_o


def grouped_moe(x, router_w, router_b, w_gate, w_up, w_down):
    bsz, seq, d = x.shape
    xt = x.reshape(-1, d)
    probs = jax.nn.softmax((xt @ router_w).astype(jnp.float32), axis=-1)
    sel = (probs + router_b.astype(jnp.float32)).reshape(-1, N_GROUPS, EXPERTS_PER_GROUP)
    top_in_group, _ = lax.top_k(sel, TOP_K)
    group = jnp.argmax(jnp.sum(top_in_group, axis=-1), axis=-1)
    in_group = jnp.take_along_axis(sel, group[:, None, None], axis=1)[:, 0]
    _, local = lax.top_k(in_group, TOP_K)
    expert = group[:, None] * EXPERTS_PER_GROUP + local
    gate = jnp.take_along_axis(probs, expert, axis=1)
    gate = gate / jnp.sum(gate, axis=-1, keepdims=True)
    combine = jnp.sum(jax.nn.one_hot(expert, N_EXPERTS, dtype=jnp.float32) * gate[..., None], axis=1)
    hidden = jax.nn.silu(jnp.einsum('nd,edf->nef', xt, w_gate)) * jnp.einsum('nd,edf->nef', xt, w_up)
    y = jnp.einsum('nef,efd->nd', hidden * combine[:, :, None].astype(xt.dtype), w_down)
    return y.reshape(bsz, seq, d)


def setup_inputs(seed: int = 0) -> dict:
    key = jax.random.key(seed)
    ks = jax.random.split(key, 24)
    n_a = (DEPTH + 1) // 2
    n_b = DEPTH // 2
    hw = N_HEADS * HEAD_DIM

    def nrm(k, shape, scale):
        return jax.random.normal(k, shape, jnp.float32) * scale

    return {
        "x": nrm(ks[0], (BATCH, SEQ, D_MODEL), 1.0),
        "rel_bias": nrm(ks[1], (N_BUCKETS, N_HEADS), 0.5),
        "router_w": nrm(ks[2], (D_MODEL, N_EXPERTS), D_MODEL ** -0.5),
        "router_b": nrm(ks[3], (N_EXPERTS,), 0.01),
        "a_w_in": nrm(ks[4], (n_a, D_MODEL, A_IN_COLS), D_MODEL ** -0.5),
        "a_q_norm": 1.0 + nrm(ks[5], (n_a, Q_LORA), 0.02),
        "a_kv_norm": 1.0 + nrm(ks[6], (n_a, KV_LORA), 0.02),
        "a_w_uq": nrm(ks[7], (n_a, Q_LORA, hw), Q_LORA ** -0.5),
        "a_w_uq_idx": nrm(ks[8], (n_a, Q_LORA, IDX_HEADS * IDX_DIM), Q_LORA ** -0.5),
        "a_w_uk": nrm(ks[9], (n_a, N_HEADS, HEAD_DIM, KV_LORA), HEAD_DIM ** -0.5),
        "a_w_uv": nrm(ks[10], (n_a, N_HEADS, KV_LORA, HEAD_DIM), KV_LORA ** -0.5),
        "a_w_o": nrm(ks[11], (n_a, hw, D_MODEL), hw ** -0.5 * DEEPNORM_BETA),
        "b_w_in": nrm(ks[12], (n_b, D_MODEL, 3 * hw), D_MODEL ** -0.5),
        "b_w_o": nrm(ks[13], (n_b, hw, D_MODEL), hw ** -0.5 * DEEPNORM_BETA),
        "ln1_g": 1.0 + nrm(ks[14], (DEPTH, D_MODEL), 0.02),
        "ln1_b": nrm(ks[15], (DEPTH, D_MODEL), 0.02),
        "ln2_g": 1.0 + nrm(ks[16], (DEPTH, D_MODEL), 0.02),
        "ln2_b": nrm(ks[17], (DEPTH, D_MODEL), 0.02),
        "moe_w_gate": nrm(ks[18], (DEPTH, N_EXPERTS, D_MODEL, D_EXPERT), D_MODEL ** -0.5),
        "moe_w_up": nrm(ks[19], (DEPTH, N_EXPERTS, D_MODEL, D_EXPERT), D_MODEL ** -0.5),
        "moe_w_down": nrm(ks[20], (DEPTH, N_EXPERTS, D_EXPERT, D_MODEL), D_EXPERT ** -0.5 * DEEPNORM_BETA),
    }


def reference(x, rel_bias, router_w, router_b, a_w_in, a_q_norm, a_kv_norm, a_w_uq, a_w_uq_idx,
              a_w_uk, a_w_uv, a_w_o, b_w_in, b_w_o, ln1_g, ln1_b, ln2_g, ln2_b,
              moe_w_gate, moe_w_up, moe_w_down):
    for i in range(DEPTH):
        j = i // N_MIXERS
        if i % N_MIXERS == 0:
            h = dsa_attention(x, a_w_in[j], a_q_norm[j], a_kv_norm[j], a_w_uq[j], a_w_uq_idx[j],
                              a_w_uk[j], a_w_uv[j], a_w_o[j], rel_bias)
        else:
            h = dilated_attention(x, b_w_in[j], b_w_o[j], rel_bias)
        x = layer_norm(DEEPNORM_ALPHA * x + h, ln1_g[i], ln1_b[i])
        y = grouped_moe(x, router_w, router_b, moe_w_gate[i], moe_w_up[i], moe_w_down[i])
        x = layer_norm(DEEPNORM_ALPHA * x + y, ln2_g[i], ln2_b[i])
    return x
```

```cpp
#include <hip/hip_runtime.h>
#include <cstdio>
#include <cstdint>

#ifndef MK_SINGLE
#define MK_SINGLE 1
#endif

namespace {
constexpr int D = 2048, NB_ = 4, T = 4096, DEPTH = 4, M = NB_ * T;
constexpr int H = 16, HD = 128, HW = H * HD, QL = 512, KVL = 256, IH = 16, IDM = 64, TOPK = 256;
constexpr int AIN = QL + KVL + IDM + IH;
constexpr int NBUCK = 32, NE = 16, NG = 4, EPG = 4, DE = 512;
constexpr float ALPHA = 1.6817928305074292f;
constexpr float EPS = 1e-5f;
constexpr int NTHR = 512, NWAVES = 8;
constexpr int RMAX = 36864;
constexpr int NCHUNK = 256, CHUNK = M / NCHUNK;

constexpr size_t MiB = 1u << 20;
constexpr size_t WS_CTL = 0, CTL_BYTES = 1 * MiB;
constexpr size_t WS_BIAS = 1 * MiB;
constexpr size_t WS_EXPID = 2 * MiB;
constexpr size_t WS_GATEW = WS_EXPID + (size_t)M * 2 * 4;
constexpr size_t WS_POS = WS_GATEW + (size_t)M * 2 * 4;
constexpr size_t WS_ROWTOK = WS_POS + (size_t)M * 2 * 4;
constexpr size_t WS_ROWGATE = WS_ROWTOK + (size_t)RMAX * 4;
constexpr size_t WS_HIST = WS_ROWGATE + (size_t)RMAX * 4;
constexpr size_t WS_TILEE = WS_HIST + (size_t)NCHUNK * 16 * 4;
constexpr size_t WS_NSEL = WS_TILEE + 1024;
constexpr size_t WS_XB = 8 * MiB;
constexpr size_t WS_XPRE = 72 * MiB;
constexpr size_t WS_WL = 200 * MiB;
constexpr size_t WL_STRIDE = 128 * MiB;
constexpr size_t WS_AR = 456 * MiB;
constexpr int QALD = 5120;
constexpr size_t WS_END = 906 * MiB;
constexpr size_t AR_PRAW = WS_AR;
constexpr size_t AR_CQ = WS_AR + 64 * MiB;
constexpr size_t AR_CKV = WS_AR + 80 * MiB;
constexpr size_t AR_KIDX = WS_AR + 88 * MiB;
constexpr size_t AR_WIDX = WS_AR + 90 * MiB;
constexpr size_t AR_SEL = WS_AR + 92 * MiB;
constexpr size_t AR_QALL = WS_AR + 108 * MiB;
constexpr size_t AR_SC = WS_AR + 268 * MiB;
constexpr size_t AR_OLAT = WS_AR + 268 * MiB;
constexpr size_t AR_OB = WS_AR + 0 * MiB;
constexpr size_t AR_QKV = WS_AR + 100 * MiB;
constexpr size_t AR_DST = WS_AR + 300 * MiB;
constexpr size_t AR_DML = WS_AR + 336 * MiB;
constexpr size_t AR_HID = WS_AR + 0 * MiB;
constexpr size_t AR_YS = WS_AR + 40 * MiB;
constexpr size_t SC_PER_B = (size_t)1024 * 128 * 129 / 2;
static_assert(AR_SC + 4 * SC_PER_B * 4 <= WS_END, "arena");
static_assert(AR_YS + (size_t)RMAX * D * 2 <= WS_END, "arena");
constexpr size_t WL_GU = WS_WL;
constexpr size_t WL_DN = WS_WL + 64 * MiB;
constexpr size_t WL_MIX = WS_WL + 96 * MiB;
constexpr size_t WL_WIN = WL_MIX;
constexpr size_t WL_WQ = WL_MIX + 4 * MiB;
constexpr size_t WL_WUV = WL_MIX + 10 * MiB;
constexpr size_t WL_WO = WL_MIX + 12 * MiB;
constexpr size_t WL_WQKV = WL_MIX + 0 * MiB;
constexpr size_t WL_WO_D = WL_MIX + 24 * MiB;
static_assert(WL_WO_D + 8 * MiB <= WS_WL + WL_STRIDE && WS_WL + 2 * WL_STRIDE <= WS_AR, "weight scratch");

constexpr int LDS_BYTES = 163840;
constexpr int LDS_MISC = 143360;

typedef unsigned short bf16_t;
#define LAS __attribute__((address_space(3)))

__device__ __forceinline__ float bf2f(bf16_t v) { return __uint_as_float(((unsigned)v) << 16); }
__device__ __forceinline__ bf16_t f2bf(float f) { unsigned u = __float_as_uint(f); u += 0x7fffu + ((u >> 16) & 1u); return (bf16_t)(u >> 16); }
__device__ __forceinline__ float wave_sum(float v) {
#pragma unroll
    for (int o = 1; o < 64; o <<= 1) v += __shfl_xor(v, o);
    return v;
}
__device__ __forceinline__ int wave_sum_i(int v) {
#pragma unroll
    for (int o = 1; o < 64; o <<= 1) v += __shfl_xor(v, o);
    return v;
}
__device__ __forceinline__ float wave_max(float v) {
#pragma unroll
    for (int o = 1; o < 64; o <<= 1) v = fmaxf(v, __shfl_xor(v, o));
    return v;
}
__device__ __forceinline__ float wave_min(float v) {
#pragma unroll
    for (int o = 1; o < 64; o <<= 1) v = fminf(v, __shfl_xor(v, o));
    return v;
}
__device__ __forceinline__ int wave_min_i(int v) {
#pragma unroll
    for (int o = 1; o < 64; o <<= 1) { int t = __shfl_xor(v, o); v = t < v ? t : v; }
    return v;
}

__device__ __forceinline__ int wave_scan_dpp(int x) {
    x += __builtin_amdgcn_update_dpp(0, x, 0x111, 0xf, 0xf, false);
    x += __builtin_amdgcn_update_dpp(0, x, 0x112, 0xf, 0xf, false);
    x += __builtin_amdgcn_update_dpp(0, x, 0x114, 0xf, 0xf, false);
    x += __builtin_amdgcn_update_dpp(0, x, 0x118, 0xf, 0xf, false);
    x += __builtin_amdgcn_update_dpp(0, x, 0x142, 0xa, 0xf, false);
    x += __builtin_amdgcn_update_dpp(0, x, 0x143, 0xc, 0xf, false);
    return x;
}
__device__ __forceinline__ float wave_max_dpp(float v) {
    const int ninf = __float_as_int(-__builtin_inff());
#define WMX(ctrl, rm) v = fmaxf(v, __int_as_float(__builtin_amdgcn_update_dpp(ninf, __float_as_int(v), ctrl, rm, 0xf, false)))
    WMX(0x111, 0xf); WMX(0x112, 0xf); WMX(0x114, 0xf); WMX(0x118, 0xf); WMX(0x142, 0xa); WMX(0x143, 0xc);
#undef WMX
    return __int_as_float(__builtin_amdgcn_readlane(__float_as_int(v), 63));
}
__device__ __forceinline__ float wave_min_dpp(float v) {
    const int pinf = __float_as_int(__builtin_inff());
#define WMN(ctrl, rm) v = fminf(v, __int_as_float(__builtin_amdgcn_update_dpp(pinf, __float_as_int(v), ctrl, rm, 0xf, false)))
    WMN(0x111, 0xf); WMN(0x112, 0xf); WMN(0x114, 0xf); WMN(0x118, 0xf); WMN(0x142, 0xa); WMN(0x143, 0xc);
#undef WMN
    return __int_as_float(__builtin_amdgcn_readlane(__float_as_int(v), 63));
}
__device__ __forceinline__ int wave_sum_dpp(int x) {
    x += __builtin_amdgcn_update_dpp(0, x, 0x111, 0xf, 0xf, false);
    x += __builtin_amdgcn_update_dpp(0, x, 0x112, 0xf, 0xf, false);
    x += __builtin_amdgcn_update_dpp(0, x, 0x114, 0xf, 0xf, false);
    x += __builtin_amdgcn_update_dpp(0, x, 0x118, 0xf, 0xf, false);
    x += __builtin_amdgcn_update_dpp(0, x, 0x142, 0xa, 0xf, false);
    x += __builtin_amdgcn_update_dpp(0, x, 0x143, 0xc, 0xf, false);
    return __builtin_amdgcn_readlane(x, 63);
}
__device__ __forceinline__ int ld_mut(const int* p) { return __hip_atomic_load(p, __ATOMIC_RELAXED, __HIP_MEMORY_SCOPE_AGENT); }

#define XB_TMO      128
#define XB_XCNT(j)  (256  + 64 * (j))
#define XB_XSUB(j)  (1280 + 64 * (j))
#define XB_XGEN(j)  (2304 + 64 * (j))
#define XB_TOP      3328
#define XB_TOPGEN   3392
#define XCD_BAR_WORDS 3456
#define XB_SPIN_CAP (1u << 18)

__device__ __forceinline__ unsigned xb_ld(unsigned* p)              { return __hip_atomic_load(p, __ATOMIC_RELAXED, __HIP_MEMORY_SCOPE_AGENT); }
__device__ __forceinline__ unsigned xb_add(unsigned* p, unsigned v) { return __hip_atomic_fetch_add(p, v, __ATOMIC_RELAXED, __HIP_MEMORY_SCOPE_AGENT); }
__device__ __forceinline__ unsigned xb_xcc_id() { return (unsigned)__builtin_amdgcn_s_getreg((3 << 11) | 20) & 0xFu; }
#define XB_SPIN(cond, bar) do { unsigned _sp = 0; while (cond) { __builtin_amdgcn_s_sleep(1); \
    if ((++_sp & 255u) == 0u) { if (xb_ld(&(bar)[XB_TMO])) break; if (_sp > XB_SPIN_CAP) { atomicAdd(&(bar)[XB_TMO], 1u); break; } } } } while (0)

struct XcdBarrier {
    unsigned* bar; unsigned x;
    volatile LAS unsigned* st;
};
__device__ __forceinline__ XcdBarrier xcd_barrier_post(unsigned* bar, volatile LAS unsigned* st) {
    XcdBarrier b; b.bar = bar; b.x = xb_xcc_id(); b.st = st;
    if (threadIdx.x == 0) (void)xb_add(&bar[XB_XCNT(b.x)], 1u);
    return b;
}
__device__ __forceinline__ void xcd_barrier_complete(unsigned* bar, unsigned x, unsigned& nloc, unsigned& nx) {
    const unsigned G = gridDim.x * gridDim.y * gridDim.z;
    unsigned sum, cnt, mine, sp = 0u;
    for (;;) {
        sum = 0u; cnt = 0u; mine = 0u;
#pragma unroll
        for (unsigned j = 0; j < 16; ++j) { const unsigned c = xb_ld(&bar[XB_XCNT(j)]); sum += c; cnt += (c > 0u) ? 1u : 0u; mine = (j == x) ? c : mine; }
        if (sum == G) break;
        __builtin_amdgcn_s_sleep(1);
        if ((++sp & 255u) == 0u) { if (xb_ld(&bar[XB_TMO])) break; if (sp > XB_SPIN_CAP) { atomicAdd(&bar[XB_TMO], 1u); break; } }
    }
    nloc = mine > 0u ? mine : 1u; nx = cnt > 0u ? cnt : 1u;
}
__device__ __forceinline__ void xcd_barrier(const XcdBarrier& b) {
    asm volatile("s_waitcnt vmcnt(0)" ::: "memory");
    __syncthreads();
    if (threadIdx.x == 0) {
        unsigned* bar = b.bar;
        __builtin_amdgcn_s_waitcnt(0);
        unsigned nloc = b.st[0], nx = b.st[1];
        if (nloc == 0u) { xcd_barrier_complete(bar, b.x, nloc, nx); b.st[0] = nloc; b.st[1] = nx; }
        const unsigned old = xb_add(&bar[XB_XSUB(b.x)], 1u);
        const unsigned gen = old / nloc;
        if (old + 1u == (gen + 1u) * nloc) {
            __builtin_amdgcn_fence(__ATOMIC_RELEASE, "agent");
            asm volatile("s_waitcnt vmcnt(0)" ::: "memory");
            const unsigned og = xb_add(&bar[XB_TOP], 1u);
            const unsigned tg = og / nx;
            if (og + 1u == (tg + 1u) * nx) xb_add(&bar[XB_TOPGEN], 1u);
            else XB_SPIN(xb_ld(&bar[XB_TOPGEN]) == tg, bar);
            __builtin_amdgcn_fence(__ATOMIC_ACQUIRE, "agent");
            xb_add(&bar[XB_XGEN(b.x)], 1u);
            asm volatile("s_waitcnt vmcnt(0)" ::: "memory");
        } else {
            XB_SPIN(xb_ld(&bar[XB_XGEN(b.x)]) == gen, bar);
            __builtin_amdgcn_fence(__ATOMIC_ACQUIRE, "agent");
            asm volatile("s_waitcnt vmcnt(0)" ::: "memory");
        }
    }
    __syncthreads();
}

template <class AF, class BF, class EF>
__device__ __forceinline__ void gemm_naive(float* lds, int nbatch, int Mr, int N, int K, AF af, BF bf, EF ef) {
    float* As = lds; float* Bs = lds + 16 * 132;
    const int tid = threadIdx.x, ty = tid >> 4, tx = tid & 15;
    const int tm = Mr / 128, tn = (N + 63) / 64, per = tm * tn, total = per * nbatch;
    for (int u = blockIdx.x; u < total; u += gridDim.x) {
        const int bi = u / per, rr = u % per, m0 = (rr / tn) * 128, n0 = (rr % tn) * 64;
        float acc[4][4];
#pragma unroll
        for (int i = 0; i < 4; ++i)
#pragma unroll
            for (int j = 0; j < 4; ++j) acc[i][j] = 0.f;
        for (int k0 = 0; k0 < K; k0 += 16) {
            __syncthreads();
#pragma unroll
            for (int i = 0; i < 4; ++i) { const int e = tid + 512 * i, row = e >> 4, kk = e & 15; As[kk * 132 + row] = af(bi, m0 + row, k0 + kk); }
#pragma unroll
            for (int i = 0; i < 2; ++i) { const int e = tid + 512 * i, kk = e >> 6, n = e & 63; Bs[kk * 68 + n] = (n0 + n < N) ? bf(bi, k0 + kk, n0 + n) : 0.f; }
            __syncthreads();
#pragma unroll
            for (int kk = 0; kk < 16; ++kk) {
                const float4 a = *(const float4*)(As + kk * 132 + ty * 4);
                const float4 b = *(const float4*)(Bs + kk * 68 + tx * 4);
                const float av[4] = {a.x, a.y, a.z, a.w}, bv[4] = {b.x, b.y, b.z, b.w};
#pragma unroll
                for (int i = 0; i < 4; ++i)
#pragma unroll
                    for (int j = 0; j < 4; ++j) acc[i][j] = fmaf(av[i], bv[j], acc[i][j]);
            }
        }
#pragma unroll
        for (int i = 0; i < 4; ++i)
#pragma unroll
            for (int j = 0; j < 4; ++j) { const int n = n0 + tx * 4 + j; if (n < N) ef(bi, m0 + ty * 4 + i, n, acc[i][j]); }
    }
    __syncthreads();
}

__device__ __forceinline__ int t5_bucket(int n) {
    if (n < 16) return n;
    const float nf = (float)n;
    int large = 16 + (int)(logf(nf / 16.0f) / 4.852030263919617f * 16.0f);
    return large < 31 ? large : 31;
}
__device__ __forceinline__ size_t sc_off(int b, int t) { const int qb = t >> 5; return (size_t)b * SC_PER_B + (size_t)512 * qb * (qb + 1) + (size_t)(t & 31) * (32 * (qb + 1)); }

struct Args {
    const float* x; const float* rel_bias; const float* router_w; const float* router_b;
    const float* a_w_in; const float* a_q_norm; const float* a_kv_norm; const float* a_w_uq; const float* a_w_uq_idx;
    const float* a_w_uk; const float* a_w_uv; const float* a_w_o; const float* b_w_in; const float* b_w_o;
    const float* ln1_g; const float* ln1_b; const float* ln2_g; const float* ln2_b;
    const float* moe_w_gate; const float* moe_w_up; const float* moe_w_down;
    float* out; unsigned char* ws; int ph_lo, ph_hi;
};

template <class V4>
__device__ __forceinline__ void ln_row(V4 (&v)[8], const float* g, const float* bta, int lane) {
    float s = 0.f;
#pragma unroll
    for (int j = 0; j < 8; ++j) s += (v[j].x + v[j].y) + (v[j].z + v[j].w);
    const float mu = wave_sum(s) * (1.f / D);
    float q = 0.f;
#pragma unroll
    for (int j = 0; j < 8; ++j) { v[j].x -= mu; v[j].y -= mu; v[j].z -= mu; v[j].w -= mu; q += (v[j].x * v[j].x + v[j].y * v[j].y) + (v[j].z * v[j].z + v[j].w * v[j].w); }
    const float rstd = rsqrtf(wave_sum(q) * (1.f / D) + EPS);
#pragma unroll
    for (int j = 0; j < 8; ++j) {
        const float4 gg = *(const float4*)(g + 4 * lane + 256 * j), bb = *(const float4*)(bta + 4 * lane + 256 * j);
        v[j].x = v[j].x * rstd * gg.x + bb.x; v[j].y = v[j].y * rstd * gg.y + bb.y; v[j].z = v[j].z * rstd * gg.z + bb.z; v[j].w = v[j].w * rstd * gg.w + bb.w;
        if (j == 3) asm volatile("" ::: "memory");
    }
}
template <class V4>
__device__ __forceinline__ void store_row_bf16(bf16_t* dst, const V4 (&v)[8], int lane) {
#pragma unroll
    for (int j = 0; j < 8; ++j) {
        uint2 o; o.x = (unsigned)f2bf(v[j].x) | ((unsigned)f2bf(v[j].y) << 16); o.y = (unsigned)f2bf(v[j].z) | ((unsigned)f2bf(v[j].w) << 16);
        *(uint2*)(dst + 4 * lane + 256 * j) = o;
    }
}

extern __shared__ __attribute__((aligned(16))) unsigned char lds_raw[];
#define BIAS_T ((float*)(ws + WS_BIAS))
#define EXPID ((int*)(ws + WS_EXPID))
#define GATEW ((float*)(ws + WS_GATEW))
#define POS ((int*)(ws + WS_POS))
#define ROWTOK ((int*)(ws + WS_ROWTOK))
#define ROWGATE ((float*)(ws + WS_ROWGATE))
#define HIST ((int*)(ws + WS_HIST))
#define TILEE ((int*)(ws + WS_TILEE))
#define NSEL ((int*)(ws + WS_NSEL))
#define XB ((bf16_t*)(ws + WS_XB))
#define XPRE ((bf16_t*)(ws + WS_XPRE))
#define PRAW ((float*)(ws + AR_PRAW))
#define CQ ((bf16_t*)(ws + AR_CQ))
#define CKV ((bf16_t*)(ws + AR_CKV))
#define KIDX ((bf16_t*)(ws + AR_KIDX))
#define WIDX ((float*)(ws + AR_WIDX))
#define SEL ((int*)(ws + AR_SEL))
#define QALL ((bf16_t*)(ws + AR_QALL))
#define SC ((float*)(ws + AR_SC))
#define OLAT ((bf16_t*)(ws + AR_OLAT))
#define OB ((bf16_t*)(ws + AR_OB))
#define QKV ((bf16_t*)(ws + AR_QKV))
#define HID ((bf16_t*)(ws + AR_HID))
#define YS ((bf16_t*)(ws + AR_YS))
#define W_GU(L) ((bf16_t*)(ws + WL_GU + (size_t)((L) & 1) * WL_STRIDE))
#define W_DN(L) ((bf16_t*)(ws + WL_DN + (size_t)((L) & 1) * WL_STRIDE))
#define W_IN(L) ((bf16_t*)(ws + WL_WIN + (size_t)((L) & 1) * WL_STRIDE))
#define W_Q(L) ((bf16_t*)(ws + WL_WQ + (size_t)((L) & 1) * WL_STRIDE))
#define W_UV(L) ((bf16_t*)(ws + WL_WUV + (size_t)((L) & 1) * WL_STRIDE))
#define W_O(L) ((bf16_t*)(ws + WL_WO + (size_t)((L) & 1) * WL_STRIDE))
#define W_QKV(L) ((bf16_t*)(ws + WL_WQKV + (size_t)((L) & 1) * WL_STRIDE))
#define W_O_D(L) ((bf16_t*)(ws + WL_WO_D + (size_t)((L) & 1) * WL_STRIDE))

namespace pg8 {
#define PG8_LAS __attribute__((address_space(3)))
typedef short bf16x8 __attribute__((ext_vector_type(8)));
typedef float f32x4 __attribute__((ext_vector_type(4)));
typedef unsigned u32x4 __attribute__((ext_vector_type(4)));
typedef unsigned u32x2 __attribute__((ext_vector_type(2)));
constexpr int BM = 256, BK = 64, HALF = 128, HTB = HALF * BK * 2  , STAGE_BYTES = 8 * HTB, NXCD = 8, WGM = 8;

__device__ __forceinline__ int lds_byte(int r, int c) { const int st = (r >> 4) * 2 + (c >> 5), rr = r & 15, cc = c & 31, ob = rr * 64 + cc * 2; return st * 1024 + (ob ^ (((ob >> 9) & 1) << 5)); }
__device__ __forceinline__ void stage_rc(int b, int& R, int& C) { const int st = b / 1024, sb = b % 1024, swz = sb ^ (((sb >> 9) & 1) << 5); R = (st >> 1) * 16 + swz / 64; C = (st & 1) * 32 + (swz % 64) / 2; }
__device__ __forceinline__ int perm32(int rho) { const int n = rho >> 4, i = rho & 15; return 8 * (i >> 2) + 4 * n + (i & 3); }

struct Unit { int pm, pn; };
enum { EPI_F32 = 0, EPI_RESID = 1, EPI_BF16 = 2, EPI_SWIGLU = 3, EPI_QKVH = 4 };
struct GemmDesc {
    const bf16_t* A; const bf16_t* Bt; const int* rowtok; const int* tilee; void* out; const void* aux;
    size_t btile, bexp; unsigned lda2, acol2, ldb2; int K, nM, nN, epi, ldc; float alpha; int pad;
};
struct Order {
    int nM, nN, nwg, G, c;
    __device__ __forceinline__ bool next(int i, Unit& u) const {
        const long L = (long)i * G + c; if (L >= nwg) return false;
        int wgid = (int)L; { const int q = nwg / NXCD, r = nwg % NXCD, xcd = wgid % NXCD, off = wgid / NXCD; wgid = (xcd < r ? xcd * (q + 1) : r * (q + 1) + (xcd - r) * q) + off; }
        const int nig = WGM * nN, gid = wgid / nig, fm = gid * WGM, gsz = (nM - fm) < WGM ? (nM - fm) : WGM;
        u.pm = fm + ((wgid % nig) % gsz); u.pn = (wgid % nig) / gsz; return true;
    }
};
__device__ __forceinline__ unsigned arow_off(const GemmDesc& d, const Unit& u, int r) { const int row = u.pm * BM + r; return (unsigned)(d.rowtok ? d.rowtok[row] : row) * d.lda2 + (unsigned)u.pn * d.acol2; }
__device__ __forceinline__ const char* bptr(const GemmDesc& d, const Unit& u) { return (const char*)d.Bt + (d.tilee ? (size_t)__builtin_amdgcn_readfirstlane(ld_mut(d.tilee + u.pm)) * d.bexp : (size_t)0) + (size_t)u.pn * d.btile; }

__device__ __forceinline__ unsigned cvt_pk_bf16(float lo, float hi) { unsigned r; asm volatile("v_cvt_pk_bf16_f32 %0, %1, %2" : "=v"(r) : "v"(lo), "v"(hi)); return r; }

__device__ __forceinline__ void st16_wt(void* p, u32x4 v) { asm volatile("global_store_dwordx4 %0, %1, off sc1\n\ts_nop 1" :: "v"(p), "v"(v) : "memory"); }
template <bool WT> __device__ __forceinline__ void st16(void* p, u32x4 v) { if constexpr (WT) st16_wt(p, v); else *(u32x4*)p = v; }
template <bool WT>
__device__ __forceinline__ void epi_f32(const f32x4 (&acc)[2][2][4][2], const Unit& u, int wr, int wc, int fr, int fq, float* C, int ldc) {
    const int row0 = u.pm * BM + wr * 64 + fr, col0 = u.pn * BM + wc * 32 + 4 * fq;
#pragma unroll
    for (int ai = 0; ai < 2; ++ai)
#pragma unroll
        for (int m = 0; m < 4; ++m) { float* rowp = C + (size_t)(row0 + ai * HALF + m * 16) * ldc + col0;
#pragma unroll
            for (int bj = 0; bj < 2; ++bj)
#pragma unroll
                for (int n = 0; n < 2; ++n) st16<WT>(rowp + bj * HALF + n * 16, __builtin_bit_cast(u32x4, acc[ai][bj][m][n])); }
}
__device__ __forceinline__ void epi_resid(const f32x4 (&acc)[2][2][4][2], const Unit& u, int wr, int wc, int fr, int fq, bf16_t* C, const bf16_t* X, int ldc, float alpha) {
    const int row0 = u.pm * BM + wr * 64 + fr, col0 = u.pn * BM + wc * 32 + 8 * fq;
#pragma unroll
    for (int ai = 0; ai < 2; ++ai)
#pragma unroll
        for (int m = 0; m < 4; ++m) { const size_t ro = (size_t)(row0 + ai * HALF + m * 16) * ldc + col0;
#pragma unroll
            for (int bj = 0; bj < 2; ++bj) { const u32x4 xr = *(const u32x4*)(X + ro + bj * HALF); const f32x4 a0 = acc[ai][bj][m][0], a1 = acc[ai][bj][m][1];
                u32x4 w;
                w.x = cvt_pk_bf16(alpha * __uint_as_float(xr.x << 16) + a0[0], alpha * __uint_as_float(xr.x & 0xffff0000u) + a0[1]);
                w.y = cvt_pk_bf16(alpha * __uint_as_float(xr.y << 16) + a0[2], alpha * __uint_as_float(xr.y & 0xffff0000u) + a0[3]);
                w.z = cvt_pk_bf16(alpha * __uint_as_float(xr.z << 16) + a1[0], alpha * __uint_as_float(xr.z & 0xffff0000u) + a1[1]);
                w.w = cvt_pk_bf16(alpha * __uint_as_float(xr.w << 16) + a1[2], alpha * __uint_as_float(xr.w & 0xffff0000u) + a1[3]);
                *(u32x4*)(C + ro + bj * HALF) = w; } }
}
template <bool WT>
__device__ __forceinline__ void epi_bf16(const f32x4 (&acc)[2][2][4][2], const Unit& u, int wr, int wc, int fr, int fq, bf16_t* O, int ldc) {
    const int row0 = u.pm * BM + wr * 64 + fr, col0 = u.pn * BM + wc * 32 + 8 * fq;
#pragma unroll
    for (int ai = 0; ai < 2; ++ai)
#pragma unroll
        for (int m = 0; m < 4; ++m) { bf16_t* rowp = O + (size_t)(row0 + ai * HALF + m * 16) * ldc + col0;
#pragma unroll
            for (int bj = 0; bj < 2; ++bj) { const f32x4 v0 = acc[ai][bj][m][0], v1 = acc[ai][bj][m][1];
                u32x4 w; w.x = cvt_pk_bf16(v0[0], v0[1]); w.y = cvt_pk_bf16(v0[2], v0[3]); w.z = cvt_pk_bf16(v1[0], v1[1]); w.w = cvt_pk_bf16(v1[2], v1[3]);
                st16<WT>(rowp + bj * HALF, w); } }
}
__device__ __forceinline__ void epi_swiglu(const f32x4 (&acc)[2][2][4][2], const Unit& u, int wr, int wc, int fr, int fq, bf16_t* Hd, const float* rowgate) {
    const int row0 = u.pm * BM + wr * 64 + fr, col0 = u.pn * HALF + wc * 32 + 8 * fq;
#pragma unroll
    for (int ai = 0; ai < 2; ++ai)
#pragma unroll
        for (int m = 0; m < 4; ++m) { const int row = row0 + ai * HALF + m * 16; const float gw = rowgate[row];
            float h[8];
#pragma unroll
            for (int n = 0; n < 2; ++n)
#pragma unroll
                for (int e = 0; e < 4; ++e) { const float g = acc[ai][0][m][n][e], uu = acc[ai][1][m][n][e]; h[n * 4 + e] = g / (1.f + __expf(-g)) * uu * gw; }
            u32x4 w; w.x = cvt_pk_bf16(h[0], h[1]); w.y = cvt_pk_bf16(h[2], h[3]); w.z = cvt_pk_bf16(h[4], h[5]); w.w = cvt_pk_bf16(h[6], h[7]);
            *(u32x4*)(Hd + (size_t)row * 512 + col0) = w; }
}
__device__ __forceinline__ void epi_qkvh(const f32x4 (&acc)[2][2][4][2], const Unit& u, int wr, int wc, int fr, int fq, bf16_t* O) {
    const int row0 = u.pm * BM + wr * 64 + fr;
#pragma unroll
    for (int ai = 0; ai < 2; ++ai)
#pragma unroll
        for (int m = 0; m < 4; ++m) { const int row = row0 + ai * HALF + m * 16, b = row >> 12, t = row & 4095;
#pragma unroll
            for (int bj = 0; bj < 2; ++bj) { const int col = u.pn * BM + bj * HALF + wc * 32 + 8 * fq, which = col >> 11, head = (col >> 7) & 15, dim = col & 127;
                const f32x4 v0 = acc[ai][bj][m][0], v1 = acc[ai][bj][m][1];
                u32x4 w; w.x = cvt_pk_bf16(v0[0], v0[1]); w.y = cvt_pk_bf16(v0[2], v0[3]); w.z = cvt_pk_bf16(v1[0], v1[1]); w.w = cvt_pk_bf16(v1[2], v1[3]);
                st16_wt(O + ((size_t)((which * 64 + b * 16 + head) * 4096 + t)) * 128 + dim, w); } }
}
__device__ __forceinline__ void epi_any(const f32x4 (&acc)[2][2][4][2], const Unit& u, int wr, int wc, int fr, int fq, const GemmDesc& d) {
    if (d.epi == EPI_F32) epi_f32<true>(acc, u, wr, wc, fr, fq, (float*)d.out, d.ldc);
    else if (d.epi == EPI_RESID) epi_resid(acc, u, wr, wc, fr, fq, (bf16_t*)d.out, (const bf16_t*)d.aux, d.ldc, d.alpha);
    else if (d.epi == EPI_BF16) { if (d.pad) epi_bf16<true>(acc, u, wr, wc, fr, fq, (bf16_t*)d.out, d.ldc); else epi_bf16<false>(acc, u, wr, wc, fr, fq, (bf16_t*)d.out, d.ldc); }
    else if (d.epi == EPI_QKVH) epi_qkvh(acc, u, wr, wc, fr, fq, (bf16_t*)d.out);
    else epi_swiglu(acc, u, wr, wc, fr, fq, (bf16_t*)d.out, (const float*)d.aux);
}

template <bool ALIGN_EPI = true, bool SP2 = true>
__device__ __forceinline__ void gemm_run(PG8_LAS unsigned char* lds, const GemmDesc& d) {
    Order S; S.nM = d.nM; S.nN = d.nN; S.nwg = d.nM * d.nN; S.G = (int)gridDim.x; S.c = (int)blockIdx.x;
    const unsigned ldb2 = d.ldb2; const bool perm = d.epi != EPI_F32;
    int tid_l = threadIdx.x; asm volatile("" : "+v"(tid_l));
    const int tid = tid_l, wid = __builtin_amdgcn_readfirstlane(tid >> 6), lane = tid & 63, wr = wid >> 2, wc = wid & 3, fr = lane & 15, fq = lane >> 4;
    const int K = d.K, nt = K / BK;
    int RA[2]; unsigned CA2[2], voffB[2];
#pragma unroll
    for (int i = 0; i < 2; ++i) { int R, C; stage_rc(tid * 16 + i * 8192, R, C); const int Rb = perm ? ((R & ~31) + perm32(R & 31)) : R;
        RA[i] = R; CA2[i] = (unsigned)C * 2u; voffB[i] = (unsigned)Rb * ldb2 + (unsigned)C * 2u; }
    const size_t kstep = (size_t)(BK * 2);
    const size_t hstepB = (size_t)HALF * ldb2;
    const unsigned ldsw = (unsigned)wid * 1024u;
    const int aoff = lds_byte(wr * 64 + fr, fq * 8), boff = lds_byte(wc * 32 + fr, fq * 8);
#define PG8_SA(b, h) (((b) * 2 + (h)) * HTB)
#define PG8_SB(b, h) ((4 + (b) * 2 + (h)) * HTB)
#define PG8_STAGE(bufoff, gbase, voff) do { _Pragma("unroll") for (int _i = 0; _i < 2; ++_i) \
        __builtin_amdgcn_global_load_lds((const unsigned*)((const char*)(gbase) + (voff)[_i]), (PG8_LAS unsigned*)(lds + (bufoff) + ldsw + _i * 8192), 16, 0, 0); } while (0)
#define PG8_STAGEA(bufoff, gbase, v0, v1) do { \
        __builtin_amdgcn_global_load_lds((const unsigned*)((const char*)(gbase) + (v0)), (PG8_LAS unsigned*)(lds + (bufoff) + ldsw), 16, 0, 0); \
        __builtin_amdgcn_global_load_lds((const unsigned*)((const char*)(gbase) + (v1)), (PG8_LAS unsigned*)(lds + (bufoff) + ldsw + 8192), 16, 0, 0); } while (0)
#define PG8_LDA(dst, b, h) do { _Pragma("unroll") for (int m = 0; m < 4; ++m) _Pragma("unroll") for (int k = 0; k < 2; ++k) dst[m][k] = *(const PG8_LAS bf16x8*)(lds + PG8_SA(b, h) + aoff + m * 2048 + k * 1024); } while (0)
#define PG8_LDB(dst, b, h) do { _Pragma("unroll") for (int n = 0; n < 2; ++n) _Pragma("unroll") for (int k = 0; k < 2; ++k) dst[n][k] = *(const PG8_LAS bf16x8*)(lds + PG8_SB(b, h) + boff + n * 2048 + k * 1024); } while (0)
#define PG8_MMA(ai, bj, At, Bt) do { __builtin_amdgcn_s_setprio(1); _Pragma("unroll") for (int m = 0; m < 4; ++m) _Pragma("unroll") for (int n = 0; n < 2; ++n) _Pragma("unroll") for (int k = 0; k < 2; ++k) \
        acc[ai][bj][m][n] = __builtin_amdgcn_mfma_f32_16x16x32_bf16(Bt[n][k], At[m][k], acc[ai][bj][m][n], 0, 0, 0); __builtin_amdgcn_s_setprio(0); } while (0)
#define PG8_WAIT_V(n) asm volatile("s_waitcnt vmcnt(" #n ")" ::: "memory")
#define PG8_WAIT_L(n) asm volatile("s_waitcnt lgkmcnt(" #n ")" ::: "memory")
#define PG8_BAR __builtin_amdgcn_s_barrier()
#define PG8_SCHED __builtin_amdgcn_sched_barrier(0)
    Unit cur, nxt; int ui = 0;
    if (!S.next(0, cur)) return;
    f32x4 acc[2][2][4][2];
#pragma unroll
    for (int a = 0; a < 2; ++a)
#pragma unroll
        for (int b = 0; b < 2; ++b)
#pragma unroll
            for (int m = 0; m < 4; ++m)
#pragma unroll
                for (int n = 0; n < 2; ++n) acc[a][b][m][n] = (f32x4){0.f, 0.f, 0.f, 0.f};
    bf16x8 At[4][2], B0[2][2], B1[2][2];
    unsigned c00 = arow_off(d, cur, RA[0]) + CA2[0], c01 = arow_off(d, cur, RA[1]) + CA2[1], c10 = arow_off(d, cur, HALF + RA[0]) + CA2[0], c11 = arow_off(d, cur, HALF + RA[1]) + CA2[1];
    unsigned n00 = c00, n01 = c01, n10 = c10, n11 = c11;
    const char* const gA = (const char*)d.A;
    const char* cB = bptr(d, cur);
    if constexpr (SP2) {
        PG8_STAGE(PG8_SB(0, 0), cB, voffB); PG8_STAGE(PG8_SB(0, 1), cB + hstepB, voffB); PG8_STAGEA(PG8_SA(0, 0), gA, c00, c01); PG8_STAGEA(PG8_SA(0, 1), gA, c10, c11);
        if (wr == 1) PG8_BAR;
        PG8_WAIT_V(2); PG8_BAR;
        PG8_STAGE(PG8_SB(1, 0), cB + kstep, voffB); PG8_STAGEA(PG8_SA(1, 0), gA + kstep, c00, c01); PG8_STAGE(PG8_SB(1, 1), cB + hstepB + kstep, voffB);
        PG8_WAIT_V(6); PG8_BAR;
    } else {
        PG8_STAGE(PG8_SB(0, 0), cB, voffB); PG8_STAGEA(PG8_SA(0, 0), gA, c00, c01); PG8_STAGE(PG8_SB(0, 1), cB + hstepB, voffB); PG8_STAGEA(PG8_SA(0, 1), gA, c10, c11);
        if (wr == 1) PG8_BAR;
        PG8_WAIT_V(4); PG8_BAR;
        PG8_STAGE(PG8_SB(1, 0), cB + kstep, voffB); PG8_STAGEA(PG8_SA(1, 0), gA + kstep, c00, c01); PG8_STAGE(PG8_SB(1, 1), cB + hstepB + kstep, voffB);
        PG8_WAIT_V(6); PG8_BAR;
    }
    for (;;) {
        const bool has_next = S.next(ui + 1, nxt);
        const char* nB = cB;
        if (has_next) {
            int tl = tid; asm volatile("" : "+v"(tl)); int R0, C0, R1, C1; stage_rc(tl * 16, R0, C0); stage_rc(tl * 16 + 8192, R1, C1);
            n00 = arow_off(d, nxt, R0) + (unsigned)C0 * 2u; n01 = arow_off(d, nxt, R1) + (unsigned)C1 * 2u; n10 = arow_off(d, nxt, HALF + R0) + (unsigned)C0 * 2u; n11 = arow_off(d, nxt, HALF + R1) + (unsigned)C1 * 2u; nB = bptr(d, nxt); }
        else { n00 = c00; n01 = c01; n10 = c10; n11 = c11; }
        for (int t = 0; t < nt; t += 2) {
            const bool last = (t == nt - 2);
            const char* a1 = gA + (size_t)(t + 1) * kstep;
            const char* a2 = last ? gA : gA + (size_t)(t + 2) * kstep; const char* b2 = last ? nB : cB + (size_t)(t + 2) * kstep;
            const char* a3 = a2 + kstep; const char* b3 = b2 + kstep;
            const unsigned s00 = last ? n00 : c00, s01 = last ? n01 : c01, s10 = last ? n10 : c10, s11 = last ? n11 : c11;
            if constexpr (SP2) {
            PG8_LDB(B0, 0, 0); PG8_LDB(B1, 0, 1); PG8_SCHED; PG8_LDA(At, 0, 0); PG8_STAGEA(PG8_SA(1, 1), a1, c10, c11);
            PG8_WAIT_V(8); PG8_WAIT_L(0); PG8_BAR; PG8_MMA(0, 0, At, B0); PG8_MMA(0, 1, At, B1); PG8_BAR; PG8_SCHED;
            PG8_LDA(At, 0, 1); PG8_STAGE(PG8_SB(0, 0), b2, voffB); PG8_STAGE(PG8_SB(0, 1), b2 + hstepB, voffB); PG8_STAGEA(PG8_SA(0, 0), a2, s00, s01);
            PG8_WAIT_V(8); PG8_WAIT_L(0); PG8_BAR; PG8_MMA(1, 0, At, B0); PG8_MMA(1, 1, At, B1); PG8_BAR; PG8_SCHED;
            PG8_LDB(B0, 1, 0); PG8_LDB(B1, 1, 1); PG8_SCHED; PG8_LDA(At, 1, 0); PG8_STAGEA(PG8_SA(0, 1), a2, s10, s11);
            PG8_WAIT_V(8); PG8_WAIT_L(0); PG8_BAR; PG8_MMA(0, 0, At, B0); PG8_MMA(0, 1, At, B1); PG8_BAR; PG8_SCHED;
            PG8_LDA(At, 1, 1); PG8_STAGE(PG8_SB(1, 0), b3, voffB); PG8_STAGE(PG8_SB(1, 1), b3 + hstepB, voffB); PG8_STAGEA(PG8_SA(1, 0), a3, s00, s01);
            PG8_WAIT_V(8); PG8_WAIT_L(0); PG8_BAR; PG8_MMA(1, 0, At, B0); PG8_MMA(1, 1, At, B1); PG8_BAR; PG8_SCHED;
            } else {
            PG8_LDB(B0, 0, 0); PG8_SCHED; PG8_LDA(At, 0, 0); PG8_STAGEA(PG8_SA(1, 1), a1, c10, c11);
            PG8_WAIT_L(8); PG8_BAR; PG8_WAIT_L(0); PG8_MMA(0, 0, At, B0); PG8_BAR; PG8_SCHED;
            PG8_LDB(B1, 0, 1); PG8_STAGE(PG8_SB(0, 0), b2, voffB);
            PG8_BAR; PG8_WAIT_L(0); PG8_MMA(0, 1, At, B1); PG8_BAR;
            PG8_LDA(At, 0, 1); PG8_STAGEA(PG8_SA(0, 0), a2, s00, s01);
            PG8_BAR; PG8_WAIT_L(0); PG8_MMA(1, 0, At, B0); PG8_BAR; PG8_SCHED;
            PG8_STAGE(PG8_SB(0, 1), b2 + hstepB, voffB);
            PG8_WAIT_V(6); PG8_BAR; PG8_MMA(1, 1, At, B1); PG8_BAR;
            PG8_LDB(B0, 1, 0); PG8_SCHED; PG8_LDA(At, 1, 0); PG8_STAGEA(PG8_SA(0, 1), a2, s10, s11);
            PG8_WAIT_L(8); PG8_BAR; PG8_WAIT_L(0); PG8_MMA(0, 0, At, B0); PG8_BAR; PG8_SCHED;
            PG8_LDB(B1, 1, 1); PG8_STAGE(PG8_SB(1, 0), b3, voffB);
            PG8_BAR; PG8_WAIT_L(0); PG8_MMA(0, 1, At, B1); PG8_BAR;
            PG8_LDA(At, 1, 1); PG8_STAGEA(PG8_SA(1, 0), a3, s00, s01);
            PG8_BAR; PG8_WAIT_L(0); PG8_MMA(1, 0, At, B0); PG8_BAR; PG8_SCHED;
            PG8_STAGE(PG8_SB(1, 1), b3 + hstepB, voffB);
            PG8_WAIT_V(6); PG8_BAR; PG8_MMA(1, 1, At, B1); PG8_BAR;
            }
        }
        if constexpr (ALIGN_EPI) { if (wr == 0) PG8_BAR; }
        { int tl = tid; asm volatile("" : "+v"(tl)); const int wid_ = __builtin_amdgcn_readfirstlane(tl >> 6), ln_ = tl & 63;
          epi_any(acc, cur, wid_ >> 2, wid_ & 3, ln_ & 15, ln_ >> 4, d); }
        if (!has_next) break;
#pragma unroll
        for (int a = 0; a < 2; ++a)
#pragma unroll
            for (int b = 0; b < 2; ++b)
#pragma unroll
                for (int m = 0; m < 4; ++m)
#pragma unroll
                    for (int n = 0; n < 2; ++n) acc[a][b][m][n] = (f32x4){0.f, 0.f, 0.f, 0.f};
        cur = nxt; cB = nB; c00 = n00; c01 = n01; c10 = n10; c11 = n11; ++ui;
        if constexpr (ALIGN_EPI) { if (wr == 1) PG8_BAR; }
    }
    PG8_WAIT_V(0);
    if constexpr (!ALIGN_EPI) { if (wr == 0) PG8_BAR; }
    PG8_BAR;
#undef PG8_SA
#undef PG8_SB
#undef PG8_STAGE
#undef PG8_STAGEA
#undef PG8_LDA
#undef PG8_LDB
#undef PG8_MMA
#undef PG8_WAIT_V
#undef PG8_WAIT_L
#undef PG8_BAR
#undef PG8_SCHED
}
}

template <class RF>
__device__ __forceinline__ void cvt_block(const float* W, int ldw, int nvalid, int k0, int n0, bf16_t* WT, float scale, RF rowoff, float* scr, int lane) {
    const int c4 = 4 * (lane & 15), r4 = lane >> 4;
    const bool ok = (n0 + c4) < nvalid;
    float4 v[16];
#pragma unroll
    for (int i = 0; i < 16; ++i) v[i] = ok ? *(const float4*)(W + (size_t)(k0 + 4 * i + r4) * ldw + n0 + c4) : make_float4(0.f, 0.f, 0.f, 0.f);
#pragma unroll
    for (int i = 0; i < 16; ++i) { float* d = scr + (4 * i + r4) * 65 + c4; d[0] = v[i].x * scale; d[1] = v[i].y * scale; d[2] = v[i].z * scale; d[3] = v[i].w * scale; }
    asm volatile("s_waitcnt lgkmcnt(0)" ::: "memory");
    const int c = lane & 7;
#pragma unroll
    for (int jj = 0; jj < 8; ++jj) { const int n = (lane >> 3) + 8 * jj; const float* s = scr + (8 * c) * 65 + n;
        uint4 o; o.x = (unsigned)f2bf(s[0]) | ((unsigned)f2bf(s[65]) << 16); o.y = (unsigned)f2bf(s[2 * 65]) | ((unsigned)f2bf(s[3 * 65]) << 16);
        o.z = (unsigned)f2bf(s[4 * 65]) | ((unsigned)f2bf(s[5 * 65]) << 16); o.w = (unsigned)f2bf(s[6 * 65]) | ((unsigned)f2bf(s[7 * 65]) << 16);
        *(uint4*)(WT + rowoff(n0 + n) + k0 + 8 * c) = o; }
    asm volatile("s_waitcnt lgkmcnt(0)" ::: "memory");
}
__device__ __noinline__ int cvt_matrix(const float* W, size_t wstride, int nbatch, int K, int N, int nvalid, int ldw, bf16_t* WT, float scale, int rb, int sh, int rs, int mask, int r0, int ldt, int c1,
                                       unsigned* counter, int seg_lo, int pending) {
    const int tid = threadIdx.x, lane = tid & 63, wave = tid >> 6, gw = blockIdx.x * NWAVES + wave, NGW = gridDim.x * NWAVES;
    float* scr = (float*)lds_raw + wave * (64 * 65);
    const int nkb = K / 64, nnb = N / 64, per = nkb * nnb, total = per * nbatch;
    if (counter == nullptr) {
        for (int it = gw; it < total; it += NGW) { const int b = it / per, r = it % per, kb = r / nnb, nb = r % nnb;
            cvt_block(W + (size_t)b * wstride, ldw, nvalid, kb * 64, nb * 64, WT, scale, [=](int n) { return (size_t)(b * rb + (n >> sh) * rs + (n & mask) + r0) * ldt + (b & 1) * c1; }, scr, lane); }
        return 0;
    }
    const int seg_hi = seg_lo + (total + 3) / 4;
    int idx = pending;
    for (;;) {
        if (idx < 0) { unsigned v = 0; if (lane == 0) v = __hip_atomic_fetch_add(counter, 1u, __ATOMIC_RELAXED, __HIP_MEMORY_SCOPE_AGENT); idx = (int)__builtin_amdgcn_readfirstlane(v); }
        if (idx >= seg_hi) return idx;
        const int c0 = (idx - seg_lo) * 4, c1e = (c0 + 4 < total) ? c0 + 4 : total;
        for (int it = c0; it < c1e; ++it) { const int b = it / per, r = it % per, kb = r / nnb, nb = r % nnb;
            cvt_block(W + (size_t)b * wstride, ldw, nvalid, kb * 64, nb * 64, WT, scale, [=](int n) { return (size_t)(b * rb + (n >> sh) * rs + (n & mask) + r0) * ldt + (b & 1) * c1; }, scr, lane); }
        idx = -1;
    }
}
__device__ __noinline__ void ph_pre(const float* x, const float* rel_bias, unsigned char* ws) {
    const int tid = threadIdx.x, lane = tid & 63, wave = tid >> 6, gw = blockIdx.x * NWAVES + wave, NGW = gridDim.x * NWAVES; float* ldsf = (float*)lds_raw;
    (void)lane; (void)wave; (void)gw; (void)NGW; (void)ldsf;
        {
            const size_t stride = (size_t)gridDim.x * NTHR, n4 = (size_t)M * D / 4;
            for (size_t i = (size_t)blockIdx.x * NTHR + tid; i < n4; i += 4 * stride) {
                float4 v[4];
#pragma unroll
                for (int q = 0; q < 4; ++q) v[q] = (i + q * stride < n4) ? ((const float4*)x)[i + q * stride] : make_float4(0.f, 0.f, 0.f, 0.f);
#pragma unroll
                for (int q = 0; q < 4; ++q) if (i + q * stride < n4) { uint2 o; o.x = (unsigned)f2bf(v[q].x) | ((unsigned)f2bf(v[q].y) << 16); o.y = (unsigned)f2bf(v[q].z) | ((unsigned)f2bf(v[q].w) << 16); ((uint2*)XB)[i + q * stride] = o; }
            }
        }
        for (int i = blockIdx.x * NTHR + tid; i < 4096 * 16; i += gridDim.x * NTHR) { const int d = i >> 4, h = i & 15; BIAS_T[i] = rel_bias[t5_bucket(d) * 16 + h]; }
}

__device__ __noinline__ void ph_prep_dsa_fold(const float* w_uq, const float* w_uk, bf16_t* wq, bf16_t* wuv) {
    const int tid = threadIdx.x; float* ldsf = (float*)lds_raw;
    for (int i = blockIdx.x * NTHR + tid; i < HW * 32; i += gridDim.x * NTHR) { const int row = i >> 5, ch = i & 31, h = row >> 7; *(uint4*)(wuv + (size_t)row * 512 + ((h & 1) ^ 1) * 256 + ch * 8) = make_uint4(0u, 0u, 0u, 0u); }
    gemm_naive(ldsf, H, KVL, QL, HD,
        [=](int h, int c, int d) { return w_uk[((size_t)h * HD + d) * KVL + c]; },
        [=](int h, int d, int k) { return w_uq[(size_t)k * HW + h * HD + d]; },
        [=](int h, int c, int k, float v) { wq[(size_t)(h * KVL + c) * QL + k] = f2bf(v * 0.08838834764831845f); });
}

__device__ __noinline__ void ph_dsa_norms(const float* qn, const float* kn, unsigned char* ws) {
    const int tid = threadIdx.x, lane = tid & 63, wave = tid >> 6, gw = blockIdx.x * NWAVES + wave, NGW = gridDim.x * NWAVES; float* ldsf = (float*)lds_raw;
    (void)lane; (void)wave; (void)gw; (void)NGW; (void)ldsf;
                for (int m = gw; m < M; m += NGW) {
                    const float* p = PRAW + (size_t)m * 1024;
                    float v[8]; float s = 0.f;
#pragma unroll
                    for (int i = 0; i < 8; ++i) { v[i] = p[lane + 64 * i]; s += v[i] * v[i]; }
                    float r = rsqrtf(wave_sum(s) * (1.f / QL) + EPS);
#pragma unroll
                    for (int i = 0; i < 8; ++i) CQ[(size_t)m * QL + lane + 64 * i] = f2bf(v[i] * r * qn[lane + 64 * i]);
                    s = 0.f;
#pragma unroll
                    for (int i = 0; i < 4; ++i) { v[i] = p[QL + lane + 64 * i]; s += v[i] * v[i]; }
                    r = rsqrtf(wave_sum(s) * (1.f / KVL) + EPS);
#pragma unroll
                    for (int i = 0; i < 4; ++i) CKV[(size_t)m * KVL + lane + 64 * i] = f2bf(v[i] * r * kn[lane + 64 * i]);
                    KIDX[(size_t)m * IDM + lane] = f2bf(p[QL + KVL + lane]);
                    if (lane < IH) WIDX[(size_t)m * IH + lane] = p[QL + KVL + IDM + lane] * 0.25f;
                }
}

typedef short s16x8 __attribute__((ext_vector_type(8)));
typedef float f32x16 __attribute__((ext_vector_type(16)));
__device__ __forceinline__ void ph_dsa_index(unsigned char* ws) {
    int tid_ = threadIdx.x; asm volatile("" : "+v"(tid_));
    const int tid = tid_, lane = tid & 63, wave = __builtin_amdgcn_readfirstlane(tid >> 6);
    LAS unsigned char* lds = (LAS unsigned char*)lds_raw;
    const bf16_t* qall = QALL; const bf16_t* kidx = KIDX; const float* widx = WIDX; float* scb = SC;
    for (int unit = blockIdx.x; unit < NB_ * 64; unit += gridDim.x) {
        const int b = unit & 3, p = unit >> 2;
#pragma unroll 1
        for (int half = 0; half < 2; ++half) {
            const int qb = half ? p : 127 - p;
            const size_t qrow0 = (size_t)b * T + (size_t)qb * 32;
            __syncthreads();
#pragma unroll
            for (int i = 0; i < 8; ++i) { const int item = tid + 512 * i, q = item >> 7, hc = item & 127, h = hc >> 3, c = hc & 7;
                const uint4 v = *(const uint4*)(qall + (qrow0 + q) * QALD + 4096 + h * 64 + c * 8);
                *(LAS pg8::u32x4*)(lds + ((h * 4 + (c >> 1)) * 64 + q + 32 * (c & 1)) * 16) = (pg8::u32x4){v.x, v.y, v.z, v.w}; }
            if (tid < 256) {
                const int q = tid >> 3, c = tid & 7; float acc8[8];
#pragma unroll
                for (int e2 = 0; e2 < 8; ++e2) acc8[e2] = 0.f;
#pragma unroll 4
                for (int h = 0; h < 16; ++h) { const float w = widx[(qrow0 + q) * 16 + h]; const uint4 v = *(const uint4*)(qall + (qrow0 + q) * QALD + 4096 + h * 64 + c * 8); const unsigned w4[4] = {v.x, v.y, v.z, v.w};
#pragma unroll
                    for (int e2 = 0; e2 < 4; ++e2) { acc8[2 * e2] = fmaf(w, __uint_as_float(w4[e2] << 16), acc8[2 * e2]); acc8[2 * e2 + 1] = fmaf(w, __uint_as_float(w4[e2] & 0xffff0000u), acc8[2 * e2 + 1]); } }
                pg8::u32x4 o; o.x = (unsigned)f2bf(acc8[0]) | ((unsigned)f2bf(acc8[1]) << 16); o.y = (unsigned)f2bf(acc8[2]) | ((unsigned)f2bf(acc8[3]) << 16);
                o.z = (unsigned)f2bf(acc8[4]) | ((unsigned)f2bf(acc8[5]) << 16); o.w = (unsigned)f2bf(acc8[6]) | ((unsigned)f2bf(acc8[7]) << 16);
                *(LAS pg8::u32x4*)(lds + ((16 * 4 + (c >> 1)) * 64 + q + 32 * (c & 1)) * 16) = o;
            }
            if (tid < 512) { const int h = tid >> 5, q = tid & 31; *(LAS float*)(lds + 69632 + (h * 32 + q) * 4) = widx[(qrow0 + q) * 16 + h]; }
            __syncthreads();
            float* const scq = scb + (size_t)b * SC_PER_B + (size_t)512 * qb * (qb + 1) + (size_t)(lane & 31) * (32 * (qb + 1)) + 4 * (lane >> 5);
#pragma unroll 1
            for (int kb = wave; kb <= qb; kb += NWAVES) {
                s16x8 ka[4];
                { const bf16_t* kp = kidx + ((size_t)b * T + kb * 32 + (lane & 31)) * IDM + 8 * (lane >> 5);
#pragma unroll
                  for (int s = 0; s < 4; ++s) ka[s] = *(const s16x8*)(kp + 16 * s); }
                f32x16 acc;
                {
                    const f32x16 z = {0.f, 0.f, 0.f, 0.f, 0.f, 0.f, 0.f, 0.f, 0.f, 0.f, 0.f, 0.f, 0.f, 0.f, 0.f, 0.f};
                    acc = __builtin_amdgcn_mfma_f32_32x32x16_bf16(ka[0], *(const LAS s16x8*)(lds + ((16 * 4 + 0) * 64 + lane) * 16), z, 0, 0, 0);
#pragma unroll
                    for (int s = 1; s < 4; ++s) acc = __builtin_amdgcn_mfma_f32_32x32x16_bf16(ka[s], *(const LAS s16x8*)(lds + ((16 * 4 + s) * 64 + lane) * 16), acc, 0, 0, 0);
                }
#pragma unroll 2
                for (int h = 0; h < 16; ++h) {
                    const f32x16 z = {0.f, 0.f, 0.f, 0.f, 0.f, 0.f, 0.f, 0.f, 0.f, 0.f, 0.f, 0.f, 0.f, 0.f, 0.f, 0.f};
                    f32x16 sv = __builtin_amdgcn_mfma_f32_32x32x16_bf16(ka[0], *(const LAS s16x8*)(lds + ((h * 4 + 0) * 64 + lane) * 16), z, 0, 0, 0);
#pragma unroll
                    for (int s = 1; s < 4; ++s) sv = __builtin_amdgcn_mfma_f32_32x32x16_bf16(ka[s], *(const LAS s16x8*)(lds + ((h * 4 + s) * 64 + lane) * 16), sv, 0, 0, 0);
                    const float w = *(const LAS float*)(lds + 69632 + (h * 32 + (lane & 31)) * 4);
#pragma unroll
                    for (int r = 0; r < 16; ++r) acc[r] = fmaf(__builtin_fabsf(sv[r]), w, acc[r]);
                }
#pragma unroll
                for (int g = 0; g < 4; ++g) *(float4*)(scq + kb * 32 + 8 * g) = make_float4(acc[4 * g], acc[4 * g + 1], acc[4 * g + 2], acc[4 * g + 3]);
            }
        }
    }
    __syncthreads();
}

__device__ __forceinline__ void ph_dsa_topk(unsigned char* ws) {
    int tid_ = threadIdx.x; asm volatile("" : "+v"(tid_));
    const int tid = tid_, lane = tid & 63, wave = tid >> 6;
    float* sw = (float*)lds_raw + wave * 4096;
    const float NINF = -__builtin_inff(), PINF = __builtin_inff();
    typedef __attribute__((address_space(1))) const pg8::f32x4 gf4;
    const int nrows = M / (int)gridDim.x;
    LAS int* qctr = (LAS int*)((LAS unsigned char*)lds_raw + LDS_MISC + 3072);
    __syncthreads();
    if (tid == 0) *qctr = NWAVES;
    __syncthreads();
    auto row_of = [&](int j) -> int {
        if (gridDim.x == 256) { const int g = 8 * (int)blockIdx.x + (j & 7), bb = (j >> 3) & 3; return bb * T + ((j < 32) ? (T - 1 - g) : g); }
        return (int)blockIdx.x * nrows + j; };
    pg8::f32x4 xs[16];
    auto fetch = [&](int j) {
        if (j < nrows) { const int m = row_of(j), b = m / T, t = m % T, n = t + 1;
            if (n > TOPK) { const int nq = (n + 255) >> 8; gf4* sg = (gf4*)(SC + sc_off(b, t)) + lane;
#pragma unroll
                for (int i = 0; i < 16; ++i) xs[i] = (i < nq) ? sg[64 * i] : (pg8::f32x4){NINF, NINF, NINF, NINF}; } }
    };
    int jcur = wave;
    fetch(jcur);
    while (jcur < nrows) {
        const int m = row_of(jcur);
        int jn; { int tk = 0; if (lane == 0) tk = __hip_atomic_fetch_add(qctr, 1, __ATOMIC_RELAXED, __HIP_MEMORY_SCOPE_WORKGROUP); jn = __builtin_amdgcn_readfirstlane(tk); }
        jcur = jn;
        const int b = m / T, t = m % T, n = t + 1; (void)b;
        int* sel = SEL + (size_t)m * TOPK;
        if (n <= TOPK) { int l3 = tid; asm volatile("" : "+v"(l3)); l3 &= 63;
            for (int i = l3; i < n; i += 64) sel[i] = i; if (l3 == 0) NSEL[m] = n; fetch(jn); continue; }
        const int nq = (n + 255) >> 8;
        float mn = PINF, mx = NINF;
        {
#pragma unroll
            for (int i = 0; i < 16; ++i) { const int k0 = 4 * (lane + 64 * i); float4 x = make_float4(xs[i][0], xs[i][1], xs[i][2], xs[i][3]);
                x.x = (k0 + 0 < n) ? x.x : NINF; x.y = (k0 + 1 < n) ? x.y : NINF; x.z = (k0 + 2 < n) ? x.z : NINF; x.w = (k0 + 3 < n) ? x.w : NINF;
                *(float4*)(sw + k0) = x;
                mx = fmaxf(fmaxf(mx, x.x), fmaxf(x.y, fmaxf(x.z, x.w)));
                mn = fminf(mn, x.x == NINF ? PINF : x.x); mn = fminf(mn, x.y == NINF ? PINF : x.y); mn = fminf(mn, x.z == NINF ? PINF : x.z); mn = fminf(mn, x.w == NINF ? PINF : x.w); }
        }
        fetch(jn);
        float lo_v = wave_min_dpp(mn), hi_v = wave_max_dpp(mx);
        int c_lo = n, c_hi = 1;
#pragma unroll 1
        for (int it = 0; it < 96; ++it) {
            if (c_lo == TOPK) break;
            float f = 0.5f;
            if ((it & 1) == 0) { f = ((float)(c_lo - TOPK) + 0.5f) / (float)(c_lo - c_hi); f = fminf(fmaxf(f, 0.03f), 0.97f); }
            float mid = lo_v + (hi_v - lo_v) * f;
            if (!(mid > lo_v && mid < hi_v)) { mid = lo_v + (hi_v - lo_v) * 0.5f; if (!(mid > lo_v && mid < hi_v)) break; }
            int c = 0;
#pragma unroll 1
            for (int i0 = 0; i0 < nq; i0 += 8) {
                float4 x8[8];
#pragma unroll
                for (int j = 0; j < 8; ++j) x8[j] = *(const float4*)(sw + 4 * (lane + 64 * (i0 + j)));
#pragma unroll
                for (int j = 0; j < 8; ++j) c += (x8[j].x >= mid) + (x8[j].y >= mid) + (x8[j].z >= mid) + (x8[j].w >= mid);
            }
            c = wave_sum_dpp(c);
            if (c >= TOPK) { lo_v = mid; c_lo = c; } else { hi_v = mid; c_hi = c; }
        }
        float Tv = lo_v;
        int lgt = 0, leq = 0;
#pragma unroll 4
        for (int i = 0; i < nq; ++i) { const float4 x = *(const float4*)(sw + 4 * (lane + 64 * i));
            lgt += (x.x > Tv) + (x.y > Tv) + (x.z > Tv) + (x.w > Tv); leq += (x.x == Tv) + (x.y == Tv) + (x.z == Tv) + (x.w == Tv); }
        int sgt = wave_scan_dpp(lgt), seq = wave_scan_dpp(leq);
        int cgt = __builtin_amdgcn_readlane(sgt, 63), ceq = __builtin_amdgcn_readlane(seq, 63);
        if (cgt > TOPK) {
            Tv = hi_v; lgt = 0; leq = 0;
#pragma unroll 4
            for (int i = 0; i < nq; ++i) { const float4 x = *(const float4*)(sw + 4 * (lane + 64 * i)); leq += (x.x == Tv) + (x.y == Tv) + (x.z == Tv) + (x.w == Tv); }
            cgt = 0; sgt = 0; seq = wave_scan_dpp(leq); ceq = __builtin_amdgcn_readlane(seq, 63);
        }
        const int need = TOPK - cgt;
        LAS int* sl = (LAS int*)((LAS unsigned char*)lds_raw + 131072 + wave * 1024);
        int p = sgt - lgt, q = cgt + seq - leq;
        const bool all_ties = (ceq <= need);
#pragma unroll 2
        for (int i = 0; i < nq; ++i) {
            const int k0 = 4 * (lane + 64 * i); const float4 x = *(const float4*)(sw + k0); const float xv[4] = {x.x, x.y, x.z, x.w};
#pragma unroll
            for (int e2 = 0; e2 < 4; ++e2) { if (xv[e2] > Tv) sl[p++] = k0 + e2; else if (all_ties && xv[e2] == Tv) sl[q++] = k0 + e2; }
        }
        if (!all_ties) {
            int taken_below = -1;
            _Pragma("unroll 1") for (int i2 = 0; i2 < need; ++i2) {
                int best = 0x7fffffff;
                _Pragma("unroll 1") for (int i = 0; i < nq; ++i) { const int k0 = 4 * (lane + 64 * i); const float4 x = *(const float4*)(sw + k0); const float xv[4] = {x.x, x.y, x.z, x.w};
#pragma unroll
                    for (int e2 = 0; e2 < 4; ++e2) { const int key = k0 + e2; if (xv[e2] == Tv && key > taken_below && key < best) best = key; } }
                best = wave_min_i(best);
                if (lane == 0) sl[cgt + i2] = best;
                taken_below = best;
            }
        }
        asm volatile("s_waitcnt lgkmcnt(0)" ::: "memory");
        *(pg8::u32x4*)(sel + 4 * lane) = *(const LAS pg8::u32x4*)(sl + 4 * lane);
        if (lane == 0) NSEL[m] = TOPK;
    }
}

typedef float f32x4v __attribute__((ext_vector_type(4)));
__device__ __forceinline__ void ph_dsa_attn(unsigned char* ws) {
    int tid_ = threadIdx.x; asm volatile("" : "+v"(tid_));
    const int tid = tid_, lane = tid & 63, wave = __builtin_amdgcn_readfirstlane(tid >> 6), n16 = lane & 15, g4 = lane >> 4;
    LAS unsigned char* lds = (LAS unsigned char*)lds_raw;
    LAS unsigned char* kvb = lds + wave * 16384;
    LAS int* sell = (LAS int*)(lds + 131072 + wave * 1024);
    const bf16_t* qall = QALL; const bf16_t* ckv = CKV; const int* selg = SEL; const int* nselg = NSEL; const float* biasT = BIAS_T; bf16_t* olat = OLAT;
    const int NQ = (M + (int)(gridDim.x * NWAVES) - 1) / (int)(gridDim.x * NWAVES);
    for (int it = 0; it < NQ; ++it) {
        int m;
        if (gridDim.x == 256) { const int b = (blockIdx.x & 7) >> 1, wb = ((blockIdx.x & 1) * 32 + (blockIdx.x >> 3)) * NWAVES + wave; m = b * T + wb + 512 * it; }
        else m = (blockIdx.x * NWAVES + wave) + (int)(gridDim.x * NWAVES) * it;
        if (m >= M) continue;
        const int b = m / T, t = m % T;
        const int nsel = __builtin_amdgcn_readfirstlane(ld_mut(nselg + m));
        float zf = 0.f; asm volatile("" : "+v"(zf));
        { int sv[4];
#pragma unroll
          for (int i = 0; i < 4; ++i) sv[i] = selg[(size_t)m * TOPK + lane + 64 * i];
#pragma unroll
          for (int i = 0; i < 4; ++i) { const int k = lane + 64 * i; sell[k] = (k < nsel) ? sv[i] : 0; } }
        s16x8 qf[8];
        { const bf16_t* qrow = qall + (size_t)m * QALD + n16 * KVL + 8 * g4;
#pragma unroll
          for (int s = 0; s < 8; ++s) qf[s] = *(const s16x8*)(qrow + 32 * s); }
        f32x4v o[16];
#pragma unroll
        for (int cb = 0; cb < 16; ++cb) o[cb] = (f32x4v){zf, zf, zf, zf};
        float m_run = -1e30f, l_run = 0.f;
        const int nch = (nsel + 31) >> 5;
        const size_t rowb = (size_t)b * T;
#pragma unroll 1
        for (int ch = 0; ch < nch; ++ch) {
            asm volatile("s_waitcnt lgkmcnt(0)" ::: "memory");
#pragma unroll
            for (int i = 0; i < 16; ++i) { const int row = 2 * i + (lane >> 5), key = sell[ch * 32 + row], c = (lane & 31) ^ (row & 15);
                __builtin_amdgcn_global_load_lds((const unsigned*)(ckv + (rowb + key) * KVL + c * 8), (LAS unsigned*)(kvb + i * 1024), 16, 0, 0); }
            const pg8::u32x4 k0 = *(const LAS pg8::u32x4*)(sell + ch * 32 + 4 * g4), k1 = *(const LAS pg8::u32x4*)(sell + ch * 32 + 16 + 4 * g4);
            float bia[8];
            bia[0] = biasT[(t - (int)k0.x) * 16 + n16]; bia[1] = biasT[(t - (int)k0.y) * 16 + n16]; bia[2] = biasT[(t - (int)k0.z) * 16 + n16]; bia[3] = biasT[(t - (int)k0.w) * 16 + n16];
            bia[4] = biasT[(t - (int)k1.x) * 16 + n16]; bia[5] = biasT[(t - (int)k1.y) * 16 + n16]; bia[6] = biasT[(t - (int)k1.z) * 16 + n16]; bia[7] = biasT[(t - (int)k1.w) * 16 + n16];
            asm volatile("s_waitcnt vmcnt(0)" ::: "memory");
            f32x4v s0 = (f32x4v){0.f, 0.f, 0.f, 0.f}, s1 = (f32x4v){0.f, 0.f, 0.f, 0.f};
#pragma unroll
            for (int s = 0; s < 8; ++s) {
                const int cs = ((4 * s + g4) ^ n16) * 16;
                const s16x8 a0 = *(const LAS s16x8*)(kvb + n16 * 512 + cs), a1 = *(const LAS s16x8*)(kvb + (16 + n16) * 512 + cs);
                s0 = __builtin_amdgcn_mfma_f32_16x16x32_bf16(a0, qf[s], s0, 0, 0, 0); s1 = __builtin_amdgcn_mfma_f32_16x16x32_bf16(a1, qf[s], s1, 0, 0, 0);
            }
            float sc[8]; float tmax = -__builtin_inff();
#pragma unroll
            for (int r = 0; r < 4; ++r) { sc[r] = (ch * 32 + 4 * g4 + r < nsel) ? s0[r] + bia[r] : -__builtin_inff(); sc[4 + r] = (ch * 32 + 16 + 4 * g4 + r < nsel) ? s1[r] + bia[4 + r] : -__builtin_inff(); }
#pragma unroll
            for (int r = 0; r < 8; ++r) tmax = fmaxf(tmax, sc[r]);
            tmax = fmaxf(tmax, __shfl_xor(tmax, 16)); tmax = fmaxf(tmax, __shfl_xor(tmax, 32));
            if (__any(tmax > m_run + 6.f)) {
                const float mnew = fmaxf(m_run, tmax), alpha = __expf(m_run - mnew);
#pragma unroll
                for (int cb = 0; cb < 16; ++cb) o[cb] *= alpha;
                l_run *= alpha; m_run = mnew;
            }
            float p[8]; float psum = 0.f;
#pragma unroll
            for (int r = 0; r < 8; ++r) { p[r] = __expf(sc[r] - m_run); psum += p[r]; }
            l_run += psum;
            s16x8 pb;
            { const unsigned w0 = pg8::cvt_pk_bf16(p[0], p[1]), w1 = pg8::cvt_pk_bf16(p[2], p[3]), w2 = pg8::cvt_pk_bf16(p[4], p[5]), w3 = pg8::cvt_pk_bf16(p[6], p[7]);
              pb[0] = (short)(w0 & 0xffff); pb[1] = (short)(w0 >> 16); pb[2] = (short)(w1 & 0xffff); pb[3] = (short)(w1 >> 16); pb[4] = (short)(w2 & 0xffff); pb[5] = (short)(w2 >> 16); pb[6] = (short)(w3 & 0xffff); pb[7] = (short)(w3 >> 16); }
            {
                const int q4 = n16 >> 2, p4 = n16 & 3, x = 4 * g4 + q4;
                const LAS unsigned char* vb = kvb + x * 512 + (p4 & 1) * 8;
                const int yo = (p4 >> 1) ^ (x & 1), xe = x & 14;
#pragma unroll
                for (int cq = 0; cq < 4; ++cq) {
                    typedef short s16x4 __attribute__((ext_vector_type(4)));
                    s16x4 lo[4], hi4[4];
#pragma unroll
                    for (int u = 0; u < 4; ++u) { const int cb = 4 * cq + u; const int co = (((2 * cb) ^ xe) + yo) * 16;
                        lo[u] = __builtin_bit_cast(s16x4, __builtin_amdgcn_ds_read_tr16_b64_v4i16((LAS s16x4*)(vb + co)));
                        hi4[u] = __builtin_bit_cast(s16x4, __builtin_amdgcn_ds_read_tr16_b64_v4i16((LAS s16x4*)(vb + 16 * 512 + co))); }
#pragma unroll
                    for (int u = 0; u < 4; ++u) { const int cb = 4 * cq + u;
                        s16x8 va; va[0] = lo[u][0]; va[1] = lo[u][1]; va[2] = lo[u][2]; va[3] = lo[u][3]; va[4] = hi4[u][0]; va[5] = hi4[u][1]; va[6] = hi4[u][2]; va[7] = hi4[u][3];
                        o[cb] = __builtin_amdgcn_mfma_f32_16x16x32_bf16(va, pb, o[cb], 0, 0, 0); }
                }
            }
        }
        {
            float lt = l_run; lt += __shfl_xor(lt, 16); lt += __shfl_xor(lt, 32);
            const float inv = 1.f / lt;
            bf16_t* orow = olat + (size_t)m * 4096 + n16 * KVL + 4 * g4;
#pragma unroll
            for (int cb = 0; cb < 16; ++cb) { pg8::u32x2 w; w.x = pg8::cvt_pk_bf16(o[cb][0] * inv, o[cb][1] * inv); w.y = pg8::cvt_pk_bf16(o[cb][2] * inv, o[cb][3] * inv); *(pg8::u32x2*)(orow + 16 * cb) = w; }
        }
    }
    __syncthreads();
}

__device__ __forceinline__ void ph_dil_attn(unsigned char* ws) {
    int tid_ = threadIdx.x; asm volatile("" : "+v"(tid_));
    const int tid = tid_, lane = tid & 63, wave = __builtin_amdgcn_readfirstlane(tid >> 6), qi = lane & 31, hi = lane >> 5;
    LAS unsigned char* lds = (LAS unsigned char*)lds_raw;
    LAS unsigned char* kbuf = lds + wave * 16384;
    LAS unsigned char* vbuf = kbuf + 8192;
    const int drow = lane >> 4, kc0 = ((lane & 15) ^ drow) * 8, kc1 = ((lane & 15) ^ (4 + drow)) * 8, vc = ((lane & 15) ^ (drow << 2)) * 8;
    LAS float* btab = (LAS float*)(lds + 131072);
    const bf16_t* qkv = QKV; bf16_t* ob = OB; const float* biasT = BIAS_T;
    bf16_t* stb = (bf16_t*)(ws + AR_DST) + (size_t)blockIdx.x * (512 * 128);
    float* mlb = (float*)(ws + AR_DML) + (size_t)blockIdx.x * (512 * 4);
    for (int task = blockIdx.x; task < 512; task += gridDim.x) {
        float zf = 0.f; asm volatile("" : "+v"(zf));
        const f32x16 zero16 = {zf, zf, zf, zf, zf, zf, zf, zf, zf, zf, zf, zf, zf, zf, zf, zf};
        const int x = task & 7, u = task >> 3, bh = x + 8 * (u >> 3), h = bh & 15, s0 = (u & 7) * 512;
        __syncthreads();
        { int t2 = tid; asm volatile("" : "+v"(t2));
          if (t2 < 387) { const int br = t2 / 129, m = t2 - br * 129, dl = (br == 0) ? 1 : (br == 1 ? 4 : 16); btab[br * 132 + m] = biasT[(dl * m) * 16 + h] * 1.4426950408889634f; } }
        __syncthreads();
        const bf16_t* qbase = qkv + (size_t)bh * T * HD + 8 * hi;
        const bf16_t* kbase = qkv + (size_t)(64 + bh) * T * HD;
        const bf16_t* vbase = qkv + (size_t)(128 + bh) * T * HD;
        s16x8 qf[8], kf[8];
        f32x16 o0 = zero16, o1 = zero16, o2 = zero16, o3 = zero16;
        float m_run = -1e30f, l_run = 0.f;
        int br = 0, gi = 0, kt = 0, tb = s0 + 32 * wave, tq = 0;
        while (tb + (-128 + 32 * kt + 31) < 0) ++kt;
        bool fresh = true;
        {
            const int J0 = -128 + 32 * kt;
#pragma unroll
            for (int i = 0; i < 8; ++i) { int tk = tb + (J0 + 4 * i + drow); tk = tk < 0 ? 0 : tk;
                __builtin_amdgcn_global_load_lds((const unsigned*)(kbase + (size_t)tk * HD + ((i & 1) ? kc1 : kc0)), (LAS unsigned*)(kbuf + i * 1024), 16, 0, 0); }
#pragma unroll
            for (int i = 0; i < 8; ++i) { int tv = tb + (J0 + 4 * i + drow); tv = tv < 0 ? 0 : tv;
                __builtin_amdgcn_global_load_lds((const unsigned*)(vbase + (size_t)tv * HD + vc), (LAS unsigned*)(vbuf + i * 1024), 16, 0, 0); }
        }
#pragma unroll 1
        for (;;) {
            const int shift = 2 * br, J0 = -128 + 32 * kt;
            if (fresh) {
                tq = tb + (qi << shift);
                if (br > 0 && gi == 0) { asm volatile("s_waitcnt vmcnt(0)" ::: "memory"); __syncthreads(); }
                const bf16_t* qrow = qbase + (size_t)tq * HD;
#pragma unroll
                for (int s = 0; s < 8; ++s) qf[s] = *(const s16x8*)(qrow + 16 * s);
                if (br == 0) { o0 = zero16; o1 = zero16; o2 = zero16; o3 = zero16; m_run = -1e30f; l_run = 0.f; }
                else {
                    const int ql = (tq - s0) * 2 + hi;
                    const pg8::u32x4* sp = (const pg8::u32x4*)(stb + (size_t)ql * 64);
                    const float2 ml = *(const float2*)(mlb + ql * 2); m_run = ml.x; l_run = ml.y;
#define DIL_LD(O, DB) { const pg8::u32x4 w0 = sp[2 * (DB)], w1 = sp[2 * (DB) + 1]; \
                        O[0] = __uint_as_float(w0.x << 16); O[1] = __uint_as_float(w0.x & 0xffff0000u); O[2] = __uint_as_float(w0.y << 16); O[3] = __uint_as_float(w0.y & 0xffff0000u); \
                        O[4] = __uint_as_float(w0.z << 16); O[5] = __uint_as_float(w0.z & 0xffff0000u); O[6] = __uint_as_float(w0.w << 16); O[7] = __uint_as_float(w0.w & 0xffff0000u); \
                        O[8] = __uint_as_float(w1.x << 16); O[9] = __uint_as_float(w1.x & 0xffff0000u); O[10] = __uint_as_float(w1.y << 16); O[11] = __uint_as_float(w1.y & 0xffff0000u); \
                        O[12] = __uint_as_float(w1.z << 16); O[13] = __uint_as_float(w1.z & 0xffff0000u); O[14] = __uint_as_float(w1.w << 16); O[15] = __uint_as_float(w1.w & 0xffff0000u); }
                    DIL_LD(o0, 0) DIL_LD(o1, 1) DIL_LD(o2, 2) DIL_LD(o3, 3)
#undef DIL_LD
                }
            }
            const int mmax = min(128, tq >> shift);
            int nbr = br, ngi = gi, nkt = kt + 1, ntb = tb;
            if (nkt == 5) {
                ++ngi; if (ngi == 2) { ngi = 0; ++nbr; }
                nkt = 0;
                if (nbr < 3) { const int g = wave + 8 * ngi, ndl = 1 << (2 * nbr);
                    ntb = s0 + ((nbr == 0) ? 32 * g : (nbr == 1) ? 128 * (g >> 2) + (g & 3) : g);
                    while (ntb + (-128 + 32 * nkt + 31) * ndl < 0) ++nkt; }
            }
            const bool more = nbr < 3, glast = (kt == 4);
            const int mb = qi - J0 - 4 * hi;
            const LAS float* bt = btab + br * 132;
            float bv[16];
#pragma unroll
            for (int r = 0; r < 16; ++r) { const int m = mb - ((r & 3) + 8 * (r >> 2)); bv[r] = bt[min(max(m, 0), 128)]; }
            asm volatile("s_waitcnt vmcnt(8)" ::: "memory");
#pragma unroll
            for (int s = 0; s < 8; ++s) kf[s] = *(const LAS s16x8*)(kbuf + qi * 256 + (((2 * s + hi) ^ (qi & 7)) * 16));
            asm volatile("s_waitcnt lgkmcnt(0)" ::: "memory");
            if (more) {
                const int ndl = 1 << (2 * nbr), nJ0 = -128 + 32 * nkt;
#pragma unroll
                for (int i = 0; i < 8; ++i) { int tk = ntb + (nJ0 + 4 * i + drow) * ndl; tk = tk < 0 ? 0 : tk;
                    __builtin_amdgcn_global_load_lds((const unsigned*)(kbase + (size_t)tk * HD + ((i & 1) ? kc1 : kc0)), (LAS unsigned*)(kbuf + i * 1024), 16, 0, 0); }
            }
            f32x16 sc = __builtin_amdgcn_mfma_f32_32x32x16_bf16(kf[0], qf[0], (f32x16){0.f, 0.f, 0.f, 0.f, 0.f, 0.f, 0.f, 0.f, 0.f, 0.f, 0.f, 0.f, 0.f, 0.f, 0.f, 0.f}, 0, 0, 0);
#pragma unroll
            for (int s = 1; s < 8; ++s) sc = __builtin_amdgcn_mfma_f32_32x32x16_bf16(kf[s], qf[s], sc, 0, 0, 0);
            float tmax = -__builtin_inff();
#pragma unroll
            for (int r = 0; r < 16; ++r) { const int m = mb - ((r & 3) + 8 * (r >> 2));
                sc[r] = ((unsigned)m <= (unsigned)mmax) ? sc[r] + bv[r] : -__builtin_inff(); tmax = fmaxf(tmax, sc[r]); }
            tmax = fmaxf(tmax, __shfl_xor(tmax, 32));
            if (__any(tmax > m_run + 8.f)) {
                const float mnew = fmaxf(m_run, tmax), alpha = __builtin_amdgcn_exp2f(m_run - mnew);
                o0 *= alpha; o1 *= alpha; o2 *= alpha; o3 *= alpha; l_run *= alpha; m_run = mnew;
            }
            float psum = 0.f; unsigned pk[8];
#pragma unroll
            for (int r = 0; r < 16; r += 2) { const float p0 = __builtin_amdgcn_exp2f(sc[r] - m_run), p1 = __builtin_amdgcn_exp2f(sc[r + 1] - m_run); psum += p0 + p1; pk[r >> 1] = pg8::cvt_pk_bf16(p0, p1); }
            l_run += psum;
            if (more) asm volatile("s_waitcnt vmcnt(8)" ::: "memory"); else asm volatile("s_waitcnt vmcnt(0)" ::: "memory");
            {
                const int G4 = lane >> 4, q4 = (lane & 15) >> 2, p4 = lane & 3;
                const LAS unsigned char* vb = vbuf + (4 * (G4 >> 1) + q4) * 256 + (2 * (G4 & 1) + (p4 >> 1)) * 16 + (p4 & 1) * 8;
#pragma unroll
                for (int s2 = 0; s2 < 2; ++s2) {
                    s16x8 pb; pb[0] = (short)(pk[4 * s2] & 0xffff); pb[1] = (short)(pk[4 * s2] >> 16); pb[2] = (short)(pk[4 * s2 + 1] & 0xffff); pb[3] = (short)(pk[4 * s2 + 1] >> 16);
                    pb[4] = (short)(pk[4 * s2 + 2] & 0xffff); pb[5] = (short)(pk[4 * s2 + 2] >> 16); pb[6] = (short)(pk[4 * s2 + 3] & 0xffff); pb[7] = (short)(pk[4 * s2 + 3] >> 16);
                    typedef short s16x4 __attribute__((ext_vector_type(4)));
                    s16x4 lo[4], hi4[4];
#pragma unroll
                    for (int db = 0; db < 4; ++db) { const int sw = (db ^ q4) * 64;
                        lo[db] = __builtin_bit_cast(s16x4, __builtin_amdgcn_ds_read_tr16_b64_v4i16((LAS s16x4*)(vb + (16 * s2) * 256 + sw)));
                        hi4[db] = __builtin_bit_cast(s16x4, __builtin_amdgcn_ds_read_tr16_b64_v4i16((LAS s16x4*)(vb + (16 * s2 + 8) * 256 + sw))); }
#pragma unroll
                    for (int db = 0; db < 4; ++db) {
                        s16x8 va; va[0] = lo[db][0]; va[1] = lo[db][1]; va[2] = lo[db][2]; va[3] = lo[db][3]; va[4] = hi4[db][0]; va[5] = hi4[db][1]; va[6] = hi4[db][2]; va[7] = hi4[db][3];
                        if (db == 0) o0 = __builtin_amdgcn_mfma_f32_32x32x16_bf16(va, pb, o0, 0, 0, 0);
                        else if (db == 1) o1 = __builtin_amdgcn_mfma_f32_32x32x16_bf16(va, pb, o1, 0, 0, 0);
                        else if (db == 2) o2 = __builtin_amdgcn_mfma_f32_32x32x16_bf16(va, pb, o2, 0, 0, 0);
                        else o3 = __builtin_amdgcn_mfma_f32_32x32x16_bf16(va, pb, o3, 0, 0, 0);
                    }
                }
            }
            if (glast) {
                if (br < 2) {
                    const int ql = (tq - s0) * 2 + hi;
                    pg8::u32x4* sp = (pg8::u32x4*)(stb + (size_t)ql * 64);
                    float2 ml; ml.x = m_run; ml.y = l_run; *(float2*)(mlb + ql * 2) = ml;
#define DIL_ST(O, DB) { pg8::u32x4 w0, w1; \
                        w0.x = pg8::cvt_pk_bf16(O[0], O[1]); w0.y = pg8::cvt_pk_bf16(O[2], O[3]); w0.z = pg8::cvt_pk_bf16(O[4], O[5]); w0.w = pg8::cvt_pk_bf16(O[6], O[7]); \
                        w1.x = pg8::cvt_pk_bf16(O[8], O[9]); w1.y = pg8::cvt_pk_bf16(O[10], O[11]); w1.z = pg8::cvt_pk_bf16(O[12], O[13]); w1.w = pg8::cvt_pk_bf16(O[14], O[15]); \
                        sp[2 * (DB)] = w0; sp[2 * (DB) + 1] = w1; }
                    DIL_ST(o0, 0) DIL_ST(o1, 1) DIL_ST(o2, 2) DIL_ST(o3, 3)
#undef DIL_ST
                } else {
                    const float l_tot = l_run + __shfl_xor(l_run, 32), inv = 1.f / l_tot;
                    bf16_t* orow = ob + ((size_t)(bh >> 4) * T + tq) * HW + h * HD + 4 * hi;
#pragma unroll
                    for (int g = 0; g < 4; ++g) {
                        pg8::u32x2 w;
                        w.x = pg8::cvt_pk_bf16(o0[4 * g] * inv, o0[4 * g + 1] * inv); w.y = pg8::cvt_pk_bf16(o0[4 * g + 2] * inv, o0[4 * g + 3] * inv); *(pg8::u32x2*)(orow + 0 + 8 * g) = w;
                        w.x = pg8::cvt_pk_bf16(o1[4 * g] * inv, o1[4 * g + 1] * inv); w.y = pg8::cvt_pk_bf16(o1[4 * g + 2] * inv, o1[4 * g + 3] * inv); *(pg8::u32x2*)(orow + 32 + 8 * g) = w;
                        w.x = pg8::cvt_pk_bf16(o2[4 * g] * inv, o2[4 * g + 1] * inv); w.y = pg8::cvt_pk_bf16(o2[4 * g + 2] * inv, o2[4 * g + 3] * inv); *(pg8::u32x2*)(orow + 64 + 8 * g) = w;
                        w.x = pg8::cvt_pk_bf16(o3[4 * g] * inv, o3[4 * g + 1] * inv); w.y = pg8::cvt_pk_bf16(o3[4 * g + 2] * inv, o3[4 * g + 3] * inv); *(pg8::u32x2*)(orow + 96 + 8 * g) = w;
                    }
                }
            }
            if (!more) break;
            asm volatile("s_waitcnt lgkmcnt(0)" ::: "memory");
            {
                const int ndl = 1 << (2 * nbr), nJ0 = -128 + 32 * nkt;
#pragma unroll
                for (int i = 0; i < 8; ++i) { int tv = ntb + (nJ0 + 4 * i + drow) * ndl; tv = tv < 0 ? 0 : tv;
                    __builtin_amdgcn_global_load_lds((const unsigned*)(vbase + (size_t)tv * HD + vc), (LAS unsigned*)(vbuf + i * 1024), 16, 0, 0); }
            }
            fresh = glast; br = nbr; gi = ngi; kt = nkt; tb = ntb;
        }
    }
    __syncthreads();
}

__device__ __forceinline__ void route_token(const float (&lgt)[16], const float* router_b, int& i1, int& i2, float& g1, float& g2) {
    float mx = lgt[0];
#pragma unroll
    for (int e = 1; e < 16; ++e) mx = fmaxf(mx, lgt[e]);
    float pr[16], sm = 0.f;
#pragma unroll
    for (int e = 0; e < 16; ++e) { pr[e] = __expf(lgt[e] - mx); sm += pr[e]; }
    const float inv = 1.f / sm;
    float sl[16];
#pragma unroll
    for (int e = 0; e < 16; ++e) { pr[e] *= inv; sl[e] = pr[e] + router_b[e]; }
    int bg = 0; float bgs = -__builtin_inff();
#pragma unroll
    for (int g = 0; g < NG; ++g) {
        const float a0 = sl[g * 4], a1 = sl[g * 4 + 1], a2 = sl[g * 4 + 2], a3 = sl[g * 4 + 3];
        const float h1 = fmaxf(a0, a1), l1 = fminf(a0, a1), h2 = fmaxf(a2, a3), l2 = fminf(a2, a3);
        const float gs = fmaxf(h1, h2) + fmaxf(fminf(h1, h2), fmaxf(l1, l2));
        const bool better = gs > bgs; bgs = better ? gs : bgs; bg = better ? g : bg;
    }
    float sg[4], pg[4];
#pragma unroll
    for (int i = 0; i < 4; ++i) { sg[i] = (bg == 0) ? sl[i] : (bg == 1) ? sl[4 + i] : (bg == 2) ? sl[8 + i] : sl[12 + i]; pg[i] = (bg == 0) ? pr[i] : (bg == 1) ? pr[4 + i] : (bg == 2) ? pr[8 + i] : pr[12 + i]; }
    int l1i = 0; float v1 = sg[0], p1 = pg[0];
#pragma unroll
    for (int i = 1; i < 4; ++i) { const bool b = sg[i] > v1; v1 = b ? sg[i] : v1; p1 = b ? pg[i] : p1; l1i = b ? i : l1i; }
    int l2i = 0; float v2 = -__builtin_inff(), p2 = 0.f;
#pragma unroll
    for (int i = 0; i < 4; ++i) { const bool b = (i != l1i) && (sg[i] > v2); v2 = b ? sg[i] : v2; p2 = b ? pg[i] : p2; l2i = b ? i : l2i; }
    i1 = bg * 4 + l1i; i2 = bg * 4 + l2i;
    const float gsum = p1 + p2; g1 = p1 / gsum; g2 = p2 / gsum;
}
__device__ __forceinline__ float reduce16(float (&v)[16], int lane) {
#pragma unroll
    for (int i = 0; i < 8; ++i) { const bool up = lane & 1; const float keep = up ? v[i + 8] : v[i], send = up ? v[i] : v[i + 8]; v[i] = keep + __shfl_xor(send, 1); }
#pragma unroll
    for (int i = 0; i < 4; ++i) { const bool up = lane & 2; const float keep = up ? v[i + 4] : v[i], send = up ? v[i] : v[i + 4]; v[i] = keep + __shfl_xor(send, 2); }
#pragma unroll
    for (int i = 0; i < 2; ++i) { const bool up = lane & 4; const float keep = up ? v[i + 2] : v[i], send = up ? v[i] : v[i + 2]; v[i] = keep + __shfl_xor(send, 4); }
    { const bool up = lane & 8; const float keep = up ? v[1] : v[0], send = up ? v[0] : v[1]; v[0] = keep + __shfl_xor(send, 8); }
    float r = v[0]; r += __shfl_xor(r, 16); r += __shfl_xor(r, 32); return r;
}
__device__ __forceinline__ void route_pair(float x, int lane, const float* router_b, int m, int* expid, float* gatew, int* lh) {
    const int E = lane & 15;
    float mx = x; mx = fmaxf(mx, __shfl_xor(mx, 1)); mx = fmaxf(mx, __shfl_xor(mx, 2)); mx = fmaxf(mx, __shfl_xor(mx, 4)); mx = fmaxf(mx, __shfl_xor(mx, 8));
    const float p = __expf(x - mx);
    float sm = p; sm += __shfl_xor(sm, 1); sm += __shfl_xor(sm, 2); sm += __shfl_xor(sm, 4); sm += __shfl_xor(sm, 8);
    const float pr = p * (1.f / sm), sl = pr + router_b[E];
    const float a = __shfl_xor(sl, 1), h1 = fmaxf(sl, a), l1 = fminf(sl, a), bh = __shfl_xor(h1, 2), bl = __shfl_xor(l1, 2);
    float gs = fmaxf(h1, bh) + fmaxf(fminf(h1, bh), fmaxf(l1, bl));
    int g = E >> 2;
    { const float og = __shfl_xor(gs, 4); const int oi = __shfl_xor(g, 4); const bool t = (og > gs) || (og == gs && oi < g); gs = t ? og : gs; g = t ? oi : g; }
    { const float og = __shfl_xor(gs, 8); const int oi = __shfl_xor(g, 8); const bool t = (og > gs) || (og == gs && oi < g); gs = t ? og : gs; g = t ? oi : g; }
    const bool inb = (E >> 2) == g;
    int rank = 0;
#pragma unroll
    for (int d = 1; d < 4; ++d) { const float os = __shfl_xor(sl, d); const int oe = E ^ d; rank += ((os > sl) || (os == sl && oe < E)) ? 1 : 0; }
    const unsigned long long b1 = __ballot(inb && rank == 0), b2 = __ballot(inb && rank == 1);
    const int pri = __float_as_int(pr);
#pragma unroll
    for (int q = 0; q < 2; ++q) {
        const int i1 = __builtin_ctz(((unsigned)(b1 >> (16 * q)) & 0xffffu) | 0x10000u), i2 = __builtin_ctz(((unsigned)(b2 >> (16 * q)) & 0xffffu) | 0x10000u);
        const float p1 = __int_as_float(__builtin_amdgcn_readlane(pri, 16 * q + (i1 & 15))), p2 = __int_as_float(__builtin_amdgcn_readlane(pri, 16 * q + (i2 & 15)));
        const float gsum = p1 + p2;
        if (lane == 0) { expid[(m + q) * 2] = i1 & 15; expid[(m + q) * 2 + 1] = i2 & 15; gatew[(m + q) * 2] = p1 / gsum; gatew[(m + q) * 2 + 1] = p2 / gsum; atomicAdd(&lh[i1 & 15], 1); atomicAdd(&lh[i2 & 15], 1); }
    }
}
__device__ __forceinline__ void ph_ln1_router(const float* g1, const float* b1, const float* router_w, const float* router_b, unsigned char* ws) {
    int tid_ = threadIdx.x; asm volatile("" : "+v"(tid_));
    const int tid = tid_, lane = tid & 63, wave = __builtin_amdgcn_readfirstlane(tid >> 6);
    LAS unsigned char* lds = (LAS unsigned char*)lds_raw;
    LAS float* stat = (LAS float*)(lds + 131072);
    LAS pg8::f32x4* dpart = (LAS pg8::f32x4*)(lds + 131072 + 1024);
    int* lh = (int*)((unsigned char*)lds_raw + LDS_MISC + 256);
    LAS float* gbl = (LAS float*)(lds + 147456);
    __syncthreads();
    { const float4 gv = *(const float4*)(g1 + 4 * tid), bv = *(const float4*)(b1 + 4 * tid);
      *(LAS pg8::f32x4*)(gbl + 4 * tid) = (pg8::f32x4){gv.x, gv.y, gv.z, gv.w}; *(LAS pg8::f32x4*)(gbl + 2048 + 4 * tid) = (pg8::f32x4){bv.x, bv.y, bv.z, bv.w}; }
    {
        float4 w0[8], w1[8];
#pragma unroll
        for (int q = 0; q < 8; ++q) { const int p = tid + NTHR * q, k = (p >> 2) * 2, e4 = (p & 3) * 4; w0[q] = *(const float4*)(router_w + k * 16 + e4); w1[q] = *(const float4*)(router_w + (k + 1) * 16 + e4); }
#pragma unroll
        for (int q = 0; q < 8; ++q) { const int p = tid + NTHR * q, k = (p >> 2) * 2, e4 = (p & 3) * 4, ks = k >> 5, gg = (k >> 3) & 3, j = k & 7;
            const float a[4] = {w0[q].x, w0[q].y, w0[q].z, w0[q].w}, b[4] = {w1[q].x, w1[q].y, w1[q].z, w1[q].w};
#pragma unroll
            for (int i = 0; i < 4; ++i) { const bf16_t ah = f2bf(a[i]), bh = f2bf(b[i]), al = f2bf(a[i] - bf2f(ah)), bl = f2bf(b[i] - bf2f(bh));
                const int off = ks * 1024 + (e4 + i + 16 * gg) * 16 + j * 2;
                *(LAS unsigned*)(lds + off) = (unsigned)ah | ((unsigned)bh << 16); *(LAS unsigned*)(lds + 65536 + off) = (unsigned)al | ((unsigned)bl << 16); } }
    }
    for (int c = blockIdx.x; c < NCHUNK; c += gridDim.x) {
        __syncthreads();
        if (tid < 16) lh[tid] = 0;
        const int tb = wave >> 1, kh = wave & 1, t = lane & 15, g = lane >> 4, tl = 16 * tb + t, m = c * CHUNK + tl;
        const bf16_t* xrow = XPRE + (size_t)m * D + kh * 1024 + 8 * g;
#define LN1_UNPACK(R, X) { X[0] = __uint_as_float(R.x << 16); X[1] = __uint_as_float(R.x & 0xffff0000u); X[2] = __uint_as_float(R.y << 16); X[3] = __uint_as_float(R.y & 0xffff0000u); \
                           X[4] = __uint_as_float(R.z << 16); X[5] = __uint_as_float(R.z & 0xffff0000u); X[6] = __uint_as_float(R.w << 16); X[7] = __uint_as_float(R.w & 0xffff0000u); }
        float s = 0.f, q2 = 0.f;
#pragma unroll 1
        for (int k16 = 0; k16 < 32; k16 += 16) {
            pg8::u32x4 raw[16];
#pragma unroll
            for (int i = 0; i < 16; ++i) raw[i] = *(const pg8::u32x4*)(xrow + 32 * (k16 + i));
#pragma unroll
            for (int i = 0; i < 16; ++i) { float x[8]; LN1_UNPACK(raw[i], x); s += ((x[0] + x[1]) + (x[2] + x[3])) + ((x[4] + x[5]) + (x[6] + x[7]));
#pragma unroll
                for (int j = 0; j < 8; ++j) q2 = fmaf(x[j], x[j], q2); }
        }
        s += __shfl_xor(s, 16); s += __shfl_xor(s, 32); q2 += __shfl_xor(q2, 16); q2 += __shfl_xor(q2, 32);
        if (g == 0) { stat[kh * 64 + tl] = s; stat[128 + kh * 64 + tl] = q2; }
        __syncthreads();
        const float mu = (stat[tl] + stat[64 + tl]) * (1.f / D);
        const float rstd = rsqrtf(fmaxf((stat[128 + tl] + stat[192 + tl]) * (1.f / D) - mu * mu, 0.f) + EPS);
        pg8::f32x4 acc = {0.f, 0.f, 0.f, 0.f};
        {
            const LAS float* gp = gbl + kh * 1024 + 8 * g; const LAS float* bp = gbl + 2048 + kh * 1024 + 8 * g;
            bf16_t* orow = XB + (size_t)m * D + kh * 1024 + 8 * g;
            const LAS unsigned char* wf = lds + (kh * 32) * 1024 + lane * 16;
            pg8::u32x4 rn[4];
#pragma unroll
            for (int i = 0; i < 4; ++i) rn[i] = *(const pg8::u32x4*)(xrow + 32 * i);
#pragma unroll 1
            for (int k4 = 0; k4 < 32; k4 += 4) {
                pg8::u32x4 raw[4];
#pragma unroll
                for (int i = 0; i < 4; ++i) raw[i] = rn[i];
                if (k4 + 4 < 32) {
#pragma unroll
                    for (int i = 0; i < 4; ++i) rn[i] = *(const pg8::u32x4*)(xrow + 32 * (k4 + 4 + i));
                }
#pragma unroll
                for (int i = 0; i < 4; ++i) {
                    const int ks = k4 + i;
                    float x[8]; LN1_UNPACK(raw[i], x);
                    const pg8::f32x4 ga = *(const LAS pg8::f32x4*)(gp + 32 * ks), gb = *(const LAS pg8::f32x4*)(gp + 32 * ks + 4), ba = *(const LAS pg8::f32x4*)(bp + 32 * ks), bb = *(const LAS pg8::f32x4*)(bp + 32 * ks + 4);
                    const float gm[8] = {ga[0], ga[1], ga[2], ga[3], gb[0], gb[1], gb[2], gb[3]}, bt[8] = {ba[0], ba[1], ba[2], ba[3], bb[0], bb[1], bb[2], bb[3]};
                    float y[8];
#pragma unroll
                    for (int j = 0; j < 8; ++j) y[j] = (x[j] - mu) * rstd * gm[j] + bt[j];
                    pg8::u32x4 hi, lo;
                    hi.x = pg8::cvt_pk_bf16(y[0], y[1]); hi.y = pg8::cvt_pk_bf16(y[2], y[3]); hi.z = pg8::cvt_pk_bf16(y[4], y[5]); hi.w = pg8::cvt_pk_bf16(y[6], y[7]);
                    *(pg8::u32x4*)(orow + 32 * ks) = hi;
                    lo.x = pg8::cvt_pk_bf16(y[0] - __uint_as_float(hi.x << 16), y[1] - __uint_as_float(hi.x & 0xffff0000u));
                    lo.y = pg8::cvt_pk_bf16(y[2] - __uint_as_float(hi.y << 16), y[3] - __uint_as_float(hi.y & 0xffff0000u));
                    lo.z = pg8::cvt_pk_bf16(y[4] - __uint_as_float(hi.z << 16), y[5] - __uint_as_float(hi.z & 0xffff0000u));
                    lo.w = pg8::cvt_pk_bf16(y[6] - __uint_as_float(hi.w << 16), y[7] - __uint_as_float(hi.w & 0xffff0000u));
                    const s16x8 wh = *(const LAS s16x8*)(wf + ks * 1024), wl = *(const LAS s16x8*)(wf + 65536 + ks * 1024);
                    const s16x8 yh = __builtin_bit_cast(s16x8, hi), yl = __builtin_bit_cast(s16x8, lo);
                    acc = __builtin_amdgcn_mfma_f32_16x16x32_bf16(wh, yh, acc, 0, 0, 0);
                    acc = __builtin_amdgcn_mfma_f32_16x16x32_bf16(wh, yl, acc, 0, 0, 0);
                    acc = __builtin_amdgcn_mfma_f32_16x16x32_bf16(wl, yh, acc, 0, 0, 0);
                }
            }
        }
#undef LN1_UNPACK
        if (kh == 1) dpart[tb * 64 + lane] = acc;
        __syncthreads();
        if (kh == 0) {
            const pg8::f32x4 o = dpart[tb * 64 + lane];
            const float x0 = acc[0] + o[0], x1 = acc[1] + o[1], x2 = acc[2] + o[2], x3 = acc[3] + o[3];
            float mx = fmaxf(fmaxf(x0, x1), fmaxf(x2, x3)); mx = fmaxf(mx, __shfl_xor(mx, 16)); mx = fmaxf(mx, __shfl_xor(mx, 32));
            const float p0 = __expf(x0 - mx), p1 = __expf(x1 - mx), p2 = __expf(x2 - mx), p3 = __expf(x3 - mx);
            float sm = (p0 + p1) + (p2 + p3); sm += __shfl_xor(sm, 16); sm += __shfl_xor(sm, 32);
            const float inv = 1.f / sm;
            const float pr[4] = {p0 * inv, p1 * inv, p2 * inv, p3 * inv};
            const float4 rb4 = *(const float4*)(router_b + 4 * g);
            const float sl[4] = {pr[0] + rb4.x, pr[1] + rb4.y, pr[2] + rb4.z, pr[3] + rb4.w};
            const float h1 = fmaxf(sl[0], sl[1]), l1 = fminf(sl[0], sl[1]), h2 = fmaxf(sl[2], sl[3]), l2 = fminf(sl[2], sl[3]);
            float bgs = fmaxf(h1, h2) + fmaxf(fminf(h1, h2), fmaxf(l1, l2));
            int bg = g;
            { const float og = __shfl_xor(bgs, 16); const int oi = __shfl_xor(bg, 16); const bool tk = (og > bgs) || (og == bgs && oi < bg); bgs = tk ? og : bgs; bg = tk ? oi : bg; }
            { const float og = __shfl_xor(bgs, 32); const int oi = __shfl_xor(bg, 32); const bool tk = (og > bgs) || (og == bgs && oi < bg); bgs = tk ? og : bgs; bg = tk ? oi : bg; }
            if (bg == g) {
                int l1i = 0; float v1 = sl[0], q1 = pr[0];
#pragma unroll
                for (int i = 1; i < 4; ++i) { const bool b = sl[i] > v1; v1 = b ? sl[i] : v1; q1 = b ? pr[i] : q1; l1i = b ? i : l1i; }
                int l2i = 0; float v2 = -__builtin_inff(), q2b = 0.f;
#pragma unroll
                for (int i = 0; i < 4; ++i) { const bool b = (i != l1i) && (sl[i] > v2); v2 = b ? sl[i] : v2; q2b = b ? pr[i] : q2b; l2i = b ? i : l2i; }
                const int i1 = 4 * g + l1i, i2 = 4 * g + l2i; const float gsum = q1 + q2b;
                EXPID[m * 2] = i1; EXPID[m * 2 + 1] = i2; GATEW[m * 2] = q1 / gsum; GATEW[m * 2 + 1] = q2b / gsum;
                atomicAdd(&lh[i1], 1); atomicAdd(&lh[i2], 1);
            }
        }
        __syncthreads();
        { int t3 = tid; asm volatile("" : "+v"(t3)); if (t3 < 16) HIST[c * 16 + t3] = lh[t3]; }
    }
}

__device__ __noinline__ void ph_route_pos(unsigned char* ws) {
    const int tid = threadIdx.x, lane = tid & 63, wave = tid >> 6, gw = blockIdx.x * NWAVES + wave, NGW = gridDim.x * NWAVES; float* ldsf = (float*)lds_raw;
    (void)lane; (void)wave; (void)gw; (void)NGW; (void)ldsf;
            int* hl = (int*)ldsf;
            int* tot = hl + NCHUNK * 16;
            int* seg = tot + 16;
            __syncthreads();
            for (int i = tid; i < NCHUNK * 16; i += NTHR) hl[i] = HIST[i];
            __syncthreads();
            if (tid < 16) { int run = 0; for (int c = 0; c < NCHUNK; ++c) { const int h = hl[c * 16 + tid]; hl[c * 16 + tid] = run; run += h; } tot[tid] = run; }
            __syncthreads();
            if (tid == 0) { int s = 0; for (int e = 0; e < 16; ++e) { seg[e] = s; s += (tot[e] + 255) & ~255; } seg[16] = s; }
            __syncthreads();
            for (int c = blockIdx.x; c < NCHUNK; c += gridDim.x) {
                if (wave == 0) {
                    const int m = c * CHUNK + lane;
                    const int e0 = EXPID[m * 2], e1 = EXPID[m * 2 + 1];
                    const unsigned long long lt = (1ull << lane) - 1ull;
                    int r0 = 0, r1 = 0;
                    for (int e = 0; e < 16; ++e) {
                        const unsigned long long m0 = __ballot(e0 == e), m1 = __ballot(e1 == e);
                        const int below = __popcll(m0 & lt) + __popcll(m1 & lt);
                        if (e0 == e) r0 = below;
                        if (e1 == e) r1 = below;
                    }
                    const int p0 = seg[e0] + hl[c * 16 + e0] + r0, p1 = seg[e1] + hl[c * 16 + e1] + r1;
                    POS[m * 2] = p0; POS[m * 2 + 1] = p1;
                    ROWTOK[p0] = m; ROWTOK[p1] = m; ROWGATE[p0] = GATEW[m * 2]; ROWGATE[p1] = GATEW[m * 2 + 1];
                }
            }
            if (blockIdx.x == 0) {
                for (int e = 0; e < 16; ++e) { for (int r = seg[e] + tot[e] + tid; r < seg[e + 1]; r += NTHR) { ROWTOK[r] = 0; ROWGATE[r] = 0.f; } }
                if (tid < 160) { int e = 0; const int row = tid * 256; for (int q = 0; q < 16; ++q) if (row >= seg[q]) e = q; TILEE[tid] = e; }
                __syncthreads();
                if (tid == 0) TILEE[159] = seg[16] / 256;
            }
}

__device__ __forceinline__ void ph_ln2(const float* g2, const float* b2, float* out, int last, unsigned char* ws) {
    int tid_ = threadIdx.x; asm volatile("" : "+v"(tid_));
    const int tid = tid_, lane = tid & 63, wave = tid >> 6, gw = blockIdx.x * NWAVES + wave, NGW = gridDim.x * NWAVES; float* ldsf = (float*)lds_raw;
    (void)lane; (void)wave; (void)gw; (void)NGW; (void)ldsf;
            int m = gw;
            if (m >= M) return;
            uint2 xr[8], y0[8], y1[8];
            int np0 = 0, np1 = 0;
            { const int p0 = POS[m * 2], p1 = POS[m * 2 + 1];
#pragma unroll
              for (int jj = 0; jj < 8; ++jj) { xr[jj] = *(const uint2*)(XB + (size_t)m * D + 4 * lane + 256 * jj); y0[jj] = *(const uint2*)(YS + (size_t)p0 * D + 4 * lane + 256 * jj); y1[jj] = *(const uint2*)(YS + (size_t)p1 * D + 4 * lane + 256 * jj); }
              if (m + NGW < M) { np0 = POS[(m + NGW) * 2]; np1 = POS[(m + NGW) * 2 + 1]; } }
#pragma unroll 1
            for (; m < M; m += NGW) {
                float4 v[8];
#pragma unroll
                for (int jj = 0; jj < 8; ++jj) {
                    v[jj].x = ALPHA * __uint_as_float(xr[jj].x << 16) + __uint_as_float(y0[jj].x << 16) + __uint_as_float(y1[jj].x << 16);
                    v[jj].y = ALPHA * __uint_as_float(xr[jj].x & 0xffff0000u) + __uint_as_float(y0[jj].x & 0xffff0000u) + __uint_as_float(y1[jj].x & 0xffff0000u);
                    v[jj].z = ALPHA * __uint_as_float(xr[jj].y << 16) + __uint_as_float(y0[jj].y << 16) + __uint_as_float(y1[jj].y << 16);
                    v[jj].w = ALPHA * __uint_as_float(xr[jj].y & 0xffff0000u) + __uint_as_float(y0[jj].y & 0xffff0000u) + __uint_as_float(y1[jj].y & 0xffff0000u);
                }
                const int mn = m + NGW;
                if (mn < M) {
                    const int p0 = np0, p1 = np1;
#pragma unroll
                    for (int jj = 0; jj < 8; ++jj) { xr[jj] = *(const uint2*)(XB + (size_t)mn * D + 4 * lane + 256 * jj); y0[jj] = *(const uint2*)(YS + (size_t)p0 * D + 4 * lane + 256 * jj); y1[jj] = *(const uint2*)(YS + (size_t)p1 * D + 4 * lane + 256 * jj); }
                    if (mn + NGW < M) { np0 = POS[(mn + NGW) * 2]; np1 = POS[(mn + NGW) * 2 + 1]; }
                }
                ln_row(v, g2, b2, lane);
                if (last) {
#pragma unroll
                    for (int jj = 0; jj < 8; ++jj) *(float4*)(out + (size_t)m * D + 4 * lane + 256 * jj) = v[jj];
                } else store_row_bf16(XB + (size_t)m * D, v, lane);
            }
}

__global__ void __launch_bounds__(NTHR, 2) mega_fwd(Args a) {
    const int tid0 = threadIdx.x;
    unsigned* ctl = (unsigned*)(a.ws + WS_CTL);
    volatile LAS unsigned* misc = (volatile LAS unsigned*)((LAS unsigned char*)lds_raw + LDS_MISC);
    if (tid0 < 64) misc[tid0] = 0u;
    __syncthreads();
#if MK_SINGLE
    XcdBarrier bar = xcd_barrier_post(ctl + 4096, misc + 8);
#define GRID_BAR() xcd_barrier(bar)
#else
    (void)ctl;
#define GRID_BAR() do { } while (0)
#endif
    const int lo = a.ph_lo, hi = a.ph_hi;
    for (int pc = lo; pc < hi; ++pc) {
        bool ran = true, is_gemm = false; int do_prep = 0;
        pg8::GemmDesc d{};
        const __attribute__((address_space(4))) Args* ap = (const __attribute__((address_space(4))) Args*)__builtin_amdgcn_kernarg_segment_ptr();
        asm volatile("" : "+s"(ap));
#define a (*ap)
        unsigned char* ws = ap->ws;
        if (pc == 0) ph_pre(a.x, a.rel_bias, ws);
        else {
            const int q = pc - 1, L = q / 14, s = q % 14, j = L >> 1; const bool dsa = (L & 1) == 0;
            switch (s) {
            case 0:
                if (L == 0) do_prep = 1; else if (dsa) ph_prep_dsa_fold(a.a_w_uq + (size_t)j * QL * HW, a.a_w_uk + (size_t)j * H * HD * KVL, W_Q(L), W_UV(L)); else ran = false;
                break;
            case 1: is_gemm = true;
                if (dsa) { d.A = XB; d.Bt = W_IN(L); d.K = D; d.lda2 = D * 2; d.ldb2 = D * 2; d.btile = (size_t)256 * D * 2; d.nM = M / 256; d.nN = 4; d.epi = pg8::EPI_F32; d.out = PRAW; d.ldc = 1024; }
                else     { d.A = XB; d.Bt = W_QKV(L); d.K = D; d.lda2 = D * 2; d.ldb2 = D * 2; d.btile = (size_t)256 * D * 2; d.nM = M / 256; d.nN = 3 * HW / 256; d.epi = pg8::EPI_QKVH; d.out = QKV; d.ldc = 3 * HW; }
                break;
            case 2: if (dsa) ph_dsa_norms(a.a_q_norm + (size_t)j * QL, a.a_kv_norm + (size_t)j * KVL, ws); else ran = false; break;
            case 3: if (dsa) { is_gemm = true; d.A = CQ; d.Bt = W_Q(L); d.K = QL; d.lda2 = QL * 2; d.ldb2 = QL * 2; d.btile = (size_t)256 * QL * 2; d.nM = M / 256; d.nN = QALD / 256; d.epi = pg8::EPI_BF16; d.out = QALL; d.ldc = QALD; d.pad = 1; }
                    else ran = false; break;
            case 4: if (dsa) ph_dsa_index(ws); else ran = false; break;
            case 5: if (dsa) ph_dsa_topk(ws); else ran = false; break;
            case 6: if (dsa) ph_dsa_attn(ws); else ph_dil_attn(ws); break;
            case 7: if (dsa) { is_gemm = true; d.A = OLAT; d.Bt = W_UV(L); d.K = 512; d.lda2 = 4096 * 2; d.acol2 = 512 * 2; d.ldb2 = 512 * 2; d.btile = (size_t)256 * 512 * 2; d.nM = M / 256; d.nN = HW / 256;
                               d.epi = pg8::EPI_BF16; d.out = OB; d.ldc = HW; }
                    else ran = false; break;
            case 8: is_gemm = true; d.A = OB; d.Bt = dsa ? W_O(L) : W_O_D(L); d.K = HW; d.lda2 = HW * 2; d.ldb2 = HW * 2; d.btile = (size_t)256 * HW * 2; d.nM = M / 256; d.nN = D / 256;
                    d.epi = pg8::EPI_RESID; d.out = XPRE; d.aux = XB; d.ldc = D; d.alpha = ALPHA; break;
            case 9: ph_ln1_router(a.ln1_g + (size_t)L * D, a.ln1_b + (size_t)L * D, a.router_w, a.router_b, ws); break;
            case 10: ph_route_pos(ws); break;
            case 11: is_gemm = true; d.A = XB; d.Bt = W_GU(L); d.K = D; d.lda2 = D * 2; d.ldb2 = D * 2; d.btile = (size_t)256 * D * 2; d.bexp = (size_t)1024 * D * 2; d.nM = __builtin_amdgcn_readfirstlane(ld_mut(TILEE + 159)); d.nN = 4;
                     d.rowtok = ROWTOK; d.tilee = TILEE; d.epi = pg8::EPI_SWIGLU; d.out = HID; d.aux = ROWGATE; d.ldc = DE; if (L + 1 < DEPTH) do_prep = 2; break;
            case 12: is_gemm = true; d.A = HID; d.Bt = W_DN(L); d.K = DE; d.lda2 = DE * 2; d.ldb2 = DE * 2; d.btile = (size_t)256 * DE * 2; d.bexp = (size_t)D * DE * 2; d.nM = __builtin_amdgcn_readfirstlane(ld_mut(TILEE + 159)); d.nN = D / 256;
                     d.tilee = TILEE; d.epi = pg8::EPI_BF16; d.out = YS; d.ldc = D; if (L + 1 < DEPTH) do_prep = 2; break;
            default: ph_ln2(a.ln2_g + (size_t)L * D, a.ln2_b + (size_t)L * D, a.out, L == DEPTH - 1 ? 1 : 0, ws); break;
            }
        }
#undef a
        if (is_gemm) pg8::gemm_run((PG8_LAS unsigned char*)lds_raw, d);
#define a (*ap)
        if (do_prep) {
            const int Lp = (do_prep == 1) ? 0 : (pc - 1) / 14 + 1, jp = Lp >> 1; const bool pdsa = (Lp & 1) == 0;
            unsigned* cnt = (do_prep == 1) ? nullptr : (unsigned*)(ap->ws + WS_CTL) + 8192 + 64 * Lp;
            int pend = -1, seg = 0;
            const float* wg = a.moe_w_gate + (size_t)Lp * NE * D * DE; const float* wu = a.moe_w_up + (size_t)Lp * NE * D * DE; const float* wd = a.moe_w_down + (size_t)Lp * NE * DE * D;
            pend = cvt_matrix(wg, (size_t)D * DE, NE, D, DE, DE, DE, W_GU(Lp), 1.f, 1024, 7, 256, 127, 0, D, 0, cnt, seg, pend); seg += 1024;
            pend = cvt_matrix(wu, (size_t)D * DE, NE, D, DE, DE, DE, W_GU(Lp), 1.f, 1024, 7, 256, 127, 128, D, 0, cnt, seg, pend); seg += 1024;
            pend = cvt_matrix(wd, (size_t)DE * D, NE, DE, D, D, D, W_DN(Lp), 1.f, D, 31, 0, 0x7fffffff, 0, DE, 0, cnt, seg, pend); seg += 1024;
            if (pdsa) {
                const float* w_in = a.a_w_in + (size_t)jp * D * AIN; const float* w_uqi = a.a_w_uq_idx + (size_t)jp * QL * IH * IDM; const float* w_uv = a.a_w_uv + (size_t)jp * H * KVL * HD; const float* w_o = a.a_w_o + (size_t)jp * HW * D;
                pend = cvt_matrix(w_in, 0, 1, D, 1024, AIN, AIN, W_IN(Lp), 1.f, 0, 31, 0, 0x7fffffff, 0, D, 0, cnt, seg, pend); seg += 128;
                pend = cvt_matrix(w_uqi, 0, 1, QL, IH * IDM, IH * IDM, IH * IDM, W_Q(Lp), 0.125f, 0, 31, 0, 0x7fffffff, 4096, QL, 0, cnt, seg, pend); seg += 32;
                pend = cvt_matrix(w_o, 0, 1, HW, D, D, D, W_O(Lp), 1.f, 0, 31, 0, 0x7fffffff, 0, HW, 0, cnt, seg, pend); seg += 256;
                pend = cvt_matrix(w_uv, (size_t)KVL * HD, H, KVL, HD, HD, HD, W_UV(Lp), 1.f, HD, 31, 0, 0x7fffffff, 0, 512, 256, cnt, seg, pend); seg += 32;
                if (do_prep == 1) ph_prep_dsa_fold(a.a_w_uq + (size_t)jp * QL * HW, a.a_w_uk + (size_t)jp * H * HD * KVL, W_Q(Lp), W_UV(Lp));
            } else {
                const float* w_in = a.b_w_in + (size_t)jp * D * 3 * HW; const float* w_o = a.b_w_o + (size_t)jp * HW * D;
                pend = cvt_matrix(w_in, 0, 1, D, HW, HW, 3 * HW, W_QKV(Lp), 0.12751743082459868f  , 0, 31, 0, 0x7fffffff, 0, D, 0, cnt, seg, pend); seg += 256;
                pend = cvt_matrix(w_in + HW, 0, 1, D, 2 * HW, 2 * HW, 3 * HW, W_QKV(Lp), 1.f, 0, 31, 0, 0x7fffffff, HW, D, 0, cnt, seg, pend); seg += 512;
                pend = cvt_matrix(w_o, 0, 1, HW, D, D, D, W_O_D(Lp), 1.f, 0, 31, 0, 0x7fffffff, 0, HW, 0, cnt, seg, pend); seg += 256;
            }
        }
#undef a
        bool skipbar = false;
        if (MK_SINGLE) { if (pc == 0) skipbar = true; else { const int q2 = pc - 1, L2_ = q2 / 14, s2 = q2 % 14; if (s2 == 13 && (L2_ & 1) == 1 && L2_ + 1 < DEPTH) skipbar = true; } }
        if (ran && !skipbar && pc + 1 < hi) GRID_BAR();
    }
}
constexpr int N_PHASES = 1 + DEPTH * 14;
}

extern "C" void kernel_launch(void* const* d_in, const int* in_sizes, int n_in, void* d_out, int out_size, void* d_ws, size_t ws_size, hipStream_t stream) {
    static int grid = 0;
    if (grid == 0) {
        if (n_in != 21 || in_sizes[0] != M * D || out_size != M * D || ws_size < WS_END) {
            fprintf(stderr, "kernel_launch: unexpected shapes: n_in %d in0 %d out %d ws %zu (need %zu)\n", n_in, n_in > 0 ? in_sizes[0] : -1, out_size, ws_size, (size_t)WS_END);
            grid = -1; return; }
        int dev = 0, cus = 0, per_cu = 0;
        if (hipGetDevice(&dev) != hipSuccess || hipDeviceGetAttribute(&cus, hipDeviceAttributeMultiprocessorCount, dev) != hipSuccess) { grid = -1; return; }
        if (hipFuncSetAttribute((const void*)mega_fwd, hipFuncAttributeMaxDynamicSharedMemorySize, LDS_BYTES) != hipSuccess) { fprintf(stderr, "kernel_launch: hipFuncSetAttribute failed\n"); grid = -1; return; }
        if (hipOccupancyMaxActiveBlocksPerMultiprocessor(&per_cu, (const void*)mega_fwd, NTHR, LDS_BYTES) != hipSuccess || per_cu < 1)
            fprintf(stderr, "kernel_launch: occupancy query reports %d workgroups per CU\n", per_cu);
        (void)hipGetLastError();
        grid = cus;
    }
    if (grid < 0) return;
    if (hipMemsetAsync((char*)d_ws + WS_CTL, 0, CTL_BYTES, stream) != hipSuccess) return;
    Args a{};
    a.x = (const float*)d_in[0]; a.rel_bias = (const float*)d_in[1]; a.router_w = (const float*)d_in[2]; a.router_b = (const float*)d_in[3];
    a.a_w_in = (const float*)d_in[4]; a.a_q_norm = (const float*)d_in[5]; a.a_kv_norm = (const float*)d_in[6]; a.a_w_uq = (const float*)d_in[7]; a.a_w_uq_idx = (const float*)d_in[8];
    a.a_w_uk = (const float*)d_in[9]; a.a_w_uv = (const float*)d_in[10]; a.a_w_o = (const float*)d_in[11]; a.b_w_in = (const float*)d_in[12]; a.b_w_o = (const float*)d_in[13];
    a.ln1_g = (const float*)d_in[14]; a.ln1_b = (const float*)d_in[15]; a.ln2_g = (const float*)d_in[16]; a.ln2_b = (const float*)d_in[17];
    a.moe_w_gate = (const float*)d_in[18]; a.moe_w_up = (const float*)d_in[19]; a.moe_w_down = (const float*)d_in[20];
    a.out = (float*)d_out; a.ws = (unsigned char*)d_ws;
#if MK_SINGLE
    a.ph_lo = 0; a.ph_hi = N_PHASES;
    hipLaunchKernelGGL(mega_fwd, dim3(grid), dim3(NTHR), LDS_BYTES, stream, a);
#else
    for (int p = 0; p < N_PHASES; ++p) { a.ph_lo = p; a.ph_hi = p + 1; hipLaunchKernelGGL(mega_fwd, dim3(grid), dim3(NTHR), LDS_BYTES, stream, a); }
#endif
}
```

```cpp
#include <hip/hip_runtime.h>
#include <cstdio>
#include <cstdint>

#ifndef MK_SINGLE
#define MK_SINGLE 1
#endif

namespace {
constexpr int D = 2048, NB_ = 4, T = 4096, DEPTH = 4, M = NB_ * T;
constexpr int H = 16, HD = 128, HW = H * HD, QL = 512, KVL = 256, IH = 16, IDM = 64, TOPK = 256;
constexpr int AIN = QL + KVL + IDM + IH;
constexpr int NBUCK = 32, NE = 16, NG = 4, EPG = 4, DE = 512;
constexpr float ALPHA = 1.6817928305074292f;
constexpr float EPS = 1e-5f;
constexpr int NTHR = 512, NWAVES = 8;
constexpr int RMAX = 36864;
constexpr int NCHUNK = 256, CHUNK = M / NCHUNK;

constexpr size_t MiB = 1u << 20;
constexpr size_t WS_CTL = 0, CTL_BYTES = 1 * MiB;
constexpr size_t WS_BIAS = 1 * MiB;
constexpr size_t WS_EXPID = 2 * MiB;
constexpr size_t WS_GATEW = WS_EXPID + (size_t)M * 2 * 4;
constexpr size_t WS_POS = WS_GATEW + (size_t)M * 2 * 4;
constexpr size_t WS_ROWTOK = WS_POS + (size_t)M * 2 * 4;
constexpr size_t WS_ROWGATE = WS_ROWTOK + (size_t)RMAX * 4;
constexpr size_t WS_HIST = WS_ROWGATE + (size_t)RMAX * 4;
constexpr size_t WS_TILEE = WS_HIST + (size_t)NCHUNK * 16 * 4;
constexpr size_t WS_NSEL = WS_TILEE + 1024;
constexpr size_t WS_XB = 8 * MiB;
constexpr size_t WS_XPRE = 72 * MiB;
constexpr size_t WS_WL = 200 * MiB;
constexpr size_t WL_STRIDE = 128 * MiB;
constexpr size_t WS_AR = 456 * MiB;
constexpr int QALD = 5120;
constexpr size_t WS_END = 906 * MiB;
constexpr size_t AR_PRAW = WS_AR;
constexpr size_t AR_CQ = WS_AR + 64 * MiB;
constexpr size_t AR_CKV = WS_AR + 80 * MiB;
constexpr size_t AR_KIDX = WS_AR + 88 * MiB;
constexpr size_t AR_WIDX = WS_AR + 90 * MiB;
constexpr size_t AR_SEL = WS_AR + 92 * MiB;
constexpr size_t AR_QALL = WS_AR + 108 * MiB;
constexpr size_t AR_SC = WS_AR + 268 * MiB;
constexpr size_t AR_OLAT = WS_AR + 268 * MiB;
constexpr size_t AR_OB = WS_AR + 0 * MiB;
constexpr size_t AR_QKV = WS_AR + 100 * MiB;
constexpr size_t AR_DST = WS_AR + 300 * MiB;
constexpr size_t AR_DML = WS_AR + 336 * MiB;
constexpr size_t AR_HID = WS_AR + 0 * MiB;
constexpr size_t AR_YS = WS_AR + 40 * MiB;
constexpr size_t SC_PER_B = (size_t)1024 * 128 * 129 / 2;
static_assert(AR_SC + 4 * SC_PER_B * 4 <= WS_END, "arena");
static_assert(AR_YS + (size_t)RMAX * D * 2 <= WS_END, "arena");
constexpr size_t WL_GU = WS_WL;
constexpr size_t WL_DN = WS_WL + 64 * MiB;
constexpr size_t WL_MIX = WS_WL + 96 * MiB;
constexpr size_t WL_WIN = WL_MIX;
constexpr size_t WL_WQ = WL_MIX + 4 * MiB;
constexpr size_t WL_WUV = WL_MIX + 10 * MiB;
constexpr size_t WL_WO = WL_MIX + 12 * MiB;
constexpr size_t WL_WQKV = WL_MIX + 0 * MiB;
constexpr size_t WL_WO_D = WL_MIX + 24 * MiB;
static_assert(WL_WO_D + 8 * MiB <= WS_WL + WL_STRIDE && WS_WL + 2 * WL_STRIDE <= WS_AR, "weight scratch");

constexpr int LDS_BYTES = 163840;
constexpr int LDS_MISC = 143360;

typedef unsigned short bf16_t;
#define LAS __attribute__((address_space(3)))

__device__ __forceinline__ float bf2f(bf16_t v) { return __uint_as_float(((unsigned)v) << 16); }
__device__ __forceinline__ bf16_t f2bf(float f) { unsigned u = __float_as_uint(f); u += 0x7fffu + ((u >> 16) & 1u); return (bf16_t)(u >> 16); }
__device__ __forceinline__ float wave_sum(float v) {
#pragma unroll
    for (int o = 1; o < 64; o <<= 1) v += __shfl_xor(v, o);
    return v;
}
__device__ __forceinline__ int wave_sum_i(int v) {
#pragma unroll
    for (int o = 1; o < 64; o <<= 1) v += __shfl_xor(v, o);
    return v;
}
__device__ __forceinline__ float wave_max(float v) {
#pragma unroll
    for (int o = 1; o < 64; o <<= 1) v = fmaxf(v, __shfl_xor(v, o));
    return v;
}
__device__ __forceinline__ float wave_min(float v) {
#pragma unroll
    for (int o = 1; o < 64; o <<= 1) v = fminf(v, __shfl_xor(v, o));
    return v;
}
__device__ __forceinline__ int wave_min_i(int v) {
#pragma unroll
    for (int o = 1; o < 64; o <<= 1) { int t = __shfl_xor(v, o); v = t < v ? t : v; }
    return v;
}

__device__ __forceinline__ int wave_scan_dpp(int x) {
    x += __builtin_amdgcn_update_dpp(0, x, 0x111, 0xf, 0xf, false);
    x += __builtin_amdgcn_update_dpp(0, x, 0x112, 0xf, 0xf, false);
    x += __builtin_amdgcn_update_dpp(0, x, 0x114, 0xf, 0xf, false);
    x += __builtin_amdgcn_update_dpp(0, x, 0x118, 0xf, 0xf, false);
    x += __builtin_amdgcn_update_dpp(0, x, 0x142, 0xa, 0xf, false);
    x += __builtin_amdgcn_update_dpp(0, x, 0x143, 0xc, 0xf, false);
    return x;
}
__device__ __forceinline__ float wave_max_dpp(float v) {
    const int ninf = __float_as_int(-__builtin_inff());
#define WMX(ctrl, rm) v = fmaxf(v, __int_as_float(__builtin_amdgcn_update_dpp(ninf, __float_as_int(v), ctrl, rm, 0xf, false)))
    WMX(0x111, 0xf); WMX(0x112, 0xf); WMX(0x114, 0xf); WMX(0x118, 0xf); WMX(0x142, 0xa); WMX(0x143, 0xc);
#undef WMX
    return __int_as_float(__builtin_amdgcn_readlane(__float_as_int(v), 63));
}
__device__ __forceinline__ float wave_min_dpp(float v) {
    const int pinf = __float_as_int(__builtin_inff());
#define WMN(ctrl, rm) v = fminf(v, __int_as_float(__builtin_amdgcn_update_dpp(pinf, __float_as_int(v), ctrl, rm, 0xf, false)))
    WMN(0x111, 0xf); WMN(0x112, 0xf); WMN(0x114, 0xf); WMN(0x118, 0xf); WMN(0x142, 0xa); WMN(0x143, 0xc);
#undef WMN
    return __int_as_float(__builtin_amdgcn_readlane(__float_as_int(v), 63));
}
__device__ __forceinline__ int wave_sum_dpp(int x) {
    x += __builtin_amdgcn_update_dpp(0, x, 0x111, 0xf, 0xf, false);
    x += __builtin_amdgcn_update_dpp(0, x, 0x112, 0xf, 0xf, false);
    x += __builtin_amdgcn_update_dpp(0, x, 0x114, 0xf, 0xf, false);
    x += __builtin_amdgcn_update_dpp(0, x, 0x118, 0xf, 0xf, false);
    x += __builtin_amdgcn_update_dpp(0, x, 0x142, 0xa, 0xf, false);
    x += __builtin_amdgcn_update_dpp(0, x, 0x143, 0xc, 0xf, false);
    return __builtin_amdgcn_readlane(x, 63);
}
__device__ __forceinline__ int ld_mut(const int* p) { return __hip_atomic_load(p, __ATOMIC_RELAXED, __HIP_MEMORY_SCOPE_AGENT); }

#define XB_TMO      128
#define XB_XCNT(j)  (256  + 64 * (j))
#define XB_XSUB(j)  (1280 + 64 * (j))
#define XB_XGEN(j)  (2304 + 64 * (j))
#define XB_TOP      3328
#define XB_TOPGEN   3392
#define XCD_BAR_WORDS 3456
#define XB_SPIN_CAP (1u << 18)

__device__ __forceinline__ unsigned xb_ld(unsigned* p)              { return __hip_atomic_load(p, __ATOMIC_RELAXED, __HIP_MEMORY_SCOPE_AGENT); }
__device__ __forceinline__ unsigned xb_add(unsigned* p, unsigned v) { return __hip_atomic_fetch_add(p, v, __ATOMIC_RELAXED, __HIP_MEMORY_SCOPE_AGENT); }
__device__ __forceinline__ unsigned xb_xcc_id() { return (unsigned)__builtin_amdgcn_s_getreg((3 << 11) | 20) & 0xFu; }
#define XB_SPIN(cond, bar) do { unsigned _sp = 0; while (cond) { __builtin_amdgcn_s_sleep(1); \
    if ((++_sp & 255u) == 0u) { if (xb_ld(&(bar)[XB_TMO])) break; if (_sp > XB_SPIN_CAP) { atomicAdd(&(bar)[XB_TMO], 1u); break; } } } } while (0)

struct XcdBarrier {
    unsigned* bar; unsigned x;
    volatile LAS unsigned* st;
};
__device__ __forceinline__ XcdBarrier xcd_barrier_post(unsigned* bar, volatile LAS unsigned* st) {
    XcdBarrier b; b.bar = bar; b.x = xb_xcc_id(); b.st = st;
    if (threadIdx.x == 0) (void)xb_add(&bar[XB_XCNT(b.x)], 1u);
    return b;
}
__device__ __forceinline__ void xcd_barrier_complete(unsigned* bar, unsigned x, unsigned& nloc, unsigned& nx) {
    const unsigned G = gridDim.x * gridDim.y * gridDim.z;
    unsigned sum, cnt, mine, sp = 0u;
    for (;;) {
        sum = 0u; cnt = 0u; mine = 0u;
#pragma unroll
        for (unsigned j = 0; j < 16; ++j) { const unsigned c = xb_ld(&bar[XB_XCNT(j)]); sum += c; cnt += (c > 0u) ? 1u : 0u; mine = (j == x) ? c : mine; }
        if (sum == G) break;
        __builtin_amdgcn_s_sleep(1);
        if ((++sp & 255u) == 0u) { if (xb_ld(&bar[XB_TMO])) break; if (sp > XB_SPIN_CAP) { atomicAdd(&bar[XB_TMO], 1u); break; } }
    }
    nloc = mine > 0u ? mine : 1u; nx = cnt > 0u ? cnt : 1u;
}
__device__ __forceinline__ void xcd_barrier(const XcdBarrier& b) {
    asm volatile("s_waitcnt vmcnt(0)" ::: "memory");
    __syncthreads();
    if (threadIdx.x == 0) {
        unsigned* bar = b.bar;
        __builtin_amdgcn_s_waitcnt(0);
        unsigned nloc = b.st[0], nx = b.st[1];
        if (nloc == 0u) { xcd_barrier_complete(bar, b.x, nloc, nx); b.st[0] = nloc; b.st[1] = nx; }
        const unsigned old = xb_add(&bar[XB_XSUB(b.x)], 1u);
        const unsigned gen = old / nloc;
        if (old + 1u == (gen + 1u) * nloc) {
            __builtin_amdgcn_fence(__ATOMIC_RELEASE, "agent");
            asm volatile("s_waitcnt vmcnt(0)" ::: "memory");
            const unsigned og = xb_add(&bar[XB_TOP], 1u);
            const unsigned tg = og / nx;
            if (og + 1u == (tg + 1u) * nx) xb_add(&bar[XB_TOPGEN], 1u);
            else XB_SPIN(xb_ld(&bar[XB_TOPGEN]) == tg, bar);
            __builtin_amdgcn_fence(__ATOMIC_ACQUIRE, "agent");
            xb_add(&bar[XB_XGEN(b.x)], 1u);
            asm volatile("s_waitcnt vmcnt(0)" ::: "memory");
        } else {
            XB_SPIN(xb_ld(&bar[XB_XGEN(b.x)]) == gen, bar);
            __builtin_amdgcn_fence(__ATOMIC_ACQUIRE, "agent");
            asm volatile("s_waitcnt vmcnt(0)" ::: "memory");
        }
    }
    __syncthreads();
}

template <class AF, class BF, class EF>
__device__ __forceinline__ void gemm_naive(float* lds, int nbatch, int Mr, int N, int K, AF af, BF bf, EF ef) {
    float* As = lds; float* Bs = lds + 16 * 132;
    const int tid = threadIdx.x, ty = tid >> 4, tx = tid & 15;
    const int tm = Mr / 128, tn = (N + 63) / 64, per = tm * tn, total = per * nbatch;
    for (int u = blockIdx.x; u < total; u += gridDim.x) {
        const int bi = u / per, rr = u % per, m0 = (rr / tn) * 128, n0 = (rr % tn) * 64;
        float acc[4][4];
#pragma unroll
        for (int i = 0; i < 4; ++i)
#pragma unroll
            for (int j = 0; j < 4; ++j) acc[i][j] = 0.f;
        for (int k0 = 0; k0 < K; k0 += 16) {
            __syncthreads();
#pragma unroll
            for (int i = 0; i < 4; ++i) { const int e = tid + 512 * i, row = e >> 4, kk = e & 15; As[kk * 132 + row] = af(bi, m0 + row, k0 + kk); }
#pragma unroll
            for (int i = 0; i < 2; ++i) { const int e = tid + 512 * i, kk = e >> 6, n = e & 63; Bs[kk * 68 + n] = (n0 + n < N) ? bf(bi, k0 + kk, n0 + n) : 0.f; }
            __syncthreads();
#pragma unroll
            for (int kk = 0; kk < 16; ++kk) {
                const float4 a = *(const float4*)(As + kk * 132 + ty * 4);
                const float4 b = *(const float4*)(Bs + kk * 68 + tx * 4);
                const float av[4] = {a.x, a.y, a.z, a.w}, bv[4] = {b.x, b.y, b.z, b.w};
#pragma unroll
                for (int i = 0; i < 4; ++i)
#pragma unroll
                    for (int j = 0; j < 4; ++j) acc[i][j] = fmaf(av[i], bv[j], acc[i][j]);
            }
        }
#pragma unroll
        for (int i = 0; i < 4; ++i)
#pragma unroll
            for (int j = 0; j < 4; ++j) { const int n = n0 + tx * 4 + j; if (n < N) ef(bi, m0 + ty * 4 + i, n, acc[i][j]); }
    }
    __syncthreads();
}

__device__ __forceinline__ int t5_bucket(int n) {
    if (n < 16) return n;
    const float nf = (float)n;
    int large = 16 + (int)(logf(nf / 16.0f) / 4.852030263919617f * 16.0f);
    return large < 31 ? large : 31;
}
__device__ __forceinline__ size_t sc_off(int b, int t) { const int qb = t >> 5; return (size_t)b * SC_PER_B + (size_t)512 * qb * (qb + 1) + (size_t)(t & 31) * (32 * (qb + 1)); }

struct Args {
    const float* x; const float* rel_bias; const float* router_w; const float* router_b;
    const float* a_w_in; const float* a_q_norm; const float* a_kv_norm; const float* a_w_uq; const float* a_w_uq_idx;
    const float* a_w_uk; const float* a_w_uv; const float* a_w_o; const float* b_w_in; const float* b_w_o;
    const float* ln1_g; const float* ln1_b; const float* ln2_g; const float* ln2_b;
    const float* moe_w_gate; const float* moe_w_up; const float* moe_w_down;
    float* out; unsigned char* ws; int ph_lo, ph_hi;
};

template <class V4>
__device__ __forceinline__ void ln_row(V4 (&v)[8], const float* g, const float* bta, int lane) {
    float s = 0.f;
#pragma unroll
    for (int j = 0; j < 8; ++j) s += (v[j].x + v[j].y) + (v[j].z + v[j].w);
    const float mu = wave_sum(s) * (1.f / D);
    float q = 0.f;
#pragma unroll
    for (int j = 0; j < 8; ++j) { v[j].x -= mu; v[j].y -= mu; v[j].z -= mu; v[j].w -= mu; q += (v[j].x * v[j].x + v[j].y * v[j].y) + (v[j].z * v[j].z + v[j].w * v[j].w); }
    const float rstd = rsqrtf(wave_sum(q) * (1.f / D) + EPS);
#pragma unroll
    for (int j = 0; j < 8; ++j) {
        const float4 gg = *(const float4*)(g + 4 * lane + 256 * j), bb = *(const float4*)(bta + 4 * lane + 256 * j);
        v[j].x = v[j].x * rstd * gg.x + bb.x; v[j].y = v[j].y * rstd * gg.y + bb.y; v[j].z = v[j].z * rstd * gg.z + bb.z; v[j].w = v[j].w * rstd * gg.w + bb.w;
        if (j == 3) asm volatile("" ::: "memory");
    }
}
template <class V4>
__device__ __forceinline__ void store_row_bf16(bf16_t* dst, const V4 (&v)[8], int lane) {
#pragma unroll
    for (int j = 0; j < 8; ++j) {
        uint2 o; o.x = (unsigned)f2bf(v[j].x) | ((unsigned)f2bf(v[j].y) << 16); o.y = (unsigned)f2bf(v[j].z) | ((unsigned)f2bf(v[j].w) << 16);
        *(uint2*)(dst + 4 * lane + 256 * j) = o;
    }
}

extern __shared__ __attribute__((aligned(16))) unsigned char lds_raw[];
#define BIAS_T ((float*)(ws + WS_BIAS))
#define EXPID ((int*)(ws + WS_EXPID))
#define GATEW ((float*)(ws + WS_GATEW))
#define POS ((int*)(ws + WS_POS))
#define ROWTOK ((int*)(ws + WS_ROWTOK))
#define ROWGATE ((float*)(ws + WS_ROWGATE))
#define HIST ((int*)(ws + WS_HIST))
#define TILEE ((int*)(ws + WS_TILEE))
#define NSEL ((int*)(ws + WS_NSEL))
#define XB ((bf16_t*)(ws + WS_XB))
#define XPRE ((bf16_t*)(ws + WS_XPRE))
#define PRAW ((float*)(ws + AR_PRAW))
#define CQ ((bf16_t*)(ws + AR_CQ))
#define CKV ((bf16_t*)(ws + AR_CKV))
#define KIDX ((bf16_t*)(ws + AR_KIDX))
#define WIDX ((float*)(ws + AR_WIDX))
#define SEL ((int*)(ws + AR_SEL))
#define QALL ((bf16_t*)(ws + AR_QALL))
#define SC ((float*)(ws + AR_SC))
#define OLAT ((bf16_t*)(ws + AR_OLAT))
#define OB ((bf16_t*)(ws + AR_OB))
#define QKV ((bf16_t*)(ws + AR_QKV))
#define HID ((bf16_t*)(ws + AR_HID))
#define YS ((bf16_t*)(ws + AR_YS))
#define W_GU(L) ((bf16_t*)(ws + WL_GU + (size_t)((L) & 1) * WL_STRIDE))
#define W_DN(L) ((bf16_t*)(ws + WL_DN + (size_t)((L) & 1) * WL_STRIDE))
#define W_IN(L) ((bf16_t*)(ws + WL_WIN + (size_t)((L) & 1) * WL_STRIDE))
#define W_Q(L) ((bf16_t*)(ws + WL_WQ + (size_t)((L) & 1) * WL_STRIDE))
#define W_UV(L) ((bf16_t*)(ws + WL_WUV + (size_t)((L) & 1) * WL_STRIDE))
#define W_O(L) ((bf16_t*)(ws + WL_WO + (size_t)((L) & 1) * WL_STRIDE))
#define W_QKV(L) ((bf16_t*)(ws + WL_WQKV + (size_t)((L) & 1) * WL_STRIDE))
#define W_O_D(L) ((bf16_t*)(ws + WL_WO_D + (size_t)((L) & 1) * WL_STRIDE))

namespace pg8 {
#define PG8_LAS __attribute__((address_space(3)))
typedef short bf16x8 __attribute__((ext_vector_type(8)));
typedef float f32x4 __attribute__((ext_vector_type(4)));
typedef unsigned u32x4 __attribute__((ext_vector_type(4)));
typedef unsigned u32x2 __attribute__((ext_vector_type(2)));
constexpr int BM = 256, BK = 64, HALF = 128, HTB = HALF * BK * 2  , STAGE_BYTES = 8 * HTB, NXCD = 8, WGM = 8;

__device__ __forceinline__ int lds_byte(int r, int c) { const int st = (r >> 4) * 2 + (c >> 5), rr = r & 15, cc = c & 31, ob = rr * 64 + cc * 2; return st * 1024 + (ob ^ (((ob >> 9) & 1) << 5)); }
__device__ __forceinline__ void stage_rc(int b, int& R, int& C) { const int st = b / 1024, sb = b % 1024, swz = sb ^ (((sb >> 9) & 1) << 5); R = (st >> 1) * 16 + swz / 64; C = (st & 1) * 32 + (swz % 64) / 2; }
__device__ __forceinline__ int perm32(int rho) { const int n = rho >> 4, i = rho & 15; return 8 * (i >> 2) + 4 * n + (i & 3); }

struct Unit { int pm, pn; };
enum { EPI_F32 = 0, EPI_RESID = 1, EPI_BF16 = 2, EPI_SWIGLU = 3, EPI_QKVH = 4 };
struct GemmDesc {
    const bf16_t* A; const bf16_t* Bt; const int* rowtok; const int* tilee; void* out; const void* aux;
    size_t btile, bexp; unsigned lda2, acol2, ldb2; int K, nM, nN, epi, ldc; float alpha; int pad;
};
struct Order {
    int nM, nN, nwg, G, c;
    __device__ __forceinline__ bool next(int i, Unit& u) const {
        const long L = (long)i * G + c; if (L >= nwg) return false;
        int wgid = (int)L; { const int q = nwg / NXCD, r = nwg % NXCD, xcd = wgid % NXCD, off = wgid / NXCD; wgid = (xcd < r ? xcd * (q + 1) : r * (q + 1) + (xcd - r) * q) + off; }
        const int nig = WGM * nN, gid = wgid / nig, fm = gid * WGM, gsz = (nM - fm) < WGM ? (nM - fm) : WGM;
        u.pm = fm + ((wgid % nig) % gsz); u.pn = (wgid % nig) / gsz; return true;
    }
};
__device__ __forceinline__ unsigned arow_off(const GemmDesc& d, const Unit& u, int r) { const int row = u.pm * BM + r; return (unsigned)(d.rowtok ? d.rowtok[row] : row) * d.lda2 + (unsigned)u.pn * d.acol2; }
__device__ __forceinline__ const char* bptr(const GemmDesc& d, const Unit& u) { return (const char*)d.Bt + (d.tilee ? (size_t)__builtin_amdgcn_readfirstlane(ld_mut(d.tilee + u.pm)) * d.bexp : (size_t)0) + (size_t)u.pn * d.btile; }

__device__ __forceinline__ unsigned cvt_pk_bf16(float lo, float hi) { unsigned r; asm volatile("v_cvt_pk_bf16_f32 %0, %1, %2" : "=v"(r) : "v"(lo), "v"(hi)); return r; }

__device__ __forceinline__ void epi_f32(const f32x4 (&acc)[2][2][4][2], const Unit& u, int wr, int wc, int fr, int fq, float* C, int ldc) {
    const int row0 = u.pm * BM + wr * 64 + fr, col0 = u.pn * BM + wc * 32 + 4 * fq;
#pragma unroll
    for (int ai = 0; ai < 2; ++ai)
#pragma unroll
        for (int m = 0; m < 4; ++m) { float* rowp = C + (size_t)(row0 + ai * HALF + m * 16) * ldc + col0;
#pragma unroll
            for (int bj = 0; bj < 2; ++bj)
#pragma unroll
                for (int n = 0; n < 2; ++n) *(f32x4*)(rowp + bj * HALF + n * 16) = acc[ai][bj][m][n]; }
}
__device__ __forceinline__ void epi_resid(const f32x4 (&acc)[2][2][4][2], const Unit& u, int wr, int wc, int fr, int fq, bf16_t* C, const bf16_t* X, int ldc, float alpha) {
    const int row0 = u.pm * BM + wr * 64 + fr, col0 = u.pn * BM + wc * 32 + 8 * fq;
#pragma unroll
    for (int ai = 0; ai < 2; ++ai)
#pragma unroll
        for (int m = 0; m < 4; ++m) { const size_t ro = (size_t)(row0 + ai * HALF + m * 16) * ldc + col0;
#pragma unroll
            for (int bj = 0; bj < 2; ++bj) { const u32x4 xr = *(const u32x4*)(X + ro + bj * HALF); const f32x4 a0 = acc[ai][bj][m][0], a1 = acc[ai][bj][m][1];
                u32x4 w;
                w.x = cvt_pk_bf16(alpha * __uint_as_float(xr.x << 16) + a0[0], alpha * __uint_as_float(xr.x & 0xffff0000u) + a0[1]);
                w.y = cvt_pk_bf16(alpha * __uint_as_float(xr.y << 16) + a0[2], alpha * __uint_as_float(xr.y & 0xffff0000u) + a0[3]);
                w.z = cvt_pk_bf16(alpha * __uint_as_float(xr.z << 16) + a1[0], alpha * __uint_as_float(xr.z & 0xffff0000u) + a1[1]);
                w.w = cvt_pk_bf16(alpha * __uint_as_float(xr.w << 16) + a1[2], alpha * __uint_as_float(xr.w & 0xffff0000u) + a1[3]);
                *(u32x4*)(C + ro + bj * HALF) = w; } }
}
__device__ __forceinline__ void epi_bf16(const f32x4 (&acc)[2][2][4][2], const Unit& u, int wr, int wc, int fr, int fq, bf16_t* O, int ldc) {
    const int row0 = u.pm * BM + wr * 64 + fr, col0 = u.pn * BM + wc * 32 + 8 * fq;
#pragma unroll
    for (int ai = 0; ai < 2; ++ai)
#pragma unroll
        for (int m = 0; m < 4; ++m) { bf16_t* rowp = O + (size_t)(row0 + ai * HALF + m * 16) * ldc + col0;
#pragma unroll
            for (int bj = 0; bj < 2; ++bj) { const f32x4 v0 = acc[ai][bj][m][0], v1 = acc[ai][bj][m][1];
                u32x4 w; w.x = cvt_pk_bf16(v0[0], v0[1]); w.y = cvt_pk_bf16(v0[2], v0[3]); w.z = cvt_pk_bf16(v1[0], v1[1]); w.w = cvt_pk_bf16(v1[2], v1[3]);
                *(u32x4*)(rowp + bj * HALF) = w; } }
}
__device__ __forceinline__ void epi_swiglu(const f32x4 (&acc)[2][2][4][2], const Unit& u, int wr, int wc, int fr, int fq, bf16_t* Hd, const float* rowgate) {
    const int row0 = u.pm * BM + wr * 64 + fr, col0 = u.pn * HALF + wc * 32 + 8 * fq;
#pragma unroll
    for (int ai = 0; ai < 2; ++ai)
#pragma unroll
        for (int m = 0; m < 4; ++m) { const int row = row0 + ai * HALF + m * 16; const float gw = rowgate[row];
            float h[8];
#pragma unroll
            for (int n = 0; n < 2; ++n)
#pragma unroll
                for (int e = 0; e < 4; ++e) { const float g = acc[ai][0][m][n][e], uu = acc[ai][1][m][n][e]; h[n * 4 + e] = g / (1.f + __expf(-g)) * uu * gw; }
            u32x4 w; w.x = cvt_pk_bf16(h[0], h[1]); w.y = cvt_pk_bf16(h[2], h[3]); w.z = cvt_pk_bf16(h[4], h[5]); w.w = cvt_pk_bf16(h[6], h[7]);
            *(u32x4*)(Hd + (size_t)row * 512 + col0) = w; }
}
__device__ __forceinline__ void epi_qkvh(const f32x4 (&acc)[2][2][4][2], const Unit& u, int wr, int wc, int fr, int fq, bf16_t* O) {
    const int row0 = u.pm * BM + wr * 64 + fr;
#pragma unroll
    for (int ai = 0; ai < 2; ++ai)
#pragma unroll
        for (int m = 0; m < 4; ++m) { const int row = row0 + ai * HALF + m * 16, b = row >> 12, t = row & 4095;
#pragma unroll
            for (int bj = 0; bj < 2; ++bj) { const int col = u.pn * BM + bj * HALF + wc * 32 + 8 * fq, which = col >> 11, head = (col >> 7) & 15, dim = col & 127;
                const f32x4 v0 = acc[ai][bj][m][0], v1 = acc[ai][bj][m][1];
                u32x4 w; w.x = cvt_pk_bf16(v0[0], v0[1]); w.y = cvt_pk_bf16(v0[2], v0[3]); w.z = cvt_pk_bf16(v1[0], v1[1]); w.w = cvt_pk_bf16(v1[2], v1[3]);
                *(u32x4*)(O + ((size_t)((which * 64 + b * 16 + head) * 4096 + t)) * 128 + dim) = w; } }
}
__device__ __forceinline__ void epi_any(const f32x4 (&acc)[2][2][4][2], const Unit& u, int wr, int wc, int fr, int fq, const GemmDesc& d) {
    if (d.epi == EPI_F32) epi_f32(acc, u, wr, wc, fr, fq, (float*)d.out, d.ldc);
    else if (d.epi == EPI_RESID) epi_resid(acc, u, wr, wc, fr, fq, (bf16_t*)d.out, (const bf16_t*)d.aux, d.ldc, d.alpha);
    else if (d.epi == EPI_BF16) epi_bf16(acc, u, wr, wc, fr, fq, (bf16_t*)d.out, d.ldc);
    else if (d.epi == EPI_QKVH) epi_qkvh(acc, u, wr, wc, fr, fq, (bf16_t*)d.out);
    else epi_swiglu(acc, u, wr, wc, fr, fq, (bf16_t*)d.out, (const float*)d.aux);
}

template <bool ALIGN_EPI = true, bool SP2 = true>
__device__ __forceinline__ void gemm_run(PG8_LAS unsigned char* lds, const GemmDesc& d) {
    Order S; S.nM = d.nM; S.nN = d.nN; S.nwg = d.nM * d.nN; S.G = (int)gridDim.x; S.c = (int)blockIdx.x;
    const unsigned ldb2 = d.ldb2; const bool perm = d.epi != EPI_F32;
    int tid_l = threadIdx.x; asm volatile("" : "+v"(tid_l));
    const int tid = tid_l, wid = __builtin_amdgcn_readfirstlane(tid >> 6), lane = tid & 63, wr = wid >> 2, wc = wid & 3, fr = lane & 15, fq = lane >> 4;
    const int K = d.K, nt = K / BK;
    int RA[2]; unsigned CA2[2], voffB[2];
#pragma unroll
    for (int i = 0; i < 2; ++i) { int R, C; stage_rc(tid * 16 + i * 8192, R, C); const int Rb = perm ? ((R & ~31) + perm32(R & 31)) : R;
        RA[i] = R; CA2[i] = (unsigned)C * 2u; voffB[i] = (unsigned)Rb * ldb2 + (unsigned)C * 2u; }
    const size_t kstep = (size_t)(BK * 2);
    const size_t hstepB = (size_t)HALF * ldb2;
    const unsigned ldsw = (unsigned)wid * 1024u;
    const int aoff = lds_byte(wr * 64 + fr, fq * 8), boff = lds_byte(wc * 32 + fr, fq * 8);
#define PG8_SA(b, h) (((b) * 2 + (h)) * HTB)
#define PG8_SB(b, h) ((4 + (b) * 2 + (h)) * HTB)
#define PG8_STAGE(bufoff, gbase, voff) do { _Pragma("unroll") for (int _i = 0; _i < 2; ++_i) \
        __builtin_amdgcn_global_load_lds((const unsigned*)((const char*)(gbase) + (voff)[_i]), (PG8_LAS unsigned*)(lds + (bufoff) + ldsw + _i * 8192), 16, 0, 0); } while (0)
#define PG8_STAGEA(bufoff, gbase, v0, v1) do { \
        __builtin_amdgcn_global_load_lds((const unsigned*)((const char*)(gbase) + (v0)), (PG8_LAS unsigned*)(lds + (bufoff) + ldsw), 16, 0, 0); \
        __builtin_amdgcn_global_load_lds((const unsigned*)((const char*)(gbase) + (v1)), (PG8_LAS unsigned*)(lds + (bufoff) + ldsw + 8192), 16, 0, 0); } while (0)
#define PG8_LDA(dst, b, h) do { _Pragma("unroll") for (int m = 0; m < 4; ++m) _Pragma("unroll") for (int k = 0; k < 2; ++k) dst[m][k] = *(const PG8_LAS bf16x8*)(lds + PG8_SA(b, h) + aoff + m * 2048 + k * 1024); } while (0)
#define PG8_LDB(dst, b, h) do { _Pragma("unroll") for (int n = 0; n < 2; ++n) _Pragma("unroll") for (int k = 0; k < 2; ++k) dst[n][k] = *(const PG8_LAS bf16x8*)(lds + PG8_SB(b, h) + boff + n * 2048 + k * 1024); } while (0)
#define PG8_MMA(ai, bj, At, Bt) do { __builtin_amdgcn_s_setprio(1); _Pragma("unroll") for (int m = 0; m < 4; ++m) _Pragma("unroll") for (int n = 0; n < 2; ++n) _Pragma("unroll") for (int k = 0; k < 2; ++k) \
        acc[ai][bj][m][n] = __builtin_amdgcn_mfma_f32_16x16x32_bf16(Bt[n][k], At[m][k], acc[ai][bj][m][n], 0, 0, 0); __builtin_amdgcn_s_setprio(0); } while (0)
#define PG8_WAIT_V(n) asm volatile("s_waitcnt vmcnt(" #n ")" ::: "memory")
#define PG8_WAIT_L(n) asm volatile("s_waitcnt lgkmcnt(" #n ")" ::: "memory")
#define PG8_BAR __builtin_amdgcn_s_barrier()
#define PG8_SCHED __builtin_amdgcn_sched_barrier(0)
    Unit cur, nxt; int ui = 0;
    if (!S.next(0, cur)) return;
    f32x4 acc[2][2][4][2];
#pragma unroll
    for (int a = 0; a < 2; ++a)
#pragma unroll
        for (int b = 0; b < 2; ++b)
#pragma unroll
            for (int m = 0; m < 4; ++m)
#pragma unroll
                for (int n = 0; n < 2; ++n) acc[a][b][m][n] = (f32x4){0.f, 0.f, 0.f, 0.f};
    bf16x8 At[4][2], B0[2][2], B1[2][2];
    unsigned c00 = arow_off(d, cur, RA[0]) + CA2[0], c01 = arow_off(d, cur, RA[1]) + CA2[1], c10 = arow_off(d, cur, HALF + RA[0]) + CA2[0], c11 = arow_off(d, cur, HALF + RA[1]) + CA2[1];
    unsigned n00 = c00, n01 = c01, n10 = c10, n11 = c11;
    const char* const gA = (const char*)d.A;
    const char* cB = bptr(d, cur);
    if constexpr (SP2) {
        PG8_STAGE(PG8_SB(0, 0), cB, voffB); PG8_STAGE(PG8_SB(0, 1), cB + hstepB, voffB); PG8_STAGEA(PG8_SA(0, 0), gA, c00, c01); PG8_STAGEA(PG8_SA(0, 1), gA, c10, c11);
        if (wr == 1) PG8_BAR;
        PG8_WAIT_V(2); PG8_BAR;
        PG8_STAGE(PG8_SB(1, 0), cB + kstep, voffB); PG8_STAGEA(PG8_SA(1, 0), gA + kstep, c00, c01); PG8_STAGE(PG8_SB(1, 1), cB + hstepB + kstep, voffB);
        PG8_WAIT_V(6); PG8_BAR;
    } else {
        PG8_STAGE(PG8_SB(0, 0), cB, voffB); PG8_STAGEA(PG8_SA(0, 0), gA, c00, c01); PG8_STAGE(PG8_SB(0, 1), cB + hstepB, voffB); PG8_STAGEA(PG8_SA(0, 1), gA, c10, c11);
        if (wr == 1) PG8_BAR;
        PG8_WAIT_V(4); PG8_BAR;
        PG8_STAGE(PG8_SB(1, 0), cB + kstep, voffB); PG8_STAGEA(PG8_SA(1, 0), gA + kstep, c00, c01); PG8_STAGE(PG8_SB(1, 1), cB + hstepB + kstep, voffB);
        PG8_WAIT_V(6); PG8_BAR;
    }
    for (;;) {
        const bool has_next = S.next(ui + 1, nxt);
        const char* nB = cB;
        if (has_next) {
            int tl = tid; asm volatile("" : "+v"(tl)); int R0, C0, R1, C1; stage_rc(tl * 16, R0, C0); stage_rc(tl * 16 + 8192, R1, C1);
            n00 = arow_off(d, nxt, R0) + (unsigned)C0 * 2u; n01 = arow_off(d, nxt, R1) + (unsigned)C1 * 2u; n10 = arow_off(d, nxt, HALF + R0) + (unsigned)C0 * 2u; n11 = arow_off(d, nxt, HALF + R1) + (unsigned)C1 * 2u; nB = bptr(d, nxt); }
        else { n00 = c00; n01 = c01; n10 = c10; n11 = c11; }
        for (int t = 0; t < nt; t += 2) {
            const bool last = (t == nt - 2);
            const char* a1 = gA + (size_t)(t + 1) * kstep;
            const char* a2 = last ? gA : gA + (size_t)(t + 2) * kstep; const char* b2 = last ? nB : cB + (size_t)(t + 2) * kstep;
            const char* a3 = a2 + kstep; const char* b3 = b2 + kstep;
            const unsigned s00 = last ? n00 : c00, s01 = last ? n01 : c01, s10 = last ? n10 : c10, s11 = last ? n11 : c11;
            if constexpr (SP2) {
            PG8_LDB(B0, 0, 0); PG8_LDB(B1, 0, 1); PG8_SCHED; PG8_LDA(At, 0, 0); PG8_STAGEA(PG8_SA(1, 1), a1, c10, c11);
            PG8_WAIT_V(8); PG8_WAIT_L(0); PG8_BAR; PG8_MMA(0, 0, At, B0); PG8_MMA(0, 1, At, B1); PG8_BAR; PG8_SCHED;
            PG8_LDA(At, 0, 1); PG8_STAGE(PG8_SB(0, 0), b2, voffB); PG8_STAGE(PG8_SB(0, 1), b2 + hstepB, voffB); PG8_STAGEA(PG8_SA(0, 0), a2, s00, s01);
            PG8_WAIT_V(8); PG8_WAIT_L(0); PG8_BAR; PG8_MMA(1, 0, At, B0); PG8_MMA(1, 1, At, B1); PG8_BAR; PG8_SCHED;
            PG8_LDB(B0, 1, 0); PG8_LDB(B1, 1, 1); PG8_SCHED; PG8_LDA(At, 1, 0); PG8_STAGEA(PG8_SA(0, 1), a2, s10, s11);
            PG8_WAIT_V(8); PG8_WAIT_L(0); PG8_BAR; PG8_MMA(0, 0, At, B0); PG8_MMA(0, 1, At, B1); PG8_BAR; PG8_SCHED;
            PG8_LDA(At, 1, 1); PG8_STAGE(PG8_SB(1, 0), b3, voffB); PG8_STAGE(PG8_SB(1, 1), b3 + hstepB, voffB); PG8_STAGEA(PG8_SA(1, 0), a3, s00, s01);
            PG8_WAIT_V(8); PG8_WAIT_L(0); PG8_BAR; PG8_MMA(1, 0, At, B0); PG8_MMA(1, 1, At, B1); PG8_BAR; PG8_SCHED;
            } else {
            PG8_LDB(B0, 0, 0); PG8_SCHED; PG8_LDA(At, 0, 0); PG8_STAGEA(PG8_SA(1, 1), a1, c10, c11);
            PG8_WAIT_L(8); PG8_BAR; PG8_WAIT_L(0); PG8_MMA(0, 0, At, B0); PG8_BAR; PG8_SCHED;
            PG8_LDB(B1, 0, 1); PG8_STAGE(PG8_SB(0, 0), b2, voffB);
            PG8_BAR; PG8_WAIT_L(0); PG8_MMA(0, 1, At, B1); PG8_BAR;
            PG8_LDA(At, 0, 1); PG8_STAGEA(PG8_SA(0, 0), a2, s00, s01);
            PG8_BAR; PG8_WAIT_L(0); PG8_MMA(1, 0, At, B0); PG8_BAR; PG8_SCHED;
            PG8_STAGE(PG8_SB(0, 1), b2 + hstepB, voffB);
            PG8_WAIT_V(6); PG8_BAR; PG8_MMA(1, 1, At, B1); PG8_BAR;
            PG8_LDB(B0, 1, 0); PG8_SCHED; PG8_LDA(At, 1, 0); PG8_STAGEA(PG8_SA(0, 1), a2, s10, s11);
            PG8_WAIT_L(8); PG8_BAR; PG8_WAIT_L(0); PG8_MMA(0, 0, At, B0); PG8_BAR; PG8_SCHED;
            PG8_LDB(B1, 1, 1); PG8_STAGE(PG8_SB(1, 0), b3, voffB);
            PG8_BAR; PG8_WAIT_L(0); PG8_MMA(0, 1, At, B1); PG8_BAR;
            PG8_LDA(At, 1, 1); PG8_STAGEA(PG8_SA(1, 0), a3, s00, s01);
            PG8_BAR; PG8_WAIT_L(0); PG8_MMA(1, 0, At, B0); PG8_BAR; PG8_SCHED;
            PG8_STAGE(PG8_SB(1, 1), b3 + hstepB, voffB);
            PG8_WAIT_V(6); PG8_BAR; PG8_MMA(1, 1, At, B1); PG8_BAR;
            }
        }
        if constexpr (ALIGN_EPI) { if (wr == 0) PG8_BAR; }
        { int tl = tid; asm volatile("" : "+v"(tl)); const int wid_ = __builtin_amdgcn_readfirstlane(tl >> 6), ln_ = tl & 63;
          epi_any(acc, cur, wid_ >> 2, wid_ & 3, ln_ & 15, ln_ >> 4, d); }
        if (!has_next) break;
#pragma unroll
        for (int a = 0; a < 2; ++a)
#pragma unroll
            for (int b = 0; b < 2; ++b)
#pragma unroll
                for (int m = 0; m < 4; ++m)
#pragma unroll
                    for (int n = 0; n < 2; ++n) acc[a][b][m][n] = (f32x4){0.f, 0.f, 0.f, 0.f};
        cur = nxt; cB = nB; c00 = n00; c01 = n01; c10 = n10; c11 = n11; ++ui;
        if constexpr (ALIGN_EPI) { if (wr == 1) PG8_BAR; }
    }
    PG8_WAIT_V(0);
    if constexpr (!ALIGN_EPI) { if (wr == 0) PG8_BAR; }
    PG8_BAR;
#undef PG8_SA
#undef PG8_SB
#undef PG8_STAGE
#undef PG8_STAGEA
#undef PG8_LDA
#undef PG8_LDB
#undef PG8_MMA
#undef PG8_WAIT_V
#undef PG8_WAIT_L
#undef PG8_BAR
#undef PG8_SCHED
}
}

template <class RF>
__device__ __forceinline__ void cvt_block(const float* W, int ldw, int nvalid, int k0, int n0, bf16_t* WT, float scale, RF rowoff, float* scr, int lane) {
    const int c4 = 4 * (lane & 15), r4 = lane >> 4;
    const bool ok = (n0 + c4) < nvalid;
    float4 v[16];
#pragma unroll
    for (int i = 0; i < 16; ++i) v[i] = ok ? *(const float4*)(W + (size_t)(k0 + 4 * i + r4) * ldw + n0 + c4) : make_float4(0.f, 0.f, 0.f, 0.f);
#pragma unroll
    for (int i = 0; i < 16; ++i) { float* d = scr + (4 * i + r4) * 65 + c4; d[0] = v[i].x * scale; d[1] = v[i].y * scale; d[2] = v[i].z * scale; d[3] = v[i].w * scale; }
    asm volatile("s_waitcnt lgkmcnt(0)" ::: "memory");
    const int c = lane & 7;
#pragma unroll
    for (int jj = 0; jj < 8; ++jj) { const int n = (lane >> 3) + 8 * jj; const float* s = scr + (8 * c) * 65 + n;
        uint4 o; o.x = (unsigned)f2bf(s[0]) | ((unsigned)f2bf(s[65]) << 16); o.y = (unsigned)f2bf(s[2 * 65]) | ((unsigned)f2bf(s[3 * 65]) << 16);
        o.z = (unsigned)f2bf(s[4 * 65]) | ((unsigned)f2bf(s[5 * 65]) << 16); o.w = (unsigned)f2bf(s[6 * 65]) | ((unsigned)f2bf(s[7 * 65]) << 16);
        *(uint4*)(WT + rowoff(n0 + n) + k0 + 8 * c) = o; }
    asm volatile("s_waitcnt lgkmcnt(0)" ::: "memory");
}
__device__ __noinline__ int cvt_matrix(const float* W, size_t wstride, int nbatch, int K, int N, int nvalid, int ldw, bf16_t* WT, float scale, int rb, int sh, int rs, int mask, int r0, int ldt, int c1,
                                       unsigned* counter, int seg_lo, int pending) {
    const int tid = threadIdx.x, lane = tid & 63, wave = tid >> 6, gw = blockIdx.x * NWAVES + wave, NGW = gridDim.x * NWAVES;
    float* scr = (float*)lds_raw + wave * (64 * 65);
    const int nkb = K / 64, nnb = N / 64, per = nkb * nnb, total = per * nbatch;
    if (counter == nullptr) {
        for (int it = gw; it < total; it += NGW) { const int b = it / per, r = it % per, kb = r / nnb, nb = r % nnb;
            cvt_block(W + (size_t)b * wstride, ldw, nvalid, kb * 64, nb * 64, WT, scale, [=](int n) { return (size_t)(b * rb + (n >> sh) * rs + (n & mask) + r0) * ldt + (b & 1) * c1; }, scr, lane); }
        return 0;
    }
    const int seg_hi = seg_lo + (total + 3) / 4;
    int idx = pending;
    for (;;) {
        if (idx < 0) { unsigned v = 0; if (lane == 0) v = __hip_atomic_fetch_add(counter, 1u, __ATOMIC_RELAXED, __HIP_MEMORY_SCOPE_AGENT); idx = (int)__builtin_amdgcn_readfirstlane(v); }
        if (idx >= seg_hi) return idx;
        const int c0 = (idx - seg_lo) * 4, c1e = (c0 + 4 < total) ? c0 + 4 : total;
        for (int it = c0; it < c1e; ++it) { const int b = it / per, r = it % per, kb = r / nnb, nb = r % nnb;
            cvt_block(W + (size_t)b * wstride, ldw, nvalid, kb * 64, nb * 64, WT, scale, [=](int n) { return (size_t)(b * rb + (n >> sh) * rs + (n & mask) + r0) * ldt + (b & 1) * c1; }, scr, lane); }
        idx = -1;
    }
}
__device__ __noinline__ void ph_pre(const float* x, const float* rel_bias, unsigned char* ws) {
    const int tid = threadIdx.x, lane = tid & 63, wave = tid >> 6, gw = blockIdx.x * NWAVES + wave, NGW = gridDim.x * NWAVES; float* ldsf = (float*)lds_raw;
    (void)lane; (void)wave; (void)gw; (void)NGW; (void)ldsf;
        {
            const size_t stride = (size_t)gridDim.x * NTHR, n4 = (size_t)M * D / 4;
            for (size_t i = (size_t)blockIdx.x * NTHR + tid; i < n4; i += 4 * stride) {
                float4 v[4];
#pragma unroll
                for (int q = 0; q < 4; ++q) v[q] = (i + q * stride < n4) ? ((const float4*)x)[i + q * stride] : make_float4(0.f, 0.f, 0.f, 0.f);
#pragma unroll
                for (int q = 0; q < 4; ++q) if (i + q * stride < n4) { uint2 o; o.x = (unsigned)f2bf(v[q].x) | ((unsigned)f2bf(v[q].y) << 16); o.y = (unsigned)f2bf(v[q].z) | ((unsigned)f2bf(v[q].w) << 16); ((uint2*)XB)[i + q * stride] = o; }
            }
        }
        for (int i = blockIdx.x * NTHR + tid; i < 4096 * 16; i += gridDim.x * NTHR) { const int d = i >> 4, h = i & 15; BIAS_T[i] = rel_bias[t5_bucket(d) * 16 + h]; }
}

__device__ __noinline__ void ph_prep_dsa_fold(const float* w_uq, const float* w_uk, bf16_t* wq, bf16_t* wuv) {
    const int tid = threadIdx.x; float* ldsf = (float*)lds_raw;
    for (int i = blockIdx.x * NTHR + tid; i < HW * 32; i += gridDim.x * NTHR) { const int row = i >> 5, ch = i & 31, h = row >> 7; *(uint4*)(wuv + (size_t)row * 512 + ((h & 1) ^ 1) * 256 + ch * 8) = make_uint4(0u, 0u, 0u, 0u); }
    gemm_naive(ldsf, H, KVL, QL, HD,
        [=](int h, int c, int d) { return w_uk[((size_t)h * HD + d) * KVL + c]; },
        [=](int h, int d, int k) { return w_uq[(size_t)k * HW + h * HD + d]; },
        [=](int h, int c, int k, float v) { wq[(size_t)(h * KVL + c) * QL + k] = f2bf(v * 0.08838834764831845f); });
}

__device__ __noinline__ void ph_dsa_norms(const float* qn, const float* kn, unsigned char* ws) {
    const int tid = threadIdx.x, lane = tid & 63, wave = tid >> 6, gw = blockIdx.x * NWAVES + wave, NGW = gridDim.x * NWAVES; float* ldsf = (float*)lds_raw;
    (void)lane; (void)wave; (void)gw; (void)NGW; (void)ldsf;
                for (int m = gw; m < M; m += NGW) {
                    const float* p = PRAW + (size_t)m * 1024;
                    float v[8]; float s = 0.f;
#pragma unroll
                    for (int i = 0; i < 8; ++i) { v[i] = p[lane + 64 * i]; s += v[i] * v[i]; }
                    float r = rsqrtf(wave_sum(s) * (1.f / QL) + EPS);
#pragma unroll
                    for (int i = 0; i < 8; ++i) CQ[(size_t)m * QL + lane + 64 * i] = f2bf(v[i] * r * qn[lane + 64 * i]);
                    s = 0.f;
#pragma unroll
                    for (int i = 0; i < 4; ++i) { v[i] = p[QL + lane + 64 * i]; s += v[i] * v[i]; }
                    r = rsqrtf(wave_sum(s) * (1.f / KVL) + EPS);
#pragma unroll
                    for (int i = 0; i < 4; ++i) CKV[(size_t)m * KVL + lane + 64 * i] = f2bf(v[i] * r * kn[lane + 64 * i]);
                    KIDX[(size_t)m * IDM + lane] = f2bf(p[QL + KVL + lane]);
                    if (lane < IH) WIDX[(size_t)m * IH + lane] = p[QL + KVL + IDM + lane] * 0.25f;
                }
}

typedef short s16x8 __attribute__((ext_vector_type(8)));
typedef float f32x16 __attribute__((ext_vector_type(16)));
__device__ __forceinline__ void ph_dsa_index(unsigned char* ws) {
    int tid_ = threadIdx.x; asm volatile("" : "+v"(tid_));
    const int tid = tid_, lane = tid & 63, wave = __builtin_amdgcn_readfirstlane(tid >> 6);
    LAS unsigned char* lds = (LAS unsigned char*)lds_raw;
    const bf16_t* qall = QALL; const bf16_t* kidx = KIDX; const float* widx = WIDX; float* scb = SC;
    for (int unit = blockIdx.x; unit < NB_ * 64; unit += gridDim.x) {
        const int b = unit & 3, p = unit >> 2;
#pragma unroll 1
        for (int half = 0; half < 2; ++half) {
            const int qb = half ? p : 127 - p;
            const size_t qrow0 = (size_t)b * T + (size_t)qb * 32;
            __syncthreads();
#pragma unroll
            for (int i = 0; i < 8; ++i) { const int item = tid + 512 * i, q = item >> 7, hc = item & 127, h = hc >> 3, c = hc & 7;
                const uint4 v = *(const uint4*)(qall + (qrow0 + q) * QALD + 4096 + h * 64 + c * 8);
                *(LAS pg8::u32x4*)(lds + ((h * 4 + (c >> 1)) * 64 + q + 32 * (c & 1)) * 16) = (pg8::u32x4){v.x, v.y, v.z, v.w}; }
            if (tid < 256) {
                const int q = tid >> 3, c = tid & 7; float acc8[8];
#pragma unroll
                for (int e2 = 0; e2 < 8; ++e2) acc8[e2] = 0.f;
#pragma unroll 4
                for (int h = 0; h < 16; ++h) { const float w = widx[(qrow0 + q) * 16 + h]; const uint4 v = *(const uint4*)(qall + (qrow0 + q) * QALD + 4096 + h * 64 + c * 8); const unsigned w4[4] = {v.x, v.y, v.z, v.w};
#pragma unroll
                    for (int e2 = 0; e2 < 4; ++e2) { acc8[2 * e2] = fmaf(w, __uint_as_float(w4[e2] << 16), acc8[2 * e2]); acc8[2 * e2 + 1] = fmaf(w, __uint_as_float(w4[e2] & 0xffff0000u), acc8[2 * e2 + 1]); } }
                pg8::u32x4 o; o.x = (unsigned)f2bf(acc8[0]) | ((unsigned)f2bf(acc8[1]) << 16); o.y = (unsigned)f2bf(acc8[2]) | ((unsigned)f2bf(acc8[3]) << 16);
                o.z = (unsigned)f2bf(acc8[4]) | ((unsigned)f2bf(acc8[5]) << 16); o.w = (unsigned)f2bf(acc8[6]) | ((unsigned)f2bf(acc8[7]) << 16);
                *(LAS pg8::u32x4*)(lds + ((16 * 4 + (c >> 1)) * 64 + q + 32 * (c & 1)) * 16) = o;
            }
            if (tid < 512) { const int h = tid >> 5, q = tid & 31; *(LAS float*)(lds + 69632 + (h * 32 + q) * 4) = widx[(qrow0 + q) * 16 + h]; }
            __syncthreads();
            float* const scq = scb + (size_t)b * SC_PER_B + (size_t)512 * qb * (qb + 1) + (size_t)(lane & 31) * (32 * (qb + 1)) + 4 * (lane >> 5);
#pragma unroll 1
            for (int kb = wave; kb <= qb; kb += NWAVES) {
                s16x8 ka[4];
                { const bf16_t* kp = kidx + ((size_t)b * T + kb * 32 + (lane & 31)) * IDM + 8 * (lane >> 5);
#pragma unroll
                  for (int s = 0; s < 4; ++s) ka[s] = *(const s16x8*)(kp + 16 * s); }
                f32x16 acc;
                {
                    const f32x16 z = {0.f, 0.f, 0.f, 0.f, 0.f, 0.f, 0.f, 0.f, 0.f, 0.f, 0.f, 0.f, 0.f, 0.f, 0.f, 0.f};
                    acc = __builtin_amdgcn_mfma_f32_32x32x16_bf16(ka[0], *(const LAS s16x8*)(lds + ((16 * 4 + 0) * 64 + lane) * 16), z, 0, 0, 0);
#pragma unroll
                    for (int s = 1; s < 4; ++s) acc = __builtin_amdgcn_mfma_f32_32x32x16_bf16(ka[s], *(const LAS s16x8*)(lds + ((16 * 4 + s) * 64 + lane) * 16), acc, 0, 0, 0);
                }
#pragma unroll 2
                for (int h = 0; h < 16; ++h) {
                    const f32x16 z = {0.f, 0.f, 0.f, 0.f, 0.f, 0.f, 0.f, 0.f, 0.f, 0.f, 0.f, 0.f, 0.f, 0.f, 0.f, 0.f};
                    f32x16 sv = __builtin_amdgcn_mfma_f32_32x32x16_bf16(ka[0], *(const LAS s16x8*)(lds + ((h * 4 + 0) * 64 + lane) * 16), z, 0, 0, 0);
#pragma unroll
                    for (int s = 1; s < 4; ++s) sv = __builtin_amdgcn_mfma_f32_32x32x16_bf16(ka[s], *(const LAS s16x8*)(lds + ((h * 4 + s) * 64 + lane) * 16), sv, 0, 0, 0);
                    const float w = *(const LAS float*)(lds + 69632 + (h * 32 + (lane & 31)) * 4);
#pragma unroll
                    for (int r = 0; r < 16; ++r) acc[r] = fmaf(__builtin_fabsf(sv[r]), w, acc[r]);
                }
#pragma unroll
                for (int g = 0; g < 4; ++g) *(float4*)(scq + kb * 32 + 8 * g) = make_float4(acc[4 * g], acc[4 * g + 1], acc[4 * g + 2], acc[4 * g + 3]);
            }
        }
    }
    __syncthreads();
}

__device__ __forceinline__ void ph_dsa_topk(unsigned char* ws) {
    int tid_ = threadIdx.x; asm volatile("" : "+v"(tid_));
    const int tid = tid_, lane = tid & 63, wave = tid >> 6;
    float* sw = (float*)lds_raw + wave * 4096;
    const float NINF = -__builtin_inff(), PINF = __builtin_inff();
    typedef __attribute__((address_space(1))) const pg8::f32x4 gf4;
    const int nrows = M / (int)gridDim.x;
    LAS int* qctr = (LAS int*)((LAS unsigned char*)lds_raw + LDS_MISC + 3072);
    __syncthreads();
    if (tid == 0) *qctr = NWAVES;
    __syncthreads();
    auto row_of = [&](int j) -> int {
        if (gridDim.x == 256) { const int g = 8 * (int)blockIdx.x + (j & 7), bb = (j >> 3) & 3; return bb * T + ((j < 32) ? (T - 1 - g) : g); }
        return (int)blockIdx.x * nrows + j; };
    pg8::f32x4 xs[16];
    auto fetch = [&](int j) {
        if (j < nrows) { const int m = row_of(j), b = m / T, t = m % T, n = t + 1;
            if (n > TOPK) { const int nq = (n + 255) >> 8; gf4* sg = (gf4*)(SC + sc_off(b, t)) + lane;
#pragma unroll
                for (int i = 0; i < 16; ++i) xs[i] = (i < nq) ? sg[64 * i] : (pg8::f32x4){NINF, NINF, NINF, NINF}; } }
    };
    int jcur = wave;
    fetch(jcur);
    while (jcur < nrows) {
        const int m = row_of(jcur);
        int jn; { int tk = 0; if (lane == 0) tk = __hip_atomic_fetch_add(qctr, 1, __ATOMIC_RELAXED, __HIP_MEMORY_SCOPE_WORKGROUP); jn = __builtin_amdgcn_readfirstlane(tk); }
        jcur = jn;
        const int b = m / T, t = m % T, n = t + 1; (void)b;
        int* sel = SEL + (size_t)m * TOPK;
        if (n <= TOPK) { int l3 = tid; asm volatile("" : "+v"(l3)); l3 &= 63;
            for (int i = l3; i < n; i += 64) sel[i] = i; if (l3 == 0) NSEL[m] = n; fetch(jn); continue; }
        const int nq = (n + 255) >> 8;
        float mn = PINF, mx = NINF;
        {
#pragma unroll
            for (int i = 0; i < 16; ++i) { const int k0 = 4 * (lane + 64 * i); float4 x = make_float4(xs[i][0], xs[i][1], xs[i][2], xs[i][3]);
                x.x = (k0 + 0 < n) ? x.x : NINF; x.y = (k0 + 1 < n) ? x.y : NINF; x.z = (k0 + 2 < n) ? x.z : NINF; x.w = (k0 + 3 < n) ? x.w : NINF;
                *(float4*)(sw + k0) = x;
                mx = fmaxf(fmaxf(mx, x.x), fmaxf(x.y, fmaxf(x.z, x.w)));
                mn = fminf(mn, x.x == NINF ? PINF : x.x); mn = fminf(mn, x.y == NINF ? PINF : x.y); mn = fminf(mn, x.z == NINF ? PINF : x.z); mn = fminf(mn, x.w == NINF ? PINF : x.w); }
        }
        fetch(jn);
        float lo_v = wave_min_dpp(mn), hi_v = wave_max_dpp(mx);
        int c_lo = n, c_hi = 1;
#pragma unroll 1
        for (int it = 0; it < 96; ++it) {
            if (c_lo == TOPK) break;
            float f = 0.5f;
            if ((it & 1) == 0) { f = ((float)(c_lo - TOPK) + 0.5f) / (float)(c_lo - c_hi); f = fminf(fmaxf(f, 0.03f), 0.97f); }
            float mid = lo_v + (hi_v - lo_v) * f;
            if (!(mid > lo_v && mid < hi_v)) { mid = lo_v + (hi_v - lo_v) * 0.5f; if (!(mid > lo_v && mid < hi_v)) break; }
            int c = 0;
#pragma unroll 1
            for (int i0 = 0; i0 < nq; i0 += 8) {
                float4 x8[8];
#pragma unroll
                for (int j = 0; j < 8; ++j) x8[j] = *(const float4*)(sw + 4 * (lane + 64 * (i0 + j)));
#pragma unroll
                for (int j = 0; j < 8; ++j) c += (x8[j].x >= mid) + (x8[j].y >= mid) + (x8[j].z >= mid) + (x8[j].w >= mid);
            }
            c = wave_sum_dpp(c);
            if (c >= TOPK) { lo_v = mid; c_lo = c; } else { hi_v = mid; c_hi = c; }
        }
        float Tv = lo_v;
        int lgt = 0, leq = 0;
#pragma unroll 4
        for (int i = 0; i < nq; ++i) { const float4 x = *(const float4*)(sw + 4 * (lane + 64 * i));
            lgt += (x.x > Tv) + (x.y > Tv) + (x.z > Tv) + (x.w > Tv); leq += (x.x == Tv) + (x.y == Tv) + (x.z == Tv) + (x.w == Tv); }
        int sgt = wave_scan_dpp(lgt), seq = wave_scan_dpp(leq);
        int cgt = __builtin_amdgcn_readlane(sgt, 63), ceq = __builtin_amdgcn_readlane(seq, 63);
        if (cgt > TOPK) {
            Tv = hi_v; lgt = 0; leq = 0;
#pragma unroll 4
            for (int i = 0; i < nq; ++i) { const float4 x = *(const float4*)(sw + 4 * (lane + 64 * i)); leq += (x.x == Tv) + (x.y == Tv) + (x.z == Tv) + (x.w == Tv); }
            cgt = 0; sgt = 0; seq = wave_scan_dpp(leq); ceq = __builtin_amdgcn_readlane(seq, 63);
        }
        const int need = TOPK - cgt;
        LAS int* sl = (LAS int*)((LAS unsigned char*)lds_raw + 131072 + wave * 1024);
        int p = sgt - lgt, q = cgt + seq - leq;
        const bool all_ties = (ceq <= need);
#pragma unroll 2
        for (int i = 0; i < nq; ++i) {
            const int k0 = 4 * (lane + 64 * i); const float4 x = *(const float4*)(sw + k0); const float xv[4] = {x.x, x.y, x.z, x.w};
#pragma unroll
            for (int e2 = 0; e2 < 4; ++e2) { if (xv[e2] > Tv) sl[p++] = k0 + e2; else if (all_ties && xv[e2] == Tv) sl[q++] = k0 + e2; }
        }
        if (!all_ties) {
            int taken_below = -1;
            _Pragma("unroll 1") for (int i2 = 0; i2 < need; ++i2) {
                int best = 0x7fffffff;
                _Pragma("unroll 1") for (int i = 0; i < nq; ++i) { const int k0 = 4 * (lane + 64 * i); const float4 x = *(const float4*)(sw + k0); const float xv[4] = {x.x, x.y, x.z, x.w};
#pragma unroll
                    for (int e2 = 0; e2 < 4; ++e2) { const int key = k0 + e2; if (xv[e2] == Tv && key > taken_below && key < best) best = key; } }
                best = wave_min_i(best);
                if (lane == 0) sl[cgt + i2] = best;
                taken_below = best;
            }
        }
        asm volatile("s_waitcnt lgkmcnt(0)" ::: "memory");
        *(pg8::u32x4*)(sel + 4 * lane) = *(const LAS pg8::u32x4*)(sl + 4 * lane);
        if (lane == 0) NSEL[m] = TOPK;
    }
}

typedef float f32x4v __attribute__((ext_vector_type(4)));
__device__ __forceinline__ void ph_dsa_attn(unsigned char* ws) {
    int tid_ = threadIdx.x; asm volatile("" : "+v"(tid_));
    const int tid = tid_, lane = tid & 63, wave = __builtin_amdgcn_readfirstlane(tid >> 6), n16 = lane & 15, g4 = lane >> 4;
    LAS unsigned char* lds = (LAS unsigned char*)lds_raw;
    LAS unsigned char* kvb = lds + wave * 16384;
    LAS int* sell = (LAS int*)(lds + 131072 + wave * 1024);
    const bf16_t* qall = QALL; const bf16_t* ckv = CKV; const int* selg = SEL; const int* nselg = NSEL; const float* biasT = BIAS_T; bf16_t* olat = OLAT;
    const int NQ = (M + (int)(gridDim.x * NWAVES) - 1) / (int)(gridDim.x * NWAVES);
    for (int it = 0; it < NQ; ++it) {
        int m;
        if (gridDim.x == 256) { const int b = (blockIdx.x & 7) >> 1, wb = ((blockIdx.x & 1) * 32 + (blockIdx.x >> 3)) * NWAVES + wave; m = b * T + wb + 512 * it; }
        else m = (blockIdx.x * NWAVES + wave) + (int)(gridDim.x * NWAVES) * it;
        if (m >= M) continue;
        const int b = m / T, t = m % T;
        const int nsel = __builtin_amdgcn_readfirstlane(ld_mut(nselg + m));
        float zf = 0.f; asm volatile("" : "+v"(zf));
        { int sv[4];
#pragma unroll
          for (int i = 0; i < 4; ++i) sv[i] = selg[(size_t)m * TOPK + lane + 64 * i];
#pragma unroll
          for (int i = 0; i < 4; ++i) { const int k = lane + 64 * i; sell[k] = (k < nsel) ? sv[i] : 0; } }
        s16x8 qf[8];
        { const bf16_t* qrow = qall + (size_t)m * QALD + n16 * KVL + 8 * g4;
#pragma unroll
          for (int s = 0; s < 8; ++s) qf[s] = *(const s16x8*)(qrow + 32 * s); }
        f32x4v o[16];
#pragma unroll
        for (int cb = 0; cb < 16; ++cb) o[cb] = (f32x4v){zf, zf, zf, zf};
        float m_run = -1e30f, l_run = 0.f;
        const int nch = (nsel + 31) >> 5;
        const size_t rowb = (size_t)b * T;
#pragma unroll 1
        for (int ch = 0; ch < nch; ++ch) {
            asm volatile("s_waitcnt lgkmcnt(0)" ::: "memory");
#pragma unroll
            for (int i = 0; i < 16; ++i) { const int row = 2 * i + (lane >> 5), key = sell[ch * 32 + row], c = (lane & 31) ^ (row & 15);
                __builtin_amdgcn_global_load_lds((const unsigned*)(ckv + (rowb + key) * KVL + c * 8), (LAS unsigned*)(kvb + i * 1024), 16, 0, 0); }
            const pg8::u32x4 k0 = *(const LAS pg8::u32x4*)(sell + ch * 32 + 4 * g4), k1 = *(const LAS pg8::u32x4*)(sell + ch * 32 + 16 + 4 * g4);
            float bia[8];
            bia[0] = biasT[(t - (int)k0.x) * 16 + n16]; bia[1] = biasT[(t - (int)k0.y) * 16 + n16]; bia[2] = biasT[(t - (int)k0.z) * 16 + n16]; bia[3] = biasT[(t - (int)k0.w) * 16 + n16];
            bia[4] = biasT[(t - (int)k1.x) * 16 + n16]; bia[5] = biasT[(t - (int)k1.y) * 16 + n16]; bia[6] = biasT[(t - (int)k1.z) * 16 + n16]; bia[7] = biasT[(t - (int)k1.w) * 16 + n16];
            asm volatile("s_waitcnt vmcnt(0)" ::: "memory");
            f32x4v s0 = (f32x4v){0.f, 0.f, 0.f, 0.f}, s1 = (f32x4v){0.f, 0.f, 0.f, 0.f};
#pragma unroll
            for (int s = 0; s < 8; ++s) {
                const int cs = ((4 * s + g4) ^ n16) * 16;
                const s16x8 a0 = *(const LAS s16x8*)(kvb + n16 * 512 + cs), a1 = *(const LAS s16x8*)(kvb + (16 + n16) * 512 + cs);
                s0 = __builtin_amdgcn_mfma_f32_16x16x32_bf16(a0, qf[s], s0, 0, 0, 0); s1 = __builtin_amdgcn_mfma_f32_16x16x32_bf16(a1, qf[s], s1, 0, 0, 0);
            }
            float sc[8]; float tmax = -__builtin_inff();
#pragma unroll
            for (int r = 0; r < 4; ++r) { sc[r] = (ch * 32 + 4 * g4 + r < nsel) ? s0[r] + bia[r] : -__builtin_inff(); sc[4 + r] = (ch * 32 + 16 + 4 * g4 + r < nsel) ? s1[r] + bia[4 + r] : -__builtin_inff(); }
#pragma unroll
            for (int r = 0; r < 8; ++r) tmax = fmaxf(tmax, sc[r]);
            tmax = fmaxf(tmax, __shfl_xor(tmax, 16)); tmax = fmaxf(tmax, __shfl_xor(tmax, 32));
            if (__any(tmax > m_run + 6.f)) {
                const float mnew = fmaxf(m_run, tmax), alpha = __expf(m_run - mnew);
#pragma unroll
                for (int cb = 0; cb < 16; ++cb) o[cb] *= alpha;
                l_run *= alpha; m_run = mnew;
            }
            float p[8]; float psum = 0.f;
#pragma unroll
            for (int r = 0; r < 8; ++r) { p[r] = __expf(sc[r] - m_run); psum += p[r]; }
            l_run += psum;
            s16x8 pb;
            { const unsigned w0 = pg8::cvt_pk_bf16(p[0], p[1]), w1 = pg8::cvt_pk_bf16(p[2], p[3]), w2 = pg8::cvt_pk_bf16(p[4], p[5]), w3 = pg8::cvt_pk_bf16(p[6], p[7]);
              pb[0] = (short)(w0 & 0xffff); pb[1] = (short)(w0 >> 16); pb[2] = (short)(w1 & 0xffff); pb[3] = (short)(w1 >> 16); pb[4] = (short)(w2 & 0xffff); pb[5] = (short)(w2 >> 16); pb[6] = (short)(w3 & 0xffff); pb[7] = (short)(w3 >> 16); }
            {
                const int q4 = n16 >> 2, p4 = n16 & 3, x = 4 * g4 + q4;
                const LAS unsigned char* vb = kvb + x * 512 + (p4 & 1) * 8;
                const int yo = (p4 >> 1) ^ (x & 1), xe = x & 14;
#pragma unroll
                for (int cq = 0; cq < 4; ++cq) {
                    typedef short s16x4 __attribute__((ext_vector_type(4)));
                    s16x4 lo[4], hi4[4];
#pragma unroll
                    for (int u = 0; u < 4; ++u) { const int cb = 4 * cq + u; const int co = (((2 * cb) ^ xe) + yo) * 16;
                        lo[u] = __builtin_bit_cast(s16x4, __builtin_amdgcn_ds_read_tr16_b64_v4i16((LAS s16x4*)(vb + co)));
                        hi4[u] = __builtin_bit_cast(s16x4, __builtin_amdgcn_ds_read_tr16_b64_v4i16((LAS s16x4*)(vb + 16 * 512 + co))); }
#pragma unroll
                    for (int u = 0; u < 4; ++u) { const int cb = 4 * cq + u;
                        s16x8 va; va[0] = lo[u][0]; va[1] = lo[u][1]; va[2] = lo[u][2]; va[3] = lo[u][3]; va[4] = hi4[u][0]; va[5] = hi4[u][1]; va[6] = hi4[u][2]; va[7] = hi4[u][3];
                        o[cb] = __builtin_amdgcn_mfma_f32_16x16x32_bf16(va, pb, o[cb], 0, 0, 0); }
                }
            }
        }
        {
            float lt = l_run; lt += __shfl_xor(lt, 16); lt += __shfl_xor(lt, 32);
            const float inv = 1.f / lt;
            bf16_t* orow = olat + (size_t)m * 4096 + n16 * KVL + 4 * g4;
#pragma unroll
            for (int cb = 0; cb < 16; ++cb) { pg8::u32x2 w; w.x = pg8::cvt_pk_bf16(o[cb][0] * inv, o[cb][1] * inv); w.y = pg8::cvt_pk_bf16(o[cb][2] * inv, o[cb][3] * inv); *(pg8::u32x2*)(orow + 16 * cb) = w; }
        }
    }
    __syncthreads();
}

__device__ __forceinline__ void ph_dil_attn(unsigned char* ws, unsigned* qbase) {
    int tid_ = threadIdx.x; asm volatile("" : "+v"(tid_));
    const int tid = tid_, lane = tid & 63, wave = __builtin_amdgcn_readfirstlane(tid >> 6), qi = lane & 31, hi = lane >> 5;
    LAS unsigned char* lds = (LAS unsigned char*)lds_raw;
    LAS unsigned char* kbuf = lds + wave * 16384;
    LAS unsigned char* vbuf = kbuf + 8192;
    const int drow = lane >> 4, kc0 = ((lane & 15) ^ drow) * 8, kc1 = ((lane & 15) ^ (4 + drow)) * 8, vc = ((lane & 15) ^ (drow << 2)) * 8;
    LAS float* btab = (LAS float*)(lds + 131072);
    const bf16_t* qkv = QKV; bf16_t* ob = OB; const float* biasT = BIAS_T;
    bf16_t* stb = (bf16_t*)(ws + AR_DST) + (size_t)blockIdx.x * (512 * 128);
    float* mlb = (float*)(ws + AR_DML) + (size_t)blockIdx.x * (512 * 4);
    const int xq = (int)blockIdx.x & 7, nfirst = (int)gridDim.x >> 3;
    LAS int* tkw = (LAS int*)(lds + LDS_MISC + 3072);
    for (int j = (int)blockIdx.x >> 3; j < 64; ) {
        float zf = 0.f; asm volatile("" : "+v"(zf));
        const f32x16 zero16 = {zf, zf, zf, zf, zf, zf, zf, zf, zf, zf, zf, zf, zf, zf, zf, zf};
        const int bhi = (j < 56) ? j / 7 : j - 56, span = (j < 56) ? 1 + j % 7 : 0;
        const int x = xq, u = 8 * bhi + span, bh = x + 8 * (u >> 3), h = bh & 15, s0 = (u & 7) * 512;
        __syncthreads();
        if (tid == 0) *tkw = nfirst + (int)__hip_atomic_fetch_add(qbase + 16 * xq, 1u, __ATOMIC_RELAXED, __HIP_MEMORY_SCOPE_AGENT);
        { int t2 = tid; asm volatile("" : "+v"(t2));
          if (t2 < 387) { const int br = t2 / 129, m = t2 - br * 129, dl = (br == 0) ? 1 : (br == 1 ? 4 : 16); btab[br * 132 + m] = biasT[(dl * m) * 16 + h] * 1.4426950408889634f; } }
        __syncthreads();
        const bf16_t* qbase = qkv + (size_t)bh * T * HD + 8 * hi;
        const bf16_t* kbase = qkv + (size_t)(64 + bh) * T * HD;
        const bf16_t* vbase = qkv + (size_t)(128 + bh) * T * HD;
        s16x8 qf[8], kf[8];
        f32x16 o0 = zero16, o1 = zero16, o2 = zero16, o3 = zero16;
        float m_run = -1e30f, l_run = 0.f;
        int br = 0, gi = 0, kt = 0, tb = s0 + 32 * wave, tq = 0;
        while (tb + (-128 + 32 * kt + 31) < 0) ++kt;
        bool fresh = true;
        {
            const int J0 = -128 + 32 * kt;
#pragma unroll
            for (int i = 0; i < 8; ++i) { int tk = tb + (J0 + 4 * i + drow); tk = tk < 0 ? 0 : tk;
                __builtin_amdgcn_global_load_lds((const unsigned*)(kbase + (size_t)tk * HD + ((i & 1) ? kc1 : kc0)), (LAS unsigned*)(kbuf + i * 1024), 16, 0, 0); }
#pragma unroll
            for (int i = 0; i < 8; ++i) { int tv = tb + (J0 + 4 * i + drow); tv = tv < 0 ? 0 : tv;
                __builtin_amdgcn_global_load_lds((const unsigned*)(vbase + (size_t)tv * HD + vc), (LAS unsigned*)(vbuf + i * 1024), 16, 0, 0); }
        }
#pragma unroll 1
        for (;;) {
            const int shift = 2 * br, J0 = -128 + 32 * kt;
            if (fresh) {
                tq = tb + (qi << shift);
                if (br > 0 && gi == 0) { asm volatile("s_waitcnt vmcnt(0)" ::: "memory"); __syncthreads(); }
                const bf16_t* qrow = qbase + (size_t)tq * HD;
#pragma unroll
                for (int s = 0; s < 8; ++s) qf[s] = *(const s16x8*)(qrow + 16 * s);
                if (br == 0) { o0 = zero16; o1 = zero16; o2 = zero16; o3 = zero16; m_run = -1e30f; l_run = 0.f; }
                else {
                    const int ql = (tq - s0) * 2 + hi;
                    const pg8::u32x4* sp = (const pg8::u32x4*)(stb + (size_t)ql * 64);
                    const float2 ml = *(const float2*)(mlb + ql * 2); m_run = ml.x; l_run = ml.y;
#define DIL_LD(O, DB) { const pg8::u32x4 w0 = sp[2 * (DB)], w1 = sp[2 * (DB) + 1]; \
                        O[0] = __uint_as_float(w0.x << 16); O[1] = __uint_as_float(w0.x & 0xffff0000u); O[2] = __uint_as_float(w0.y << 16); O[3] = __uint_as_float(w0.y & 0xffff0000u); \
                        O[4] = __uint_as_float(w0.z << 16); O[5] = __uint_as_float(w0.z & 0xffff0000u); O[6] = __uint_as_float(w0.w << 16); O[7] = __uint_as_float(w0.w & 0xffff0000u); \
                        O[8] = __uint_as_float(w1.x << 16); O[9] = __uint_as_float(w1.x & 0xffff0000u); O[10] = __uint_as_float(w1.y << 16); O[11] = __uint_as_float(w1.y & 0xffff0000u); \
                        O[12] = __uint_as_float(w1.z << 16); O[13] = __uint_as_float(w1.z & 0xffff0000u); O[14] = __uint_as_float(w1.w << 16); O[15] = __uint_as_float(w1.w & 0xffff0000u); }
                    DIL_LD(o0, 0) DIL_LD(o1, 1) DIL_LD(o2, 2) DIL_LD(o3, 3)
#undef DIL_LD
                }
            }
            const int mmax = min(128, tq >> shift);
            int nbr = br, ngi = gi, nkt = kt + 1, ntb = tb;
            if (nkt == 5) {
                ++ngi; if (ngi == 2) { ngi = 0; ++nbr; }
                nkt = 0;
                if (nbr < 3) { const int g = wave + 8 * ngi, ndl = 1 << (2 * nbr);
                    ntb = s0 + ((nbr == 0) ? 32 * g : (nbr == 1) ? 128 * (g >> 2) + (g & 3) : g);
                    while (ntb + (-128 + 32 * nkt + 31) * ndl < 0) ++nkt; }
            }
            const bool more = nbr < 3, glast = (kt == 4);
            const int mb = qi - J0 - 4 * hi;
            const LAS float* bt = btab + br * 132;
            float bv[16];
#pragma unroll
            for (int r = 0; r < 16; ++r) { const int m = mb - ((r & 3) + 8 * (r >> 2)); bv[r] = bt[min(max(m, 0), 128)]; }
            asm volatile("s_waitcnt vmcnt(8)" ::: "memory");
#pragma unroll
            for (int s = 0; s < 8; ++s) kf[s] = *(const LAS s16x8*)(kbuf + qi * 256 + (((2 * s + hi) ^ (qi & 7)) * 16));
            asm volatile("s_waitcnt lgkmcnt(0)" ::: "memory");
            if (more) {
                const int ndl = 1 << (2 * nbr), nJ0 = -128 + 32 * nkt;
#pragma unroll
                for (int i = 0; i < 8; ++i) { int tk = ntb + (nJ0 + 4 * i + drow) * ndl; tk = tk < 0 ? 0 : tk;
                    __builtin_amdgcn_global_load_lds((const unsigned*)(kbase + (size_t)tk * HD + ((i & 1) ? kc1 : kc0)), (LAS unsigned*)(kbuf + i * 1024), 16, 0, 0); }
            }
            f32x16 sc = __builtin_amdgcn_mfma_f32_32x32x16_bf16(kf[0], qf[0], (f32x16){0.f, 0.f, 0.f, 0.f, 0.f, 0.f, 0.f, 0.f, 0.f, 0.f, 0.f, 0.f, 0.f, 0.f, 0.f, 0.f}, 0, 0, 0);
#pragma unroll
            for (int s = 1; s < 8; ++s) sc = __builtin_amdgcn_mfma_f32_32x32x16_bf16(kf[s], qf[s], sc, 0, 0, 0);
            float tmax = -__builtin_inff();
#pragma unroll
            for (int r = 0; r < 16; ++r) { const int m = mb - ((r & 3) + 8 * (r >> 2));
                sc[r] = ((unsigned)m <= (unsigned)mmax) ? sc[r] + bv[r] : -__builtin_inff(); tmax = fmaxf(tmax, sc[r]); }
            tmax = fmaxf(tmax, __shfl_xor(tmax, 32));
            if (__any(tmax > m_run + 8.f)) {
                const float mnew = fmaxf(m_run, tmax), alpha = __builtin_amdgcn_exp2f(m_run - mnew);
                o0 *= alpha; o1 *= alpha; o2 *= alpha; o3 *= alpha; l_run *= alpha; m_run = mnew;
            }
            float psum = 0.f; unsigned pk[8];
#pragma unroll
            for (int r = 0; r < 16; r += 2) { const float p0 = __builtin_amdgcn_exp2f(sc[r] - m_run), p1 = __builtin_amdgcn_exp2f(sc[r + 1] - m_run); psum += p0 + p1; pk[r >> 1] = pg8::cvt_pk_bf16(p0, p1); }
            l_run += psum;
            if (more) asm volatile("s_waitcnt vmcnt(8)" ::: "memory"); else asm volatile("s_waitcnt vmcnt(0)" ::: "memory");
            {
                const int G4 = lane >> 4, q4 = (lane & 15) >> 2, p4 = lane & 3;
                const LAS unsigned char* vb = vbuf + (4 * (G4 >> 1) + q4) * 256 + (2 * (G4 & 1) + (p4 >> 1)) * 16 + (p4 & 1) * 8;
#pragma unroll
                for (int s2 = 0; s2 < 2; ++s2) {
                    s16x8 pb; pb[0] = (short)(pk[4 * s2] & 0xffff); pb[1] = (short)(pk[4 * s2] >> 16); pb[2] = (short)(pk[4 * s2 + 1] & 0xffff); pb[3] = (short)(pk[4 * s2 + 1] >> 16);
                    pb[4] = (short)(pk[4 * s2 + 2] & 0xffff); pb[5] = (short)(pk[4 * s2 + 2] >> 16); pb[6] = (short)(pk[4 * s2 + 3] & 0xffff); pb[7] = (short)(pk[4 * s2 + 3] >> 16);
                    typedef short s16x4 __attribute__((ext_vector_type(4)));
                    s16x4 lo[4], hi4[4];
#pragma unroll
                    for (int db = 0; db < 4; ++db) { const int sw = (db ^ q4) * 64;
                        lo[db] = __builtin_bit_cast(s16x4, __builtin_amdgcn_ds_read_tr16_b64_v4i16((LAS s16x4*)(vb + (16 * s2) * 256 + sw)));
                        hi4[db] = __builtin_bit_cast(s16x4, __builtin_amdgcn_ds_read_tr16_b64_v4i16((LAS s16x4*)(vb + (16 * s2 + 8) * 256 + sw))); }
#pragma unroll
                    for (int db = 0; db < 4; ++db) {
                        s16x8 va; va[0] = lo[db][0]; va[1] = lo[db][1]; va[2] = lo[db][2]; va[3] = lo[db][3]; va[4] = hi4[db][0]; va[5] = hi4[db][1]; va[6] = hi4[db][2]; va[7] = hi4[db][3];
                        if (db == 0) o0 = __builtin_amdgcn_mfma_f32_32x32x16_bf16(va, pb, o0, 0, 0, 0);
                        else if (db == 1) o1 = __builtin_amdgcn_mfma_f32_32x32x16_bf16(va, pb, o1, 0, 0, 0);
                        else if (db == 2) o2 = __builtin_amdgcn_mfma_f32_32x32x16_bf16(va, pb, o2, 0, 0, 0);
                        else o3 = __builtin_amdgcn_mfma_f32_32x32x16_bf16(va, pb, o3, 0, 0, 0);
                    }
                }
            }
            if (glast) {
                if (br < 2) {
                    const int ql = (tq - s0) * 2 + hi;
                    pg8::u32x4* sp = (pg8::u32x4*)(stb + (size_t)ql * 64);
                    float2 ml; ml.x = m_run; ml.y = l_run; *(float2*)(mlb + ql * 2) = ml;
#define DIL_ST(O, DB) { pg8::u32x4 w0, w1; \
                        w0.x = pg8::cvt_pk_bf16(O[0], O[1]); w0.y = pg8::cvt_pk_bf16(O[2], O[3]); w0.z = pg8::cvt_pk_bf16(O[4], O[5]); w0.w = pg8::cvt_pk_bf16(O[6], O[7]); \
                        w1.x = pg8::cvt_pk_bf16(O[8], O[9]); w1.y = pg8::cvt_pk_bf16(O[10], O[11]); w1.z = pg8::cvt_pk_bf16(O[12], O[13]); w1.w = pg8::cvt_pk_bf16(O[14], O[15]); \
                        sp[2 * (DB)] = w0; sp[2 * (DB) + 1] = w1; }
                    DIL_ST(o0, 0) DIL_ST(o1, 1) DIL_ST(o2, 2) DIL_ST(o3, 3)
#undef DIL_ST
                } else {
                    const float l_tot = l_run + __shfl_xor(l_run, 32), inv = 1.f / l_tot;
                    bf16_t* orow = ob + ((size_t)(bh >> 4) * T + tq) * HW + h * HD + 4 * hi;
#pragma unroll
                    for (int g = 0; g < 4; ++g) {
                        pg8::u32x2 w;
                        w.x = pg8::cvt_pk_bf16(o0[4 * g] * inv, o0[4 * g + 1] * inv); w.y = pg8::cvt_pk_bf16(o0[4 * g + 2] * inv, o0[4 * g + 3] * inv); *(pg8::u32x2*)(orow + 0 + 8 * g) = w;
                        w.x = pg8::cvt_pk_bf16(o1[4 * g] * inv, o1[4 * g + 1] * inv); w.y = pg8::cvt_pk_bf16(o1[4 * g + 2] * inv, o1[4 * g + 3] * inv); *(pg8::u32x2*)(orow + 32 + 8 * g) = w;
                        w.x = pg8::cvt_pk_bf16(o2[4 * g] * inv, o2[4 * g + 1] * inv); w.y = pg8::cvt_pk_bf16(o2[4 * g + 2] * inv, o2[4 * g + 3] * inv); *(pg8::u32x2*)(orow + 64 + 8 * g) = w;
                        w.x = pg8::cvt_pk_bf16(o3[4 * g] * inv, o3[4 * g + 1] * inv); w.y = pg8::cvt_pk_bf16(o3[4 * g + 2] * inv, o3[4 * g + 3] * inv); *(pg8::u32x2*)(orow + 96 + 8 * g) = w;
                    }
                }
            }
            if (!more) break;
            asm volatile("s_waitcnt lgkmcnt(0)" ::: "memory");
            {
                const int ndl = 1 << (2 * nbr), nJ0 = -128 + 32 * nkt;
#pragma unroll
                for (int i = 0; i < 8; ++i) { int tv = ntb + (nJ0 + 4 * i + drow) * ndl; tv = tv < 0 ? 0 : tv;
                    __builtin_amdgcn_global_load_lds((const unsigned*)(vbase + (size_t)tv * HD + vc), (LAS unsigned*)(vbuf + i * 1024), 16, 0, 0); }
            }
            fresh = glast; br = nbr; gi = ngi; kt = nkt; tb = ntb;
        }
        j = __builtin_amdgcn_readfirstlane(*tkw);
    }
    __syncthreads();
}

__device__ __forceinline__ void route_token(const float (&lgt)[16], const float* router_b, int& i1, int& i2, float& g1, float& g2) {
    float mx = lgt[0];
#pragma unroll
    for (int e = 1; e < 16; ++e) mx = fmaxf(mx, lgt[e]);
    float pr[16], sm = 0.f;
#pragma unroll
    for (int e = 0; e < 16; ++e) { pr[e] = __expf(lgt[e] - mx); sm += pr[e]; }
    const float inv = 1.f / sm;
    float sl[16];
#pragma unroll
    for (int e = 0; e < 16; ++e) { pr[e] *= inv; sl[e] = pr[e] + router_b[e]; }
    int bg = 0; float bgs = -__builtin_inff();
#pragma unroll
    for (int g = 0; g < NG; ++g) {
        const float a0 = sl[g * 4], a1 = sl[g * 4 + 1], a2 = sl[g * 4 + 2], a3 = sl[g * 4 + 3];
        const float h1 = fmaxf(a0, a1), l1 = fminf(a0, a1), h2 = fmaxf(a2, a3), l2 = fminf(a2, a3);
        const float gs = fmaxf(h1, h2) + fmaxf(fminf(h1, h2), fmaxf(l1, l2));
        const bool better = gs > bgs; bgs = better ? gs : bgs; bg = better ? g : bg;
    }
    float sg[4], pg[4];
#pragma unroll
    for (int i = 0; i < 4; ++i) { sg[i] = (bg == 0) ? sl[i] : (bg == 1) ? sl[4 + i] : (bg == 2) ? sl[8 + i] : sl[12 + i]; pg[i] = (bg == 0) ? pr[i] : (bg == 1) ? pr[4 + i] : (bg == 2) ? pr[8 + i] : pr[12 + i]; }
    int l1i = 0; float v1 = sg[0], p1 = pg[0];
#pragma unroll
    for (int i = 1; i < 4; ++i) { const bool b = sg[i] > v1; v1 = b ? sg[i] : v1; p1 = b ? pg[i] : p1; l1i = b ? i : l1i; }
    int l2i = 0; float v2 = -__builtin_inff(), p2 = 0.f;
#pragma unroll
    for (int i = 0; i < 4; ++i) { const bool b = (i != l1i) && (sg[i] > v2); v2 = b ? sg[i] : v2; p2 = b ? pg[i] : p2; l2i = b ? i : l2i; }
    i1 = bg * 4 + l1i; i2 = bg * 4 + l2i;
    const float gsum = p1 + p2; g1 = p1 / gsum; g2 = p2 / gsum;
}
__device__ __forceinline__ float reduce16(float (&v)[16], int lane) {
#pragma unroll
    for (int i = 0; i < 8; ++i) { const bool up = lane & 1; const float keep = up ? v[i + 8] : v[i], send = up ? v[i] : v[i + 8]; v[i] = keep + __shfl_xor(send, 1); }
#pragma unroll
    for (int i = 0; i < 4; ++i) { const bool up = lane & 2; const float keep = up ? v[i + 4] : v[i], send = up ? v[i] : v[i + 4]; v[i] = keep + __shfl_xor(send, 2); }
#pragma unroll
    for (int i = 0; i < 2; ++i) { const bool up = lane & 4; const float keep = up ? v[i + 2] : v[i], send = up ? v[i] : v[i + 2]; v[i] = keep + __shfl_xor(send, 4); }
    { const bool up = lane & 8; const float keep = up ? v[1] : v[0], send = up ? v[0] : v[1]; v[0] = keep + __shfl_xor(send, 8); }
    float r = v[0]; r += __shfl_xor(r, 16); r += __shfl_xor(r, 32); return r;
}
__device__ __forceinline__ void route_pair(float x, int lane, const float* router_b, int m, int* expid, float* gatew, int* lh) {
    const int E = lane & 15;
    float mx = x; mx = fmaxf(mx, __shfl_xor(mx, 1)); mx = fmaxf(mx, __shfl_xor(mx, 2)); mx = fmaxf(mx, __shfl_xor(mx, 4)); mx = fmaxf(mx, __shfl_xor(mx, 8));
    const float p = __expf(x - mx);
    float sm = p; sm += __shfl_xor(sm, 1); sm += __shfl_xor(sm, 2); sm += __shfl_xor(sm, 4); sm += __shfl_xor(sm, 8);
    const float pr = p * (1.f / sm), sl = pr + router_b[E];
    const float a = __shfl_xor(sl, 1), h1 = fmaxf(sl, a), l1 = fminf(sl, a), bh = __shfl_xor(h1, 2), bl = __shfl_xor(l1, 2);
    float gs = fmaxf(h1, bh) + fmaxf(fminf(h1, bh), fmaxf(l1, bl));
    int g = E >> 2;
    { const float og = __shfl_xor(gs, 4); const int oi = __shfl_xor(g, 4); const bool t = (og > gs) || (og == gs && oi < g); gs = t ? og : gs; g = t ? oi : g; }
    { const float og = __shfl_xor(gs, 8); const int oi = __shfl_xor(g, 8); const bool t = (og > gs) || (og == gs && oi < g); gs = t ? og : gs; g = t ? oi : g; }
    const bool inb = (E >> 2) == g;
    int rank = 0;
#pragma unroll
    for (int d = 1; d < 4; ++d) { const float os = __shfl_xor(sl, d); const int oe = E ^ d; rank += ((os > sl) || (os == sl && oe < E)) ? 1 : 0; }
    const unsigned long long b1 = __ballot(inb && rank == 0), b2 = __ballot(inb && rank == 1);
    const int pri = __float_as_int(pr);
#pragma unroll
    for (int q = 0; q < 2; ++q) {
        const int i1 = __builtin_ctz(((unsigned)(b1 >> (16 * q)) & 0xffffu) | 0x10000u), i2 = __builtin_ctz(((unsigned)(b2 >> (16 * q)) & 0xffffu) | 0x10000u);
        const float p1 = __int_as_float(__builtin_amdgcn_readlane(pri, 16 * q + (i1 & 15))), p2 = __int_as_float(__builtin_amdgcn_readlane(pri, 16 * q + (i2 & 15)));
        const float gsum = p1 + p2;
        if (lane == 0) { expid[(m + q) * 2] = i1 & 15; expid[(m + q) * 2 + 1] = i2 & 15; gatew[(m + q) * 2] = p1 / gsum; gatew[(m + q) * 2 + 1] = p2 / gsum; atomicAdd(&lh[i1 & 15], 1); atomicAdd(&lh[i2 & 15], 1); }
    }
}
__device__ __forceinline__ void ph_ln1_router(const float* g1, const float* b1, const float* router_w, const float* router_b, unsigned char* ws) {
    int tid_ = threadIdx.x; asm volatile("" : "+v"(tid_));
    const int tid = tid_, lane = tid & 63, wave = __builtin_amdgcn_readfirstlane(tid >> 6);
    LAS unsigned char* lds = (LAS unsigned char*)lds_raw;
    LAS float* stat = (LAS float*)(lds + 131072);
    LAS pg8::f32x4* dpart = (LAS pg8::f32x4*)(lds + 131072 + 1024);
    int* lh = (int*)((unsigned char*)lds_raw + LDS_MISC + 256);
    LAS float* gbl = (LAS float*)(lds + 147456);
    __syncthreads();
    { const float4 gv = *(const float4*)(g1 + 4 * tid), bv = *(const float4*)(b1 + 4 * tid);
      *(LAS pg8::f32x4*)(gbl + 4 * tid) = (pg8::f32x4){gv.x, gv.y, gv.z, gv.w}; *(LAS pg8::f32x4*)(gbl + 2048 + 4 * tid) = (pg8::f32x4){bv.x, bv.y, bv.z, bv.w}; }
    {
        float4 w0[8], w1[8];
#pragma unroll
        for (int q = 0; q < 8; ++q) { const int p = tid + NTHR * q, k = (p >> 2) * 2, e4 = (p & 3) * 4; w0[q] = *(const float4*)(router_w + k * 16 + e4); w1[q] = *(const float4*)(router_w + (k + 1) * 16 + e4); }
#pragma unroll
        for (int q = 0; q < 8; ++q) { const int p = tid + NTHR * q, k = (p >> 2) * 2, e4 = (p & 3) * 4, ks = k >> 5, gg = (k >> 3) & 3, j = k & 7;
            const float a[4] = {w0[q].x, w0[q].y, w0[q].z, w0[q].w}, b[4] = {w1[q].x, w1[q].y, w1[q].z, w1[q].w};
#pragma unroll
            for (int i = 0; i < 4; ++i) { const bf16_t ah = f2bf(a[i]), bh = f2bf(b[i]), al = f2bf(a[i] - bf2f(ah)), bl = f2bf(b[i] - bf2f(bh));
                const int off = ks * 1024 + (e4 + i + 16 * gg) * 16 + j * 2;
                *(LAS unsigned*)(lds + off) = (unsigned)ah | ((unsigned)bh << 16); *(LAS unsigned*)(lds + 65536 + off) = (unsigned)al | ((unsigned)bl << 16); } }
    }
    for (int c = blockIdx.x; c < NCHUNK; c += gridDim.x) {
        __syncthreads();
        if (tid < 16) lh[tid] = 0;
        const int tb = wave >> 1, kh = wave & 1, t = lane & 15, g = lane >> 4, tl = 16 * tb + t, m = c * CHUNK + tl;
        const bf16_t* xrow = XPRE + (size_t)m * D + kh * 1024 + 8 * g;
#define LN1_UNPACK(R, X) { X[0] = __uint_as_float(R.x << 16); X[1] = __uint_as_float(R.x & 0xffff0000u); X[2] = __uint_as_float(R.y << 16); X[3] = __uint_as_float(R.y & 0xffff0000u); \
                           X[4] = __uint_as_float(R.z << 16); X[5] = __uint_as_float(R.z & 0xffff0000u); X[6] = __uint_as_float(R.w << 16); X[7] = __uint_as_float(R.w & 0xffff0000u); }
        float s = 0.f, q2 = 0.f;
#pragma unroll 1
        for (int k16 = 0; k16 < 32; k16 += 16) {
            pg8::u32x4 raw[16];
#pragma unroll
            for (int i = 0; i < 16; ++i) raw[i] = *(const pg8::u32x4*)(xrow + 32 * (k16 + i));
#pragma unroll
            for (int i = 0; i < 16; ++i) { float x[8]; LN1_UNPACK(raw[i], x); s += ((x[0] + x[1]) + (x[2] + x[3])) + ((x[4] + x[5]) + (x[6] + x[7]));
#pragma unroll
                for (int j = 0; j < 8; ++j) q2 = fmaf(x[j], x[j], q2); }
        }
        s += __shfl_xor(s, 16); s += __shfl_xor(s, 32); q2 += __shfl_xor(q2, 16); q2 += __shfl_xor(q2, 32);
        if (g == 0) { stat[kh * 64 + tl] = s; stat[128 + kh * 64 + tl] = q2; }
        __syncthreads();
        const float mu = (stat[tl] + stat[64 + tl]) * (1.f / D);
        const float rstd = rsqrtf(fmaxf((stat[128 + tl] + stat[192 + tl]) * (1.f / D) - mu * mu, 0.f) + EPS);
        pg8::f32x4 acc = {0.f, 0.f, 0.f, 0.f};
        {
            const LAS float* gp = gbl + kh * 1024 + 8 * g; const LAS float* bp = gbl + 2048 + kh * 1024 + 8 * g;
            bf16_t* orow = XB + (size_t)m * D + kh * 1024 + 8 * g;
            const LAS unsigned char* wf = lds + (kh * 32) * 1024 + lane * 16;
            pg8::u32x4 rn[4];
#pragma unroll
            for (int i = 0; i < 4; ++i) rn[i] = *(const pg8::u32x4*)(xrow + 32 * i);
#pragma unroll 1
            for (int k4 = 0; k4 < 32; k4 += 4) {
                pg8::u32x4 raw[4];
#pragma unroll
                for (int i = 0; i < 4; ++i) raw[i] = rn[i];
                if (k4 + 4 < 32) {
#pragma unroll
                    for (int i = 0; i < 4; ++i) rn[i] = *(const pg8::u32x4*)(xrow + 32 * (k4 + 4 + i));
                }
#pragma unroll
                for (int i = 0; i < 4; ++i) {
                    const int ks = k4 + i;
                    float x[8]; LN1_UNPACK(raw[i], x);
                    const pg8::f32x4 ga = *(const LAS pg8::f32x4*)(gp + 32 * ks), gb = *(const LAS pg8::f32x4*)(gp + 32 * ks + 4), ba = *(const LAS pg8::f32x4*)(bp + 32 * ks), bb = *(const LAS pg8::f32x4*)(bp + 32 * ks + 4);
                    const float gm[8] = {ga[0], ga[1], ga[2], ga[3], gb[0], gb[1], gb[2], gb[3]}, bt[8] = {ba[0], ba[1], ba[2], ba[3], bb[0], bb[1], bb[2], bb[3]};
                    float y[8];
#pragma unroll
                    for (int j = 0; j < 8; ++j) y[j] = (x[j] - mu) * rstd * gm[j] + bt[j];
                    pg8::u32x4 hi, lo;
                    hi.x = pg8::cvt_pk_bf16(y[0], y[1]); hi.y = pg8::cvt_pk_bf16(y[2], y[3]); hi.z = pg8::cvt_pk_bf16(y[4], y[5]); hi.w = pg8::cvt_pk_bf16(y[6], y[7]);
                    *(pg8::u32x4*)(orow + 32 * ks) = hi;
                    lo.x = pg8::cvt_pk_bf16(y[0] - __uint_as_float(hi.x << 16), y[1] - __uint_as_float(hi.x & 0xffff0000u));
                    lo.y = pg8::cvt_pk_bf16(y[2] - __uint_as_float(hi.y << 16), y[3] - __uint_as_float(hi.y & 0xffff0000u));
                    lo.z = pg8::cvt_pk_bf16(y[4] - __uint_as_float(hi.z << 16), y[5] - __uint_as_float(hi.z & 0xffff0000u));
                    lo.w = pg8::cvt_pk_bf16(y[6] - __uint_as_float(hi.w << 16), y[7] - __uint_as_float(hi.w & 0xffff0000u));
                    const s16x8 wh = *(const LAS s16x8*)(wf + ks * 1024), wl = *(const LAS s16x8*)(wf + 65536 + ks * 1024);
                    const s16x8 yh = __builtin_bit_cast(s16x8, hi), yl = __builtin_bit_cast(s16x8, lo);
                    acc = __builtin_amdgcn_mfma_f32_16x16x32_bf16(wh, yh, acc, 0, 0, 0);
                    acc = __builtin_amdgcn_mfma_f32_16x16x32_bf16(wh, yl, acc, 0, 0, 0);
                    acc = __builtin_amdgcn_mfma_f32_16x16x32_bf16(wl, yh, acc, 0, 0, 0);
                }
            }
        }
#undef LN1_UNPACK
        if (kh == 1) dpart[tb * 64 + lane] = acc;
        __syncthreads();
        if (kh == 0) {
            const pg8::f32x4 o = dpart[tb * 64 + lane];
            const float x0 = acc[0] + o[0], x1 = acc[1] + o[1], x2 = acc[2] + o[2], x3 = acc[3] + o[3];
            float mx = fmaxf(fmaxf(x0, x1), fmaxf(x2, x3)); mx = fmaxf(mx, __shfl_xor(mx, 16)); mx = fmaxf(mx, __shfl_xor(mx, 32));
            const float p0 = __expf(x0 - mx), p1 = __expf(x1 - mx), p2 = __expf(x2 - mx), p3 = __expf(x3 - mx);
            float sm = (p0 + p1) + (p2 + p3); sm += __shfl_xor(sm, 16); sm += __shfl_xor(sm, 32);
            const float inv = 1.f / sm;
            const float pr[4] = {p0 * inv, p1 * inv, p2 * inv, p3 * inv};
            const float4 rb4 = *(const float4*)(router_b + 4 * g);
            const float sl[4] = {pr[0] + rb4.x, pr[1] + rb4.y, pr[2] + rb4.z, pr[3] + rb4.w};
            const float h1 = fmaxf(sl[0], sl[1]), l1 = fminf(sl[0], sl[1]), h2 = fmaxf(sl[2], sl[3]), l2 = fminf(sl[2], sl[3]);
            float bgs = fmaxf(h1, h2) + fmaxf(fminf(h1, h2), fmaxf(l1, l2));
            int bg = g;
            { const float og = __shfl_xor(bgs, 16); const int oi = __shfl_xor(bg, 16); const bool tk = (og > bgs) || (og == bgs && oi < bg); bgs = tk ? og : bgs; bg = tk ? oi : bg; }
            { const float og = __shfl_xor(bgs, 32); const int oi = __shfl_xor(bg, 32); const bool tk = (og > bgs) || (og == bgs && oi < bg); bgs = tk ? og : bgs; bg = tk ? oi : bg; }
            if (bg == g) {
                int l1i = 0; float v1 = sl[0], q1 = pr[0];
#pragma unroll
                for (int i = 1; i < 4; ++i) { const bool b = sl[i] > v1; v1 = b ? sl[i] : v1; q1 = b ? pr[i] : q1; l1i = b ? i : l1i; }
                int l2i = 0; float v2 = -__builtin_inff(), q2b = 0.f;
#pragma unroll
                for (int i = 0; i < 4; ++i) { const bool b = (i != l1i) && (sl[i] > v2); v2 = b ? sl[i] : v2; q2b = b ? pr[i] : q2b; l2i = b ? i : l2i; }
                const int i1 = 4 * g + l1i, i2 = 4 * g + l2i; const float gsum = q1 + q2b;
                EXPID[m * 2] = i1; EXPID[m * 2 + 1] = i2; GATEW[m * 2] = q1 / gsum; GATEW[m * 2 + 1] = q2b / gsum;
                atomicAdd(&lh[i1], 1); atomicAdd(&lh[i2], 1);
            }
        }
        __syncthreads();
        { int t3 = tid; asm volatile("" : "+v"(t3)); if (t3 < 16) HIST[c * 16 + t3] = lh[t3]; }
    }
}

__device__ __noinline__ void ph_route_pos(unsigned char* ws) {
    const int tid = threadIdx.x, lane = tid & 63, wave = tid >> 6, gw = blockIdx.x * NWAVES + wave, NGW = gridDim.x * NWAVES; float* ldsf = (float*)lds_raw;
    (void)lane; (void)wave; (void)gw; (void)NGW; (void)ldsf;
            int* hl = (int*)ldsf;
            int* tot = hl + NCHUNK * 16;
            int* seg = tot + 16;
            __syncthreads();
            for (int i = tid; i < NCHUNK * 16; i += NTHR) hl[i] = HIST[i];
            __syncthreads();
            if (tid < 16) { int run = 0; for (int c = 0; c < NCHUNK; ++c) { const int h = hl[c * 16 + tid]; hl[c * 16 + tid] = run; run += h; } tot[tid] = run; }
            __syncthreads();
            if (tid == 0) { int s = 0; for (int e = 0; e < 16; ++e) { seg[e] = s; s += (tot[e] + 255) & ~255; } seg[16] = s; }
            __syncthreads();
            for (int c = blockIdx.x; c < NCHUNK; c += gridDim.x) {
                if (wave == 0) {
                    const int m = c * CHUNK + lane;
                    const int e0 = EXPID[m * 2], e1 = EXPID[m * 2 + 1];
                    const unsigned long long lt = (1ull << lane) - 1ull;
                    int r0 = 0, r1 = 0;
                    for (int e = 0; e < 16; ++e) {
                        const unsigned long long m0 = __ballot(e0 == e), m1 = __ballot(e1 == e);
                        const int below = __popcll(m0 & lt) + __popcll(m1 & lt);
                        if (e0 == e) r0 = below;
                        if (e1 == e) r1 = below;
                    }
                    const int p0 = seg[e0] + hl[c * 16 + e0] + r0, p1 = seg[e1] + hl[c * 16 + e1] + r1;
                    POS[m * 2] = p0; POS[m * 2 + 1] = p1;
                    ROWTOK[p0] = m; ROWTOK[p1] = m; ROWGATE[p0] = GATEW[m * 2]; ROWGATE[p1] = GATEW[m * 2 + 1];
                }
            }
            if (blockIdx.x == 0) {
                for (int e = 0; e < 16; ++e) { for (int r = seg[e] + tot[e] + tid; r < seg[e + 1]; r += NTHR) { ROWTOK[r] = 0; ROWGATE[r] = 0.f; } }
                if (tid < 160) { int e = 0; const int row = tid * 256; for (int q = 0; q < 16; ++q) if (row >= seg[q]) e = q; TILEE[tid] = e; }
                __syncthreads();
                if (tid == 0) TILEE[159] = seg[16] / 256;
            }
}

__device__ __forceinline__ void ph_ln2(const float* g2, const float* b2, float* out, int last, unsigned char* ws) {
    int tid_ = threadIdx.x; asm volatile("" : "+v"(tid_));
    const int tid = tid_, lane = tid & 63, wave = tid >> 6, gw = blockIdx.x * NWAVES + wave, NGW = gridDim.x * NWAVES; float* ldsf = (float*)lds_raw;
    (void)lane; (void)wave; (void)gw; (void)NGW; (void)ldsf;
            int m = gw;
            if (m >= M) return;
            uint2 xr[8], y0[8], y1[8];
            int np0 = 0, np1 = 0;
            { const int p0 = POS[m * 2], p1 = POS[m * 2 + 1];
#pragma unroll
              for (int jj = 0; jj < 8; ++jj) { xr[jj] = *(const uint2*)(XB + (size_t)m * D + 4 * lane + 256 * jj); y0[jj] = *(const uint2*)(YS + (size_t)p0 * D + 4 * lane + 256 * jj); y1[jj] = *(const uint2*)(YS + (size_t)p1 * D + 4 * lane + 256 * jj); }
              if (m + NGW < M) { np0 = POS[(m + NGW) * 2]; np1 = POS[(m + NGW) * 2 + 1]; } }
#pragma unroll 1
            for (; m < M; m += NGW) {
                float4 v[8];
#pragma unroll
                for (int jj = 0; jj < 8; ++jj) {
                    v[jj].x = ALPHA * __uint_as_float(xr[jj].x << 16) + __uint_as_float(y0[jj].x << 16) + __uint_as_float(y1[jj].x << 16);
                    v[jj].y = ALPHA * __uint_as_float(xr[jj].x & 0xffff0000u) + __uint_as_float(y0[jj].x & 0xffff0000u) + __uint_as_float(y1[jj].x & 0xffff0000u);
                    v[jj].z = ALPHA * __uint_as_float(xr[jj].y << 16) + __uint_as_float(y0[jj].y << 16) + __uint_as_float(y1[jj].y << 16);
                    v[jj].w = ALPHA * __uint_as_float(xr[jj].y & 0xffff0000u) + __uint_as_float(y0[jj].y & 0xffff0000u) + __uint_as_float(y1[jj].y & 0xffff0000u);
                }
                const int mn = m + NGW;
                if (mn < M) {
                    const int p0 = np0, p1 = np1;
#pragma unroll
                    for (int jj = 0; jj < 8; ++jj) { xr[jj] = *(const uint2*)(XB + (size_t)mn * D + 4 * lane + 256 * jj); y0[jj] = *(const uint2*)(YS + (size_t)p0 * D + 4 * lane + 256 * jj); y1[jj] = *(const uint2*)(YS + (size_t)p1 * D + 4 * lane + 256 * jj); }
                    if (mn + NGW < M) { np0 = POS[(mn + NGW) * 2]; np1 = POS[(mn + NGW) * 2 + 1]; }
                }
                ln_row(v, g2, b2, lane);
                if (last) {
#pragma unroll
                    for (int jj = 0; jj < 8; ++jj) *(float4*)(out + (size_t)m * D + 4 * lane + 256 * jj) = v[jj];
                } else store_row_bf16(XB + (size_t)m * D, v, lane);
            }
}

__global__ void __launch_bounds__(NTHR, 2) mega_fwd(Args a) {
    const int tid0 = threadIdx.x;
    unsigned* ctl = (unsigned*)(a.ws + WS_CTL);
    volatile LAS unsigned* misc = (volatile LAS unsigned*)((LAS unsigned char*)lds_raw + LDS_MISC);
    if (tid0 < 64) misc[tid0] = 0u;
    __syncthreads();
#if MK_SINGLE
    XcdBarrier bar = xcd_barrier_post(ctl + 4096, misc + 8);
#define GRID_BAR() xcd_barrier(bar)
#else
    (void)ctl;
#define GRID_BAR() do { } while (0)
#endif
    const int lo = a.ph_lo, hi = a.ph_hi;
    for (int pc = lo; pc < hi; ++pc) {
        bool ran = true, is_gemm = false; int do_prep = 0;
        pg8::GemmDesc d{};
        const __attribute__((address_space(4))) Args* ap = (const __attribute__((address_space(4))) Args*)__builtin_amdgcn_kernarg_segment_ptr();
        asm volatile("" : "+s"(ap));
#define a (*ap)
        unsigned char* ws = ap->ws;
        if (pc == 0) ph_pre(a.x, a.rel_bias, ws);
        else {
            const int q = pc - 1, L = q / 14, s = q % 14, j = L >> 1; const bool dsa = (L & 1) == 0;
            switch (s) {
            case 0:
                if (L == 0) do_prep = 1; else if (dsa) ph_prep_dsa_fold(a.a_w_uq + (size_t)j * QL * HW, a.a_w_uk + (size_t)j * H * HD * KVL, W_Q(L), W_UV(L)); else ran = false;
                break;
            case 1: is_gemm = true;
                if (dsa) { d.A = XB; d.Bt = W_IN(L); d.K = D; d.lda2 = D * 2; d.ldb2 = D * 2; d.btile = (size_t)256 * D * 2; d.nM = M / 256; d.nN = 4; d.epi = pg8::EPI_F32; d.out = PRAW; d.ldc = 1024; }
                else     { d.A = XB; d.Bt = W_QKV(L); d.K = D; d.lda2 = D * 2; d.ldb2 = D * 2; d.btile = (size_t)256 * D * 2; d.nM = M / 256; d.nN = 3 * HW / 256; d.epi = pg8::EPI_QKVH; d.out = QKV; d.ldc = 3 * HW; }
                break;
            case 2: if (dsa) ph_dsa_norms(a.a_q_norm + (size_t)j * QL, a.a_kv_norm + (size_t)j * KVL, ws); else ran = false; break;
            case 3: if (dsa) { is_gemm = true; d.A = CQ; d.Bt = W_Q(L); d.K = QL; d.lda2 = QL * 2; d.ldb2 = QL * 2; d.btile = (size_t)256 * QL * 2; d.nM = M / 256; d.nN = QALD / 256; d.epi = pg8::EPI_BF16; d.out = QALL; d.ldc = QALD; }
                    else ran = false; break;
            case 4: if (dsa) ph_dsa_index(ws); else ran = false; break;
            case 5: if (dsa) ph_dsa_topk(ws); else ran = false; break;
            case 6: if (dsa) ph_dsa_attn(ws); else ph_dil_attn(ws, (unsigned*)(ws + WS_CTL) + 12288 + 128 * L); break;
            case 7: if (dsa) { is_gemm = true; d.A = OLAT; d.Bt = W_UV(L); d.K = 512; d.lda2 = 4096 * 2; d.acol2 = 512 * 2; d.ldb2 = 512 * 2; d.btile = (size_t)256 * 512 * 2; d.nM = M / 256; d.nN = HW / 256;
                               d.epi = pg8::EPI_BF16; d.out = OB; d.ldc = HW; }
                    else ran = false; break;
            case 8: is_gemm = true; d.A = OB; d.Bt = dsa ? W_O(L) : W_O_D(L); d.K = HW; d.lda2 = HW * 2; d.ldb2 = HW * 2; d.btile = (size_t)256 * HW * 2; d.nM = M / 256; d.nN = D / 256;
                    d.epi = pg8::EPI_RESID; d.out = XPRE; d.aux = XB; d.ldc = D; d.alpha = ALPHA; break;
            case 9: ph_ln1_router(a.ln1_g + (size_t)L * D, a.ln1_b + (size_t)L * D, a.router_w, a.router_b, ws); break;
            case 10: ph_route_pos(ws); break;
            case 11: is_gemm = true; d.A = XB; d.Bt = W_GU(L); d.K = D; d.lda2 = D * 2; d.ldb2 = D * 2; d.btile = (size_t)256 * D * 2; d.bexp = (size_t)1024 * D * 2; d.nM = __builtin_amdgcn_readfirstlane(ld_mut(TILEE + 159)); d.nN = 4;
                     d.rowtok = ROWTOK; d.tilee = TILEE; d.epi = pg8::EPI_SWIGLU; d.out = HID; d.aux = ROWGATE; d.ldc = DE; if (L + 1 < DEPTH) do_prep = 2; break;
            case 12: is_gemm = true; d.A = HID; d.Bt = W_DN(L); d.K = DE; d.lda2 = DE * 2; d.ldb2 = DE * 2; d.btile = (size_t)256 * DE * 2; d.bexp = (size_t)D * DE * 2; d.nM = __builtin_amdgcn_readfirstlane(ld_mut(TILEE + 159)); d.nN = D / 256;
                     d.tilee = TILEE; d.epi = pg8::EPI_BF16; d.out = YS; d.ldc = D; if (L + 1 < DEPTH) do_prep = 2; break;
            default: ph_ln2(a.ln2_g + (size_t)L * D, a.ln2_b + (size_t)L * D, a.out, L == DEPTH - 1 ? 1 : 0, ws); break;
            }
        }
#undef a
        if (is_gemm) pg8::gemm_run((PG8_LAS unsigned char*)lds_raw, d);
#define a (*ap)
        if (do_prep) {
            const int Lp = (do_prep == 1) ? 0 : (pc - 1) / 14 + 1, jp = Lp >> 1; const bool pdsa = (Lp & 1) == 0;
            unsigned* cnt = (do_prep == 1) ? nullptr : (unsigned*)(ap->ws + WS_CTL) + 8192 + 64 * Lp;
            int pend = -1, seg = 0;
            const float* wg = a.moe_w_gate + (size_t)Lp * NE * D * DE; const float* wu = a.moe_w_up + (size_t)Lp * NE * D * DE; const float* wd = a.moe_w_down + (size_t)Lp * NE * DE * D;
            pend = cvt_matrix(wg, (size_t)D * DE, NE, D, DE, DE, DE, W_GU(Lp), 1.f, 1024, 7, 256, 127, 0, D, 0, cnt, seg, pend); seg += 1024;
            pend = cvt_matrix(wu, (size_t)D * DE, NE, D, DE, DE, DE, W_GU(Lp), 1.f, 1024, 7, 256, 127, 128, D, 0, cnt, seg, pend); seg += 1024;
            pend = cvt_matrix(wd, (size_t)DE * D, NE, DE, D, D, D, W_DN(Lp), 1.f, D, 31, 0, 0x7fffffff, 0, DE, 0, cnt, seg, pend); seg += 1024;
            if (pdsa) {
                const float* w_in = a.a_w_in + (size_t)jp * D * AIN; const float* w_uqi = a.a_w_uq_idx + (size_t)jp * QL * IH * IDM; const float* w_uv = a.a_w_uv + (size_t)jp * H * KVL * HD; const float* w_o = a.a_w_o + (size_t)jp * HW * D;
                pend = cvt_matrix(w_in, 0, 1, D, 1024, AIN, AIN, W_IN(Lp), 1.f, 0, 31, 0, 0x7fffffff, 0, D, 0, cnt, seg, pend); seg += 128;
                pend = cvt_matrix(w_uqi, 0, 1, QL, IH * IDM, IH * IDM, IH * IDM, W_Q(Lp), 0.125f, 0, 31, 0, 0x7fffffff, 4096, QL, 0, cnt, seg, pend); seg += 32;
                pend = cvt_matrix(w_o, 0, 1, HW, D, D, D, W_O(Lp), 1.f, 0, 31, 0, 0x7fffffff, 0, HW, 0, cnt, seg, pend); seg += 256;
                pend = cvt_matrix(w_uv, (size_t)KVL * HD, H, KVL, HD, HD, HD, W_UV(Lp), 1.f, HD, 31, 0, 0x7fffffff, 0, 512, 256, cnt, seg, pend); seg += 32;
                if (do_prep == 1) ph_prep_dsa_fold(a.a_w_uq + (size_t)jp * QL * HW, a.a_w_uk + (size_t)jp * H * HD * KVL, W_Q(Lp), W_UV(Lp));
            } else {
                const float* w_in = a.b_w_in + (size_t)jp * D * 3 * HW; const float* w_o = a.b_w_o + (size_t)jp * HW * D;
                pend = cvt_matrix(w_in, 0, 1, D, HW, HW, 3 * HW, W_QKV(Lp), 0.12751743082459868f  , 0, 31, 0, 0x7fffffff, 0, D, 0, cnt, seg, pend); seg += 256;
                pend = cvt_matrix(w_in + HW, 0, 1, D, 2 * HW, 2 * HW, 3 * HW, W_QKV(Lp), 1.f, 0, 31, 0, 0x7fffffff, HW, D, 0, cnt, seg, pend); seg += 512;
                pend = cvt_matrix(w_o, 0, 1, HW, D, D, D, W_O_D(Lp), 1.f, 0, 31, 0, 0x7fffffff, 0, HW, 0, cnt, seg, pend); seg += 256;
            }
        }
#undef a
        bool skipbar = false;
        if (MK_SINGLE) { if (pc == 0) skipbar = true; else { const int q2 = pc - 1, L2_ = q2 / 14, s2 = q2 % 14; if (s2 == 13 && (L2_ & 1) == 1 && L2_ + 1 < DEPTH) skipbar = true; } }
        if (ran && !skipbar && pc + 1 < hi) GRID_BAR();
    }
}
constexpr int N_PHASES = 1 + DEPTH * 14;
}

extern "C" void kernel_launch(void* const* d_in, const int* in_sizes, int n_in, void* d_out, int out_size, void* d_ws, size_t ws_size, hipStream_t stream) {
    static int grid = 0;
    if (grid == 0) {
        if (n_in != 21 || in_sizes[0] != M * D || out_size != M * D || ws_size < WS_END) {
            fprintf(stderr, "kernel_launch: unexpected shapes: n_in %d in0 %d out %d ws %zu (need %zu)\n", n_in, n_in > 0 ? in_sizes[0] : -1, out_size, ws_size, (size_t)WS_END);
            grid = -1; return; }
        int dev = 0, cus = 0, per_cu = 0;
        if (hipGetDevice(&dev) != hipSuccess || hipDeviceGetAttribute(&cus, hipDeviceAttributeMultiprocessorCount, dev) != hipSuccess) { grid = -1; return; }
        if (hipFuncSetAttribute((const void*)mega_fwd, hipFuncAttributeMaxDynamicSharedMemorySize, LDS_BYTES) != hipSuccess) { fprintf(stderr, "kernel_launch: hipFuncSetAttribute failed\n"); grid = -1; return; }
        if (hipOccupancyMaxActiveBlocksPerMultiprocessor(&per_cu, (const void*)mega_fwd, NTHR, LDS_BYTES) != hipSuccess || per_cu < 1)
            fprintf(stderr, "kernel_launch: occupancy query reports %d workgroups per CU\n", per_cu);
        (void)hipGetLastError();
        grid = cus;
    }
    if (grid < 0) return;
    if (hipMemsetAsync((char*)d_ws + WS_CTL, 0, CTL_BYTES, stream) != hipSuccess) return;
    Args a{};
    a.x = (const float*)d_in[0]; a.rel_bias = (const float*)d_in[1]; a.router_w = (const float*)d_in[2]; a.router_b = (const float*)d_in[3];
    a.a_w_in = (const float*)d_in[4]; a.a_q_norm = (const float*)d_in[5]; a.a_kv_norm = (const float*)d_in[6]; a.a_w_uq = (const float*)d_in[7]; a.a_w_uq_idx = (const float*)d_in[8];
    a.a_w_uk = (const float*)d_in[9]; a.a_w_uv = (const float*)d_in[10]; a.a_w_o = (const float*)d_in[11]; a.b_w_in = (const float*)d_in[12]; a.b_w_o = (const float*)d_in[13];
    a.ln1_g = (const float*)d_in[14]; a.ln1_b = (const float*)d_in[15]; a.ln2_g = (const float*)d_in[16]; a.ln2_b = (const float*)d_in[17];
    a.moe_w_gate = (const float*)d_in[18]; a.moe_w_up = (const float*)d_in[19]; a.moe_w_down = (const float*)d_in[20];
    a.out = (float*)d_out; a.ws = (unsigned char*)d_ws;
#if MK_SINGLE
    a.ph_lo = 0; a.ph_hi = N_PHASES;
    hipLaunchKernelGGL(mega_fwd, dim3(grid), dim3(NTHR), LDS_BYTES, stream, a);
#else
    for (int p = 0; p < N_PHASES; ++p) { a.ph_lo = p; a.ph_hi = p + 1; hipLaunchKernelGGL(mega_fwd, dim3(grid), dim3(NTHR), LDS_BYTES, stream, a); }
#endif
}
```

```cpp
#include <hip/hip_runtime.h>
#include <cstdio>
#include <cstdint>

#ifndef MK_SINGLE
#define MK_SINGLE 1
#endif

namespace {
constexpr int D = 2048, NB_ = 4, T = 4096, DEPTH = 4, M = NB_ * T;
constexpr int H = 16, HD = 128, HW = H * HD, QL = 512, KVL = 256, IH = 16, IDM = 64, TOPK = 256;
constexpr int AIN = QL + KVL + IDM + IH;
constexpr int NBUCK = 32, NE = 16, NG = 4, EPG = 4, DE = 512;
constexpr float ALPHA = 1.6817928305074292f;
constexpr float EPS = 1e-5f;
constexpr int NTHR = 512, NWAVES = 8;
constexpr int RMAX = 36864;
constexpr int NCHUNK = 256, CHUNK = M / NCHUNK;

constexpr size_t MiB = 1u << 20;
constexpr size_t WS_CTL = 0, CTL_BYTES = 1 * MiB;
constexpr size_t WS_BIAS = 1 * MiB;
constexpr size_t WS_EXPID = 2 * MiB;
constexpr size_t WS_GATEW = WS_EXPID + (size_t)M * 2 * 4;
constexpr size_t WS_POS = WS_GATEW + (size_t)M * 2 * 4;
constexpr size_t WS_ROWTOK = WS_POS + (size_t)M * 2 * 4;
constexpr size_t WS_ROWGATE = WS_ROWTOK + (size_t)RMAX * 4;
constexpr size_t WS_HIST = WS_ROWGATE + (size_t)RMAX * 4;
constexpr size_t WS_TILEE = WS_HIST + (size_t)NCHUNK * 16 * 4;
constexpr size_t WS_NSEL = WS_TILEE + 1024;
constexpr size_t WS_XB = 8 * MiB;
constexpr size_t WS_XPRE = 72 * MiB;
constexpr size_t WS_WL = 200 * MiB;
constexpr size_t WL_STRIDE = 128 * MiB;
constexpr size_t WS_AR = 456 * MiB;
constexpr int QALD = 5120;
constexpr size_t WS_END = 1034 * MiB;
constexpr size_t AR_PRAW = WS_AR;
constexpr size_t AR_CQ = WS_AR + 64 * MiB;
constexpr size_t AR_CKV = WS_AR + 80 * MiB;
constexpr size_t AR_KIDX = WS_AR + 88 * MiB;
constexpr size_t AR_WIDX = WS_AR + 90 * MiB;
constexpr size_t AR_SEL = WS_AR + 92 * MiB;
constexpr size_t AR_QALL = WS_AR + 108 * MiB;
constexpr size_t AR_SC = WS_AR + 268 * MiB;
constexpr size_t AR_OLAT = 906 * MiB;
constexpr size_t AR_OB = WS_AR + 0 * MiB;
constexpr size_t AR_QKV = WS_AR + 100 * MiB;
constexpr size_t AR_DST = WS_AR + 300 * MiB;
constexpr size_t AR_DML = WS_AR + 336 * MiB;
constexpr size_t AR_HID = WS_AR + 0 * MiB;
constexpr size_t AR_YS = WS_AR + 40 * MiB;
constexpr size_t SC_PER_B = (size_t)1024 * 128 * 129 / 2;
static_assert(AR_SC + 4 * SC_PER_B * 4 <= WS_END, "arena");
static_assert(AR_YS + (size_t)RMAX * D * 2 <= WS_END, "arena");
constexpr size_t WL_GU = WS_WL;
constexpr size_t WL_DN = WS_WL + 64 * MiB;
constexpr size_t WL_MIX = WS_WL + 96 * MiB;
constexpr size_t WL_WIN = WL_MIX;
constexpr size_t WL_WQ = WL_MIX + 4 * MiB;
constexpr size_t WL_WUV = WL_MIX + 10 * MiB;
constexpr size_t WL_WO = WL_MIX + 12 * MiB;
constexpr size_t WL_WQKV = WL_MIX + 0 * MiB;
constexpr size_t WL_WO_D = WL_MIX + 24 * MiB;
static_assert(WL_WO_D + 8 * MiB <= WS_WL + WL_STRIDE && WS_WL + 2 * WL_STRIDE <= WS_AR, "weight scratch");

constexpr int LDS_BYTES = 163840;
constexpr int LDS_MISC = 143360;

typedef unsigned short bf16_t;
#define LAS __attribute__((address_space(3)))

__device__ __forceinline__ float bf2f(bf16_t v) { return __uint_as_float(((unsigned)v) << 16); }
__device__ __forceinline__ bf16_t f2bf(float f) { unsigned u = __float_as_uint(f); u += 0x7fffu + ((u >> 16) & 1u); return (bf16_t)(u >> 16); }
__device__ __forceinline__ float wave_sum(float v) {
#pragma unroll
    for (int o = 1; o < 64; o <<= 1) v += __shfl_xor(v, o);
    return v;
}
__device__ __forceinline__ int wave_sum_i(int v) {
#pragma unroll
    for (int o = 1; o < 64; o <<= 1) v += __shfl_xor(v, o);
    return v;
}
__device__ __forceinline__ float wave_max(float v) {
#pragma unroll
    for (int o = 1; o < 64; o <<= 1) v = fmaxf(v, __shfl_xor(v, o));
    return v;
}
__device__ __forceinline__ float wave_min(float v) {
#pragma unroll
    for (int o = 1; o < 64; o <<= 1) v = fminf(v, __shfl_xor(v, o));
    return v;
}
__device__ __forceinline__ int wave_min_i(int v) {
#pragma unroll
    for (int o = 1; o < 64; o <<= 1) { int t = __shfl_xor(v, o); v = t < v ? t : v; }
    return v;
}

__device__ __forceinline__ int wave_scan_dpp(int x) {
    x += __builtin_amdgcn_update_dpp(0, x, 0x111, 0xf, 0xf, false);
    x += __builtin_amdgcn_update_dpp(0, x, 0x112, 0xf, 0xf, false);
    x += __builtin_amdgcn_update_dpp(0, x, 0x114, 0xf, 0xf, false);
    x += __builtin_amdgcn_update_dpp(0, x, 0x118, 0xf, 0xf, false);
    x += __builtin_amdgcn_update_dpp(0, x, 0x142, 0xa, 0xf, false);
    x += __builtin_amdgcn_update_dpp(0, x, 0x143, 0xc, 0xf, false);
    return x;
}
__device__ __forceinline__ float wave_max_dpp(float v) {
    const int ninf = __float_as_int(-__builtin_inff());
#define WMX(ctrl, rm) v = fmaxf(v, __int_as_float(__builtin_amdgcn_update_dpp(ninf, __float_as_int(v), ctrl, rm, 0xf, false)))
    WMX(0x111, 0xf); WMX(0x112, 0xf); WMX(0x114, 0xf); WMX(0x118, 0xf); WMX(0x142, 0xa); WMX(0x143, 0xc);
#undef WMX
    return __int_as_float(__builtin_amdgcn_readlane(__float_as_int(v), 63));
}
__device__ __forceinline__ float wave_min_dpp(float v) {
    const int pinf = __float_as_int(__builtin_inff());
#define WMN(ctrl, rm) v = fminf(v, __int_as_float(__builtin_amdgcn_update_dpp(pinf, __float_as_int(v), ctrl, rm, 0xf, false)))
    WMN(0x111, 0xf); WMN(0x112, 0xf); WMN(0x114, 0xf); WMN(0x118, 0xf); WMN(0x142, 0xa); WMN(0x143, 0xc);
#undef WMN
    return __int_as_float(__builtin_amdgcn_readlane(__float_as_int(v), 63));
}
__device__ __forceinline__ int wave_sum_dpp(int x) {
    x += __builtin_amdgcn_update_dpp(0, x, 0x111, 0xf, 0xf, false);
    x += __builtin_amdgcn_update_dpp(0, x, 0x112, 0xf, 0xf, false);
    x += __builtin_amdgcn_update_dpp(0, x, 0x114, 0xf, 0xf, false);
    x += __builtin_amdgcn_update_dpp(0, x, 0x118, 0xf, 0xf, false);
    x += __builtin_amdgcn_update_dpp(0, x, 0x142, 0xa, 0xf, false);
    x += __builtin_amdgcn_update_dpp(0, x, 0x143, 0xc, 0xf, false);
    return __builtin_amdgcn_readlane(x, 63);
}
__device__ __forceinline__ int ld_mut(const int* p) { return __hip_atomic_load(p, __ATOMIC_RELAXED, __HIP_MEMORY_SCOPE_AGENT); }

#define XB_TMO      128
#define XB_XCNT(j)  (256  + 64 * (j))
#define XB_XSUB(j)  (1280 + 64 * (j))
#define XB_XGEN(j)  (2304 + 64 * (j))
#define XB_TOP      3328
#define XB_TOPGEN   3392
#define XCD_BAR_WORDS 3456
#define XB_SPIN_CAP (1u << 18)

__device__ __forceinline__ unsigned xb_ld(unsigned* p)              { return __hip_atomic_load(p, __ATOMIC_RELAXED, __HIP_MEMORY_SCOPE_AGENT); }
__device__ __forceinline__ unsigned xb_add(unsigned* p, unsigned v) { return __hip_atomic_fetch_add(p, v, __ATOMIC_RELAXED, __HIP_MEMORY_SCOPE_AGENT); }
__device__ __forceinline__ unsigned xb_xcc_id() { return (unsigned)__builtin_amdgcn_s_getreg((3 << 11) | 20) & 0xFu; }
#define XB_SPIN(cond, bar) do { unsigned _sp = 0; while (cond) { __builtin_amdgcn_s_sleep(1); \
    if ((++_sp & 255u) == 0u) { if (xb_ld(&(bar)[XB_TMO])) break; if (_sp > XB_SPIN_CAP) { atomicAdd(&(bar)[XB_TMO], 1u); break; } } } } while (0)

struct XcdBarrier {
    unsigned* bar; unsigned x;
    volatile LAS unsigned* st;
};
__device__ __forceinline__ XcdBarrier xcd_barrier_post(unsigned* bar, volatile LAS unsigned* st) {
    XcdBarrier b; b.bar = bar; b.x = xb_xcc_id(); b.st = st;
    if (threadIdx.x == 0) (void)xb_add(&bar[XB_XCNT(b.x)], 1u);
    return b;
}
__device__ __forceinline__ void xcd_barrier_complete(unsigned* bar, unsigned x, unsigned& nloc, unsigned& nx) {
    const unsigned G = gridDim.x * gridDim.y * gridDim.z;
    unsigned sum, cnt, mine, sp = 0u;
    for (;;) {
        sum = 0u; cnt = 0u; mine = 0u;
#pragma unroll
        for (unsigned j = 0; j < 16; ++j) { const unsigned c = xb_ld(&bar[XB_XCNT(j)]); sum += c; cnt += (c > 0u) ? 1u : 0u; mine = (j == x) ? c : mine; }
        if (sum == G) break;
        __builtin_amdgcn_s_sleep(1);
        if ((++sp & 255u) == 0u) { if (xb_ld(&bar[XB_TMO])) break; if (sp > XB_SPIN_CAP) { atomicAdd(&bar[XB_TMO], 1u); break; } }
    }
    nloc = mine > 0u ? mine : 1u; nx = cnt > 0u ? cnt : 1u;
}
__device__ __forceinline__ void xcd_barrier(const XcdBarrier& b) {
    asm volatile("s_waitcnt vmcnt(0)" ::: "memory");
    __syncthreads();
    if (threadIdx.x == 0) {
        unsigned* bar = b.bar;
        __builtin_amdgcn_s_waitcnt(0);
        unsigned nloc = b.st[0], nx = b.st[1];
        if (nloc == 0u) { xcd_barrier_complete(bar, b.x, nloc, nx); b.st[0] = nloc; b.st[1] = nx; }
        const unsigned old = xb_add(&bar[XB_XSUB(b.x)], 1u);
        const unsigned gen = old / nloc;
        if (old + 1u == (gen + 1u) * nloc) {
            __builtin_amdgcn_fence(__ATOMIC_RELEASE, "agent");
            asm volatile("s_waitcnt vmcnt(0)" ::: "memory");
            const unsigned og = xb_add(&bar[XB_TOP], 1u);
            const unsigned tg = og / nx;
            if (og + 1u == (tg + 1u) * nx) xb_add(&bar[XB_TOPGEN], 1u);
            else XB_SPIN(xb_ld(&bar[XB_TOPGEN]) == tg, bar);
            __builtin_amdgcn_fence(__ATOMIC_ACQUIRE, "agent");
            xb_add(&bar[XB_XGEN(b.x)], 1u);
            asm volatile("s_waitcnt vmcnt(0)" ::: "memory");
        } else {
            XB_SPIN(xb_ld(&bar[XB_XGEN(b.x)]) == gen, bar);
            __builtin_amdgcn_fence(__ATOMIC_ACQUIRE, "agent");
            asm volatile("s_waitcnt vmcnt(0)" ::: "memory");
        }
    }
    __syncthreads();
}

template <class AF, class BF, class EF>
__device__ __forceinline__ void gemm_naive(float* lds, int nbatch, int Mr, int N, int K, AF af, BF bf, EF ef) {
    float* As = lds; float* Bs = lds + 16 * 132;
    const int tid = threadIdx.x, ty = tid >> 4, tx = tid & 15;
    const int tm = Mr / 128, tn = (N + 63) / 64, per = tm * tn, total = per * nbatch;
    for (int u = blockIdx.x; u < total; u += gridDim.x) {
        const int bi = u / per, rr = u % per, m0 = (rr / tn) * 128, n0 = (rr % tn) * 64;
        float acc[4][4];
#pragma unroll
        for (int i = 0; i < 4; ++i)
#pragma unroll
            for (int j = 0; j < 4; ++j) acc[i][j] = 0.f;
        for (int k0 = 0; k0 < K; k0 += 16) {
            __syncthreads();
#pragma unroll
            for (int i = 0; i < 4; ++i) { const int e = tid + 512 * i, row = e >> 4, kk = e & 15; As[kk * 132 + row] = af(bi, m0 + row, k0 + kk); }
#pragma unroll
            for (int i = 0; i < 2; ++i) { const int e = tid + 512 * i, kk = e >> 6, n = e & 63; Bs[kk * 68 + n] = (n0 + n < N) ? bf(bi, k0 + kk, n0 + n) : 0.f; }
            __syncthreads();
#pragma unroll
            for (int kk = 0; kk < 16; ++kk) {
                const float4 a = *(const float4*)(As + kk * 132 + ty * 4);
                const float4 b = *(const float4*)(Bs + kk * 68 + tx * 4);
                const float av[4] = {a.x, a.y, a.z, a.w}, bv[4] = {b.x, b.y, b.z, b.w};
#pragma unroll
                for (int i = 0; i < 4; ++i)
#pragma unroll
                    for (int j = 0; j < 4; ++j) acc[i][j] = fmaf(av[i], bv[j], acc[i][j]);
            }
        }
#pragma unroll
        for (int i = 0; i < 4; ++i)
#pragma unroll
            for (int j = 0; j < 4; ++j) { const int n = n0 + tx * 4 + j; if (n < N) ef(bi, m0 + ty * 4 + i, n, acc[i][j]); }
    }
    __syncthreads();
}

__device__ __forceinline__ int t5_bucket(int n) {
    if (n < 16) return n;
    const float nf = (float)n;
    int large = 16 + (int)(logf(nf / 16.0f) / 4.852030263919617f * 16.0f);
    return large < 31 ? large : 31;
}
__device__ __forceinline__ size_t sc_off(int b, int t) { const int qb = t >> 5; return (size_t)b * SC_PER_B + (size_t)512 * qb * (qb + 1) + (size_t)(t & 31) * (32 * (qb + 1)); }

struct Args {
    const float* x; const float* rel_bias; const float* router_w; const float* router_b;
    const float* a_w_in; const float* a_q_norm; const float* a_kv_norm; const float* a_w_uq; const float* a_w_uq_idx;
    const float* a_w_uk; const float* a_w_uv; const float* a_w_o; const float* b_w_in; const float* b_w_o;
    const float* ln1_g; const float* ln1_b; const float* ln2_g; const float* ln2_b;
    const float* moe_w_gate; const float* moe_w_up; const float* moe_w_down;
    float* out; unsigned char* ws; int ph_lo, ph_hi;
};

template <class V4>
__device__ __forceinline__ void ln_row(V4 (&v)[8], const float* g, const float* bta, int lane) {
    float s = 0.f;
#pragma unroll
    for (int j = 0; j < 8; ++j) s += (v[j].x + v[j].y) + (v[j].z + v[j].w);
    const float mu = wave_sum(s) * (1.f / D);
    float q = 0.f;
#pragma unroll
    for (int j = 0; j < 8; ++j) { v[j].x -= mu; v[j].y -= mu; v[j].z -= mu; v[j].w -= mu; q += (v[j].x * v[j].x + v[j].y * v[j].y) + (v[j].z * v[j].z + v[j].w * v[j].w); }
    const float rstd = rsqrtf(wave_sum(q) * (1.f / D) + EPS);
#pragma unroll
    for (int j = 0; j < 8; ++j) {
        const float4 gg = *(const float4*)(g + 4 * lane + 256 * j), bb = *(const float4*)(bta + 4 * lane + 256 * j);
        v[j].x = v[j].x * rstd * gg.x + bb.x; v[j].y = v[j].y * rstd * gg.y + bb.y; v[j].z = v[j].z * rstd * gg.z + bb.z; v[j].w = v[j].w * rstd * gg.w + bb.w;
        if (j == 3) asm volatile("" ::: "memory");
    }
}
template <class V4>
__device__ __forceinline__ void store_row_bf16(bf16_t* dst, const V4 (&v)[8], int lane) {
#pragma unroll
    for (int j = 0; j < 8; ++j) {
        uint2 o; o.x = (unsigned)f2bf(v[j].x) | ((unsigned)f2bf(v[j].y) << 16); o.y = (unsigned)f2bf(v[j].z) | ((unsigned)f2bf(v[j].w) << 16);
        *(uint2*)(dst + 4 * lane + 256 * j) = o;
    }
}

extern __shared__ __attribute__((aligned(16))) unsigned char lds_raw[];
#define BIAS_T ((float*)(ws + WS_BIAS))
#define EXPID ((int*)(ws + WS_EXPID))
#define GATEW ((float*)(ws + WS_GATEW))
#define POS ((int*)(ws + WS_POS))
#define ROWTOK ((int*)(ws + WS_ROWTOK))
#define ROWGATE ((float*)(ws + WS_ROWGATE))
#define HIST ((int*)(ws + WS_HIST))
#define TILEE ((int*)(ws + WS_TILEE))
#define NSEL ((int*)(ws + WS_NSEL))
#define XB ((bf16_t*)(ws + WS_XB))
#define XPRE ((bf16_t*)(ws + WS_XPRE))
#define PRAW ((float*)(ws + AR_PRAW))
#define CQ ((bf16_t*)(ws + AR_CQ))
#define CKV ((bf16_t*)(ws + AR_CKV))
#define KIDX ((bf16_t*)(ws + AR_KIDX))
#define WIDX ((float*)(ws + AR_WIDX))
#define SEL ((int*)(ws + AR_SEL))
#define QALL ((bf16_t*)(ws + AR_QALL))
#define SC ((float*)(ws + AR_SC))
#define OLAT ((bf16_t*)(ws + AR_OLAT))
#define OB ((bf16_t*)(ws + AR_OB))
#define QKV ((bf16_t*)(ws + AR_QKV))
#define HID ((bf16_t*)(ws + AR_HID))
#define YS ((bf16_t*)(ws + AR_YS))
#define W_GU(L) ((bf16_t*)(ws + WL_GU + (size_t)((L) & 1) * WL_STRIDE))
#define W_DN(L) ((bf16_t*)(ws + WL_DN + (size_t)((L) & 1) * WL_STRIDE))
#define W_IN(L) ((bf16_t*)(ws + WL_WIN + (size_t)((L) & 1) * WL_STRIDE))
#define W_Q(L) ((bf16_t*)(ws + WL_WQ + (size_t)((L) & 1) * WL_STRIDE))
#define W_UV(L) ((bf16_t*)(ws + WL_WUV + (size_t)((L) & 1) * WL_STRIDE))
#define W_O(L) ((bf16_t*)(ws + WL_WO + (size_t)((L) & 1) * WL_STRIDE))
#define W_QKV(L) ((bf16_t*)(ws + WL_WQKV + (size_t)((L) & 1) * WL_STRIDE))
#define W_O_D(L) ((bf16_t*)(ws + WL_WO_D + (size_t)((L) & 1) * WL_STRIDE))

namespace pg8 {
#define PG8_LAS __attribute__((address_space(3)))
typedef short bf16x8 __attribute__((ext_vector_type(8)));
typedef float f32x4 __attribute__((ext_vector_type(4)));
typedef unsigned u32x4 __attribute__((ext_vector_type(4)));
typedef unsigned u32x2 __attribute__((ext_vector_type(2)));
constexpr int BM = 256, BK = 64, HALF = 128, HTB = HALF * BK * 2  , STAGE_BYTES = 8 * HTB, NXCD = 8, WGM = 8;

__device__ __forceinline__ int lds_byte(int r, int c) { const int st = (r >> 4) * 2 + (c >> 5), rr = r & 15, cc = c & 31, ob = rr * 64 + cc * 2; return st * 1024 + (ob ^ (((ob >> 9) & 1) << 5)); }
__device__ __forceinline__ void stage_rc(int b, int& R, int& C) { const int st = b / 1024, sb = b % 1024, swz = sb ^ (((sb >> 9) & 1) << 5); R = (st >> 1) * 16 + swz / 64; C = (st & 1) * 32 + (swz % 64) / 2; }
__device__ __forceinline__ int perm32(int rho) { const int n = rho >> 4, i = rho & 15; return 8 * (i >> 2) + 4 * n + (i & 3); }

struct Unit { int pm, pn; };
enum { EPI_F32 = 0, EPI_RESID = 1, EPI_BF16 = 2, EPI_SWIGLU = 3, EPI_QKVH = 4 };
struct GemmDesc {
    const bf16_t* A; const bf16_t* Bt; const int* rowtok; const int* tilee; void* out; const void* aux;
    size_t btile, bexp; unsigned lda2, acol2, ldb2; int K, nM, nN, epi, ldc; float alpha; int pad;
};
struct Order {
    int nM, nN, nwg, G, c;
    __device__ __forceinline__ bool next(int i, Unit& u) const {
        const long L = (long)i * G + c; if (L >= nwg) return false;
        int wgid = (int)L; { const int q = nwg / NXCD, r = nwg % NXCD, xcd = wgid % NXCD, off = wgid / NXCD; wgid = (xcd < r ? xcd * (q + 1) : r * (q + 1) + (xcd - r) * q) + off; }
        const int nig = WGM * nN, gid = wgid / nig, fm = gid * WGM, gsz = (nM - fm) < WGM ? (nM - fm) : WGM;
        u.pm = fm + ((wgid % nig) % gsz); u.pn = (wgid % nig) / gsz; return true;
    }
};
__device__ __forceinline__ unsigned arow_off(const GemmDesc& d, const Unit& u, int r) { const int row = u.pm * BM + r; return (unsigned)(d.rowtok ? d.rowtok[row] : row) * d.lda2 + (unsigned)u.pn * d.acol2; }
__device__ __forceinline__ const char* bptr(const GemmDesc& d, const Unit& u) { return (const char*)d.Bt + (d.tilee ? (size_t)__builtin_amdgcn_readfirstlane(ld_mut(d.tilee + u.pm)) * d.bexp : (size_t)0) + (size_t)u.pn * d.btile; }

__device__ __forceinline__ unsigned cvt_pk_bf16(float lo, float hi) { unsigned r; asm volatile("v_cvt_pk_bf16_f32 %0, %1, %2" : "=v"(r) : "v"(lo), "v"(hi)); return r; }

__device__ __forceinline__ void epi_f32(const f32x4 (&acc)[2][2][4][2], const Unit& u, int wr, int wc, int fr, int fq, float* C, int ldc) {
    const int row0 = u.pm * BM + wr * 64 + fr, col0 = u.pn * BM + wc * 32 + 4 * fq;
#pragma unroll
    for (int ai = 0; ai < 2; ++ai)
#pragma unroll
        for (int m = 0; m < 4; ++m) { float* rowp = C + (size_t)(row0 + ai * HALF + m * 16) * ldc + col0;
#pragma unroll
            for (int bj = 0; bj < 2; ++bj)
#pragma unroll
                for (int n = 0; n < 2; ++n) *(f32x4*)(rowp + bj * HALF + n * 16) = acc[ai][bj][m][n]; }
}
__device__ __forceinline__ void epi_resid(const f32x4 (&acc)[2][2][4][2], const Unit& u, int wr, int wc, int fr, int fq, bf16_t* C, const bf16_t* X, int ldc, float alpha) {
    const int row0 = u.pm * BM + wr * 64 + fr, col0 = u.pn * BM + wc * 32 + 8 * fq;
#pragma unroll
    for (int ai = 0; ai < 2; ++ai)
#pragma unroll
        for (int m = 0; m < 4; ++m) { const size_t ro = (size_t)(row0 + ai * HALF + m * 16) * ldc + col0;
#pragma unroll
            for (int bj = 0; bj < 2; ++bj) { const u32x4 xr = *(const u32x4*)(X + ro + bj * HALF); const f32x4 a0 = acc[ai][bj][m][0], a1 = acc[ai][bj][m][1];
                u32x4 w;
                w.x = cvt_pk_bf16(alpha * __uint_as_float(xr.x << 16) + a0[0], alpha * __uint_as_float(xr.x & 0xffff0000u) + a0[1]);
                w.y = cvt_pk_bf16(alpha * __uint_as_float(xr.y << 16) + a0[2], alpha * __uint_as_float(xr.y & 0xffff0000u) + a0[3]);
                w.z = cvt_pk_bf16(alpha * __uint_as_float(xr.z << 16) + a1[0], alpha * __uint_as_float(xr.z & 0xffff0000u) + a1[1]);
                w.w = cvt_pk_bf16(alpha * __uint_as_float(xr.w << 16) + a1[2], alpha * __uint_as_float(xr.w & 0xffff0000u) + a1[3]);
                *(u32x4*)(C + ro + bj * HALF) = w; } }
}
__device__ __forceinline__ void epi_bf16(const f32x4 (&acc)[2][2][4][2], const Unit& u, int wr, int wc, int fr, int fq, bf16_t* O, int ldc) {
    const int row0 = u.pm * BM + wr * 64 + fr, col0 = u.pn * BM + wc * 32 + 8 * fq;
#pragma unroll
    for (int ai = 0; ai < 2; ++ai)
#pragma unroll
        for (int m = 0; m < 4; ++m) { bf16_t* rowp = O + (size_t)(row0 + ai * HALF + m * 16) * ldc + col0;
#pragma unroll
            for (int bj = 0; bj < 2; ++bj) { const f32x4 v0 = acc[ai][bj][m][0], v1 = acc[ai][bj][m][1];
                u32x4 w; w.x = cvt_pk_bf16(v0[0], v0[1]); w.y = cvt_pk_bf16(v0[2], v0[3]); w.z = cvt_pk_bf16(v1[0], v1[1]); w.w = cvt_pk_bf16(v1[2], v1[3]);
                *(u32x4*)(rowp + bj * HALF) = w; } }
}
__device__ __forceinline__ void epi_swiglu(const f32x4 (&acc)[2][2][4][2], const Unit& u, int wr, int wc, int fr, int fq, bf16_t* Hd, const float* rowgate) {
    const int row0 = u.pm * BM + wr * 64 + fr, col0 = u.pn * HALF + wc * 32 + 8 * fq;
#pragma unroll
    for (int ai = 0; ai < 2; ++ai)
#pragma unroll
        for (int m = 0; m < 4; ++m) { const int row = row0 + ai * HALF + m * 16; const float gw = rowgate[row];
            float h[8];
#pragma unroll
            for (int n = 0; n < 2; ++n)
#pragma unroll
                for (int e = 0; e < 4; ++e) { const float g = acc[ai][0][m][n][e], uu = acc[ai][1][m][n][e]; h[n * 4 + e] = g / (1.f + __expf(-g)) * uu * gw; }
            u32x4 w; w.x = cvt_pk_bf16(h[0], h[1]); w.y = cvt_pk_bf16(h[2], h[3]); w.z = cvt_pk_bf16(h[4], h[5]); w.w = cvt_pk_bf16(h[6], h[7]);
            *(u32x4*)(Hd + (size_t)row * 512 + col0) = w; }
}
__device__ __forceinline__ void epi_qkvh(const f32x4 (&acc)[2][2][4][2], const Unit& u, int wr, int wc, int fr, int fq, bf16_t* O) {
    const int row0 = u.pm * BM + wr * 64 + fr;
#pragma unroll
    for (int ai = 0; ai < 2; ++ai)
#pragma unroll
        for (int m = 0; m < 4; ++m) { const int row = row0 + ai * HALF + m * 16, b = row >> 12, t = row & 4095;
#pragma unroll
            for (int bj = 0; bj < 2; ++bj) { const int col = u.pn * BM + bj * HALF + wc * 32 + 8 * fq, which = col >> 11, head = (col >> 7) & 15, dim = col & 127;
                const f32x4 v0 = acc[ai][bj][m][0], v1 = acc[ai][bj][m][1];
                u32x4 w; w.x = cvt_pk_bf16(v0[0], v0[1]); w.y = cvt_pk_bf16(v0[2], v0[3]); w.z = cvt_pk_bf16(v1[0], v1[1]); w.w = cvt_pk_bf16(v1[2], v1[3]);
                *(u32x4*)(O + ((size_t)((which * 64 + b * 16 + head) * 4096 + t)) * 128 + dim) = w; } }
}
__device__ __forceinline__ void epi_any(const f32x4 (&acc)[2][2][4][2], const Unit& u, int wr, int wc, int fr, int fq, const GemmDesc& d) {
    if (d.epi == EPI_F32) epi_f32(acc, u, wr, wc, fr, fq, (float*)d.out, d.ldc);
    else if (d.epi == EPI_RESID) epi_resid(acc, u, wr, wc, fr, fq, (bf16_t*)d.out, (const bf16_t*)d.aux, d.ldc, d.alpha);
    else if (d.epi == EPI_BF16) epi_bf16(acc, u, wr, wc, fr, fq, (bf16_t*)d.out, d.ldc);
    else if (d.epi == EPI_QKVH) epi_qkvh(acc, u, wr, wc, fr, fq, (bf16_t*)d.out);
    else epi_swiglu(acc, u, wr, wc, fr, fq, (bf16_t*)d.out, (const float*)d.aux);
}

template <bool ALIGN_EPI = true, bool SP2 = true>
__device__ __forceinline__ void gemm_run(PG8_LAS unsigned char* lds, const GemmDesc& d) {
    Order S; S.nM = d.nM; S.nN = d.nN; S.nwg = d.nM * d.nN; S.G = (int)gridDim.x; S.c = (int)blockIdx.x;
    const unsigned ldb2 = d.ldb2; const bool perm = d.epi != EPI_F32;
    int tid_l = threadIdx.x; asm volatile("" : "+v"(tid_l));
    const int tid = tid_l, wid = __builtin_amdgcn_readfirstlane(tid >> 6), lane = tid & 63, wr = wid >> 2, wc = wid & 3, fr = lane & 15, fq = lane >> 4;
    const int K = d.K, nt = K / BK;
    int RA[2]; unsigned CA2[2], voffB[2];
#pragma unroll
    for (int i = 0; i < 2; ++i) { int R, C; stage_rc(tid * 16 + i * 8192, R, C); const int Rb = perm ? ((R & ~31) + perm32(R & 31)) : R;
        RA[i] = R; CA2[i] = (unsigned)C * 2u; voffB[i] = (unsigned)Rb * ldb2 + (unsigned)C * 2u; }
    const size_t kstep = (size_t)(BK * 2);
    const size_t hstepB = (size_t)HALF * ldb2;
    const unsigned ldsw = (unsigned)wid * 1024u;
    const int aoff = lds_byte(wr * 64 + fr, fq * 8), boff = lds_byte(wc * 32 + fr, fq * 8);
#define PG8_SA(b, h) (((b) * 2 + (h)) * HTB)
#define PG8_SB(b, h) ((4 + (b) * 2 + (h)) * HTB)
#define PG8_STAGE(bufoff, gbase, voff) do { _Pragma("unroll") for (int _i = 0; _i < 2; ++_i) \
        __builtin_amdgcn_global_load_lds((const unsigned*)((const char*)(gbase) + (voff)[_i]), (PG8_LAS unsigned*)(lds + (bufoff) + ldsw + _i * 8192), 16, 0, 0); } while (0)
#define PG8_STAGEA(bufoff, gbase, v0, v1) do { \
        __builtin_amdgcn_global_load_lds((const unsigned*)((const char*)(gbase) + (v0)), (PG8_LAS unsigned*)(lds + (bufoff) + ldsw), 16, 0, 0); \
        __builtin_amdgcn_global_load_lds((const unsigned*)((const char*)(gbase) + (v1)), (PG8_LAS unsigned*)(lds + (bufoff) + ldsw + 8192), 16, 0, 0); } while (0)
#define PG8_LDA(dst, b, h) do { _Pragma("unroll") for (int m = 0; m < 4; ++m) _Pragma("unroll") for (int k = 0; k < 2; ++k) dst[m][k] = *(const PG8_LAS bf16x8*)(lds + PG8_SA(b, h) + aoff + m * 2048 + k * 1024); } while (0)
#define PG8_LDB(dst, b, h) do { _Pragma("unroll") for (int n = 0; n < 2; ++n) _Pragma("unroll") for (int k = 0; k < 2; ++k) dst[n][k] = *(const PG8_LAS bf16x8*)(lds + PG8_SB(b, h) + boff + n * 2048 + k * 1024); } while (0)
#define PG8_MMA(ai, bj, At, Bt) do { __builtin_amdgcn_s_setprio(1); _Pragma("unroll") for (int m = 0; m < 4; ++m) _Pragma("unroll") for (int n = 0; n < 2; ++n) _Pragma("unroll") for (int k = 0; k < 2; ++k) \
        acc[ai][bj][m][n] = __builtin_amdgcn_mfma_f32_16x16x32_bf16(Bt[n][k], At[m][k], acc[ai][bj][m][n], 0, 0, 0); __builtin_amdgcn_s_setprio(0); } while (0)
#define PG8_WAIT_V(n) asm volatile("s_waitcnt vmcnt(" #n ")" ::: "memory")
#define PG8_WAIT_L(n) asm volatile("s_waitcnt lgkmcnt(" #n ")" ::: "memory")
#define PG8_BAR __builtin_amdgcn_s_barrier()
#define PG8_SCHED __builtin_amdgcn_sched_barrier(0)
    Unit cur, nxt; int ui = 0;
    if (!S.next(0, cur)) return;
    f32x4 acc[2][2][4][2];
#pragma unroll
    for (int a = 0; a < 2; ++a)
#pragma unroll
        for (int b = 0; b < 2; ++b)
#pragma unroll
            for (int m = 0; m < 4; ++m)
#pragma unroll
                for (int n = 0; n < 2; ++n) acc[a][b][m][n] = (f32x4){0.f, 0.f, 0.f, 0.f};
    bf16x8 At[4][2], B0[2][2], B1[2][2];
    unsigned c00 = arow_off(d, cur, RA[0]) + CA2[0], c01 = arow_off(d, cur, RA[1]) + CA2[1], c10 = arow_off(d, cur, HALF + RA[0]) + CA2[0], c11 = arow_off(d, cur, HALF + RA[1]) + CA2[1];
    unsigned n00 = c00, n01 = c01, n10 = c10, n11 = c11;
    const char* const gA = (const char*)d.A;
    const char* cB = bptr(d, cur);
    if constexpr (SP2) {
        PG8_STAGE(PG8_SB(0, 0), cB, voffB); PG8_STAGE(PG8_SB(0, 1), cB + hstepB, voffB); PG8_STAGEA(PG8_SA(0, 0), gA, c00, c01); PG8_STAGEA(PG8_SA(0, 1), gA, c10, c11);
        if (wr == 1) PG8_BAR;
        PG8_WAIT_V(2); PG8_BAR;
        PG8_STAGE(PG8_SB(1, 0), cB + kstep, voffB); PG8_STAGEA(PG8_SA(1, 0), gA + kstep, c00, c01); PG8_STAGE(PG8_SB(1, 1), cB + hstepB + kstep, voffB);
        PG8_WAIT_V(6); PG8_BAR;
    } else {
        PG8_STAGE(PG8_SB(0, 0), cB, voffB); PG8_STAGEA(PG8_SA(0, 0), gA, c00, c01); PG8_STAGE(PG8_SB(0, 1), cB + hstepB, voffB); PG8_STAGEA(PG8_SA(0, 1), gA, c10, c11);
        if (wr == 1) PG8_BAR;
        PG8_WAIT_V(4); PG8_BAR;
        PG8_STAGE(PG8_SB(1, 0), cB + kstep, voffB); PG8_STAGEA(PG8_SA(1, 0), gA + kstep, c00, c01); PG8_STAGE(PG8_SB(1, 1), cB + hstepB + kstep, voffB);
        PG8_WAIT_V(6); PG8_BAR;
    }
    for (;;) {
        const bool has_next = S.next(ui + 1, nxt);
        const char* nB = cB;
        if (has_next) {
            int tl = tid; asm volatile("" : "+v"(tl)); int R0, C0, R1, C1; stage_rc(tl * 16, R0, C0); stage_rc(tl * 16 + 8192, R1, C1);
            n00 = arow_off(d, nxt, R0) + (unsigned)C0 * 2u; n01 = arow_off(d, nxt, R1) + (unsigned)C1 * 2u; n10 = arow_off(d, nxt, HALF + R0) + (unsigned)C0 * 2u; n11 = arow_off(d, nxt, HALF + R1) + (unsigned)C1 * 2u; nB = bptr(d, nxt); }
        else { n00 = c00; n01 = c01; n10 = c10; n11 = c11; }
        for (int t = 0; t < nt; t += 2) {
            const bool last = (t == nt - 2);
            const char* a1 = gA + (size_t)(t + 1) * kstep;
            const char* a2 = last ? gA : gA + (size_t)(t + 2) * kstep; const char* b2 = last ? nB : cB + (size_t)(t + 2) * kstep;
            const char* a3 = a2 + kstep; const char* b3 = b2 + kstep;
            const unsigned s00 = last ? n00 : c00, s01 = last ? n01 : c01, s10 = last ? n10 : c10, s11 = last ? n11 : c11;
            if constexpr (SP2) {
            PG8_LDB(B0, 0, 0); PG8_LDB(B1, 0, 1); PG8_SCHED; PG8_LDA(At, 0, 0); PG8_STAGEA(PG8_SA(1, 1), a1, c10, c11);
            PG8_WAIT_V(8); PG8_WAIT_L(0); PG8_BAR; PG8_MMA(0, 0, At, B0); PG8_MMA(0, 1, At, B1); PG8_BAR; PG8_SCHED;
            PG8_LDA(At, 0, 1); PG8_STAGE(PG8_SB(0, 0), b2, voffB); PG8_STAGE(PG8_SB(0, 1), b2 + hstepB, voffB); PG8_STAGEA(PG8_SA(0, 0), a2, s00, s01);
            PG8_WAIT_V(8); PG8_WAIT_L(0); PG8_BAR; PG8_MMA(1, 0, At, B0); PG8_MMA(1, 1, At, B1); PG8_BAR; PG8_SCHED;
            PG8_LDB(B0, 1, 0); PG8_LDB(B1, 1, 1); PG8_SCHED; PG8_LDA(At, 1, 0); PG8_STAGEA(PG8_SA(0, 1), a2, s10, s11);
            PG8_WAIT_V(8); PG8_WAIT_L(0); PG8_BAR; PG8_MMA(0, 0, At, B0); PG8_MMA(0, 1, At, B1); PG8_BAR; PG8_SCHED;
            PG8_LDA(At, 1, 1); PG8_STAGE(PG8_SB(1, 0), b3, voffB); PG8_STAGE(PG8_SB(1, 1), b3 + hstepB, voffB); PG8_STAGEA(PG8_SA(1, 0), a3, s00, s01);
            PG8_WAIT_V(8); PG8_WAIT_L(0); PG8_BAR; PG8_MMA(1, 0, At, B0); PG8_MMA(1, 1, At, B1); PG8_BAR; PG8_SCHED;
            } else {
            PG8_LDB(B0, 0, 0); PG8_SCHED; PG8_LDA(At, 0, 0); PG8_STAGEA(PG8_SA(1, 1), a1, c10, c11);
            PG8_WAIT_L(8); PG8_BAR; PG8_WAIT_L(0); PG8_MMA(0, 0, At, B0); PG8_BAR; PG8_SCHED;
            PG8_LDB(B1, 0, 1); PG8_STAGE(PG8_SB(0, 0), b2, voffB);
            PG8_BAR; PG8_WAIT_L(0); PG8_MMA(0, 1, At, B1); PG8_BAR;
            PG8_LDA(At, 0, 1); PG8_STAGEA(PG8_SA(0, 0), a2, s00, s01);
            PG8_BAR; PG8_WAIT_L(0); PG8_MMA(1, 0, At, B0); PG8_BAR; PG8_SCHED;
            PG8_STAGE(PG8_SB(0, 1), b2 + hstepB, voffB);
            PG8_WAIT_V(6); PG8_BAR; PG8_MMA(1, 1, At, B1); PG8_BAR;
            PG8_LDB(B0, 1, 0); PG8_SCHED; PG8_LDA(At, 1, 0); PG8_STAGEA(PG8_SA(0, 1), a2, s10, s11);
            PG8_WAIT_L(8); PG8_BAR; PG8_WAIT_L(0); PG8_MMA(0, 0, At, B0); PG8_BAR; PG8_SCHED;
            PG8_LDB(B1, 1, 1); PG8_STAGE(PG8_SB(1, 0), b3, voffB);
            PG8_BAR; PG8_WAIT_L(0); PG8_MMA(0, 1, At, B1); PG8_BAR;
            PG8_LDA(At, 1, 1); PG8_STAGEA(PG8_SA(1, 0), a3, s00, s01);
            PG8_BAR; PG8_WAIT_L(0); PG8_MMA(1, 0, At, B0); PG8_BAR; PG8_SCHED;
            PG8_STAGE(PG8_SB(1, 1), b3 + hstepB, voffB);
            PG8_WAIT_V(6); PG8_BAR; PG8_MMA(1, 1, At, B1); PG8_BAR;
            }
        }
        if constexpr (ALIGN_EPI) { if (wr == 0) PG8_BAR; }
        { int tl = tid; asm volatile("" : "+v"(tl)); const int wid_ = __builtin_amdgcn_readfirstlane(tl >> 6), ln_ = tl & 63;
          epi_any(acc, cur, wid_ >> 2, wid_ & 3, ln_ & 15, ln_ >> 4, d); }
        if (!has_next) break;
#pragma unroll
        for (int a = 0; a < 2; ++a)
#pragma unroll
            for (int b = 0; b < 2; ++b)
#pragma unroll
                for (int m = 0; m < 4; ++m)
#pragma unroll
                    for (int n = 0; n < 2; ++n) acc[a][b][m][n] = (f32x4){0.f, 0.f, 0.f, 0.f};
        cur = nxt; cB = nB; c00 = n00; c01 = n01; c10 = n10; c11 = n11; ++ui;
        if constexpr (ALIGN_EPI) { if (wr == 1) PG8_BAR; }
    }
    PG8_WAIT_V(0);
    if constexpr (!ALIGN_EPI) { if (wr == 0) PG8_BAR; }
    PG8_BAR;
#undef PG8_SA
#undef PG8_SB
#undef PG8_STAGE
#undef PG8_STAGEA
#undef PG8_LDA
#undef PG8_LDB
#undef PG8_MMA
#undef PG8_WAIT_V
#undef PG8_WAIT_L
#undef PG8_BAR
#undef PG8_SCHED
}
}

template <class RF>
__device__ __forceinline__ void cvt_block(const float* W, int ldw, int nvalid, int k0, int n0, bf16_t* WT, float scale, RF rowoff, float* scr, int lane) {
    const int c4 = 4 * (lane & 15), r4 = lane >> 4;
    const bool ok = (n0 + c4) < nvalid;
    float4 v[16];
#pragma unroll
    for (int i = 0; i < 16; ++i) v[i] = ok ? *(const float4*)(W + (size_t)(k0 + 4 * i + r4) * ldw + n0 + c4) : make_float4(0.f, 0.f, 0.f, 0.f);
#pragma unroll
    for (int i = 0; i < 16; ++i) { float* d = scr + (4 * i + r4) * 65 + c4; d[0] = v[i].x * scale; d[1] = v[i].y * scale; d[2] = v[i].z * scale; d[3] = v[i].w * scale; }
    asm volatile("s_waitcnt lgkmcnt(0)" ::: "memory");
    const int c = lane & 7;
#pragma unroll
    for (int jj = 0; jj < 8; ++jj) { const int n = (lane >> 3) + 8 * jj; const float* s = scr + (8 * c) * 65 + n;
        uint4 o; o.x = (unsigned)f2bf(s[0]) | ((unsigned)f2bf(s[65]) << 16); o.y = (unsigned)f2bf(s[2 * 65]) | ((unsigned)f2bf(s[3 * 65]) << 16);
        o.z = (unsigned)f2bf(s[4 * 65]) | ((unsigned)f2bf(s[5 * 65]) << 16); o.w = (unsigned)f2bf(s[6 * 65]) | ((unsigned)f2bf(s[7 * 65]) << 16);
        *(uint4*)(WT + rowoff(n0 + n) + k0 + 8 * c) = o; }
    asm volatile("s_waitcnt lgkmcnt(0)" ::: "memory");
}
__device__ __noinline__ int cvt_matrix(const float* W, size_t wstride, int nbatch, int K, int N, int nvalid, int ldw, bf16_t* WT, float scale, int rb, int sh, int rs, int mask, int r0, int ldt, int c1,
                                       unsigned* counter, int seg_lo, int pending) {
    const int tid = threadIdx.x, lane = tid & 63, wave = tid >> 6, gw = blockIdx.x * NWAVES + wave, NGW = gridDim.x * NWAVES;
    float* scr = (float*)lds_raw + wave * (64 * 65);
    const int nkb = K / 64, nnb = N / 64, per = nkb * nnb, total = per * nbatch;
    if (counter == nullptr) {
        for (int it = gw; it < total; it += NGW) { const int b = it / per, r = it % per, kb = r / nnb, nb = r % nnb;
            cvt_block(W + (size_t)b * wstride, ldw, nvalid, kb * 64, nb * 64, WT, scale, [=](int n) { return (size_t)(b * rb + (n >> sh) * rs + (n & mask) + r0) * ldt + (b & 1) * c1; }, scr, lane); }
        return 0;
    }
    const int seg_hi = seg_lo + (total + 3) / 4;
    int idx = pending;
    for (;;) {
        if (idx < 0) { unsigned v = 0; if (lane == 0) v = __hip_atomic_fetch_add(counter, 1u, __ATOMIC_RELAXED, __HIP_MEMORY_SCOPE_AGENT); idx = (int)__builtin_amdgcn_readfirstlane(v); }
        if (idx >= seg_hi) return idx;
        const int c0 = (idx - seg_lo) * 4, c1e = (c0 + 4 < total) ? c0 + 4 : total;
        for (int it = c0; it < c1e; ++it) { const int b = it / per, r = it % per, kb = r / nnb, nb = r % nnb;
            cvt_block(W + (size_t)b * wstride, ldw, nvalid, kb * 64, nb * 64, WT, scale, [=](int n) { return (size_t)(b * rb + (n >> sh) * rs + (n & mask) + r0) * ldt + (b & 1) * c1; }, scr, lane); }
        idx = -1;
    }
}
__device__ __noinline__ void ph_pre(const float* x, const float* rel_bias, unsigned char* ws) {
    const int tid = threadIdx.x, lane = tid & 63, wave = tid >> 6, gw = blockIdx.x * NWAVES + wave, NGW = gridDim.x * NWAVES; float* ldsf = (float*)lds_raw;
    (void)lane; (void)wave; (void)gw; (void)NGW; (void)ldsf;
        {
            const size_t stride = (size_t)gridDim.x * NTHR, n4 = (size_t)M * D / 4;
            for (size_t i = (size_t)blockIdx.x * NTHR + tid; i < n4; i += 4 * stride) {
                float4 v[4];
#pragma unroll
                for (int q = 0; q < 4; ++q) v[q] = (i + q * stride < n4) ? ((const float4*)x)[i + q * stride] : make_float4(0.f, 0.f, 0.f, 0.f);
#pragma unroll
                for (int q = 0; q < 4; ++q) if (i + q * stride < n4) { uint2 o; o.x = (unsigned)f2bf(v[q].x) | ((unsigned)f2bf(v[q].y) << 16); o.y = (unsigned)f2bf(v[q].z) | ((unsigned)f2bf(v[q].w) << 16); ((uint2*)XB)[i + q * stride] = o; }
            }
        }
        for (int i = blockIdx.x * NTHR + tid; i < 4096 * 16; i += gridDim.x * NTHR) { const int d = i >> 4, h = i & 15; BIAS_T[i] = rel_bias[t5_bucket(d) * 16 + h]; }
}

__device__ __noinline__ void ph_prep_dsa_fold(const float* w_uq, const float* w_uk, bf16_t* wq, bf16_t* wuv) {
    const int tid = threadIdx.x; float* ldsf = (float*)lds_raw;
    for (int i = blockIdx.x * NTHR + tid; i < HW * 32; i += gridDim.x * NTHR) { const int row = i >> 5, ch = i & 31, h = row >> 7; *(uint4*)(wuv + (size_t)row * 512 + ((h & 1) ^ 1) * 256 + ch * 8) = make_uint4(0u, 0u, 0u, 0u); }
    gemm_naive(ldsf, H, KVL, QL, HD,
        [=](int h, int c, int d) { return w_uk[((size_t)h * HD + d) * KVL + c]; },
        [=](int h, int d, int k) { return w_uq[(size_t)k * HW + h * HD + d]; },
        [=](int h, int c, int k, float v) { wq[(size_t)(h * KVL + c) * QL + k] = f2bf(v * 0.08838834764831845f); });
}

__device__ __noinline__ void ph_dsa_norms(const float* qn, const float* kn, unsigned char* ws) {
    const int tid = threadIdx.x, lane = tid & 63, wave = tid >> 6, gw = blockIdx.x * NWAVES + wave, NGW = gridDim.x * NWAVES; float* ldsf = (float*)lds_raw;
    (void)lane; (void)wave; (void)gw; (void)NGW; (void)ldsf;
                for (int m = gw; m < M; m += NGW) {
                    const float* p = PRAW + (size_t)m * 1024;
                    float v[8]; float s = 0.f;
#pragma unroll
                    for (int i = 0; i < 8; ++i) { v[i] = p[lane + 64 * i]; s += v[i] * v[i]; }
                    float r = rsqrtf(wave_sum(s) * (1.f / QL) + EPS);
#pragma unroll
                    for (int i = 0; i < 8; ++i) CQ[(size_t)m * QL + lane + 64 * i] = f2bf(v[i] * r * qn[lane + 64 * i]);
                    s = 0.f;
#pragma unroll
                    for (int i = 0; i < 4; ++i) { v[i] = p[QL + lane + 64 * i]; s += v[i] * v[i]; }
                    r = rsqrtf(wave_sum(s) * (1.f / KVL) + EPS);
#pragma unroll
                    for (int i = 0; i < 4; ++i) CKV[(size_t)m * KVL + lane + 64 * i] = f2bf(v[i] * r * kn[lane + 64 * i]);
                    KIDX[(size_t)m * IDM + lane] = f2bf(p[QL + KVL + lane]);
                    if (lane < IH) WIDX[(size_t)m * IH + lane] = p[QL + KVL + IDM + lane] * 0.25f;
                }
}

typedef short s16x8 __attribute__((ext_vector_type(8)));
typedef float f32x16 __attribute__((ext_vector_type(16)));
__device__ __forceinline__ void ph_dsa_index(unsigned char* ws) {
    int tid_ = threadIdx.x; asm volatile("" : "+v"(tid_));
    const int tid = tid_, lane = tid & 63, wave = __builtin_amdgcn_readfirstlane(tid >> 6);
    LAS unsigned char* lds = (LAS unsigned char*)lds_raw;
    const bf16_t* qall = QALL; const bf16_t* kidx = KIDX; const float* widx = WIDX; float* scb = SC;
    for (int unit = blockIdx.x; unit < NB_ * 64; unit += gridDim.x) {
        const int b = unit & 3, p = unit >> 2;
#pragma unroll 1
        for (int half = 0; half < 2; ++half) {
            const int qb = half ? p : 127 - p;
            const size_t qrow0 = (size_t)b * T + (size_t)qb * 32;
            __syncthreads();
#pragma unroll
            for (int i = 0; i < 8; ++i) { const int item = tid + 512 * i, q = item >> 7, hc = item & 127, h = hc >> 3, c = hc & 7;
                const uint4 v = *(const uint4*)(qall + (qrow0 + q) * QALD + 4096 + h * 64 + c * 8);
                *(LAS pg8::u32x4*)(lds + ((h * 4 + (c >> 1)) * 64 + q + 32 * (c & 1)) * 16) = (pg8::u32x4){v.x, v.y, v.z, v.w}; }
            if (tid < 256) {
                const int q = tid >> 3, c = tid & 7; float acc8[8];
#pragma unroll
                for (int e2 = 0; e2 < 8; ++e2) acc8[e2] = 0.f;
#pragma unroll 4
                for (int h = 0; h < 16; ++h) { const float w = widx[(qrow0 + q) * 16 + h]; const uint4 v = *(const uint4*)(qall + (qrow0 + q) * QALD + 4096 + h * 64 + c * 8); const unsigned w4[4] = {v.x, v.y, v.z, v.w};
#pragma unroll
                    for (int e2 = 0; e2 < 4; ++e2) { acc8[2 * e2] = fmaf(w, __uint_as_float(w4[e2] << 16), acc8[2 * e2]); acc8[2 * e2 + 1] = fmaf(w, __uint_as_float(w4[e2] & 0xffff0000u), acc8[2 * e2 + 1]); } }
                pg8::u32x4 o; o.x = (unsigned)f2bf(acc8[0]) | ((unsigned)f2bf(acc8[1]) << 16); o.y = (unsigned)f2bf(acc8[2]) | ((unsigned)f2bf(acc8[3]) << 16);
                o.z = (unsigned)f2bf(acc8[4]) | ((unsigned)f2bf(acc8[5]) << 16); o.w = (unsigned)f2bf(acc8[6]) | ((unsigned)f2bf(acc8[7]) << 16);
                *(LAS pg8::u32x4*)(lds + ((16 * 4 + (c >> 1)) * 64 + q + 32 * (c & 1)) * 16) = o;
            }
            if (tid < 512) { const int h = tid >> 5, q = tid & 31; *(LAS float*)(lds + 69632 + (h * 32 + q) * 4) = widx[(qrow0 + q) * 16 + h]; }
            __syncthreads();
            float* const scq = scb + (size_t)b * SC_PER_B + (size_t)512 * qb * (qb + 1) + (size_t)(lane & 31) * (32 * (qb + 1)) + 4 * (lane >> 5);
#pragma unroll 1
            for (int kb = wave; kb <= qb; kb += NWAVES) {
                s16x8 ka[4];
                { const bf16_t* kp = kidx + ((size_t)b * T + kb * 32 + (lane & 31)) * IDM + 8 * (lane >> 5);
#pragma unroll
                  for (int s = 0; s < 4; ++s) ka[s] = *(const s16x8*)(kp + 16 * s); }
                f32x16 acc;
                {
                    const f32x16 z = {0.f, 0.f, 0.f, 0.f, 0.f, 0.f, 0.f, 0.f, 0.f, 0.f, 0.f, 0.f, 0.f, 0.f, 0.f, 0.f};
                    acc = __builtin_amdgcn_mfma_f32_32x32x16_bf16(ka[0], *(const LAS s16x8*)(lds + ((16 * 4 + 0) * 64 + lane) * 16), z, 0, 0, 0);
#pragma unroll
                    for (int s = 1; s < 4; ++s) acc = __builtin_amdgcn_mfma_f32_32x32x16_bf16(ka[s], *(const LAS s16x8*)(lds + ((16 * 4 + s) * 64 + lane) * 16), acc, 0, 0, 0);
                }
#pragma unroll 2
                for (int h = 0; h < 16; ++h) {
                    const f32x16 z = {0.f, 0.f, 0.f, 0.f, 0.f, 0.f, 0.f, 0.f, 0.f, 0.f, 0.f, 0.f, 0.f, 0.f, 0.f, 0.f};
                    f32x16 sv = __builtin_amdgcn_mfma_f32_32x32x16_bf16(ka[0], *(const LAS s16x8*)(lds + ((h * 4 + 0) * 64 + lane) * 16), z, 0, 0, 0);
#pragma unroll
                    for (int s = 1; s < 4; ++s) sv = __builtin_amdgcn_mfma_f32_32x32x16_bf16(ka[s], *(const LAS s16x8*)(lds + ((h * 4 + s) * 64 + lane) * 16), sv, 0, 0, 0);
                    const float w = *(const LAS float*)(lds + 69632 + (h * 32 + (lane & 31)) * 4);
#pragma unroll
                    for (int r = 0; r < 16; ++r) acc[r] = fmaf(__builtin_fabsf(sv[r]), w, acc[r]);
                }
#pragma unroll
                for (int g = 0; g < 4; ++g) *(float4*)(scq + kb * 32 + 8 * g) = make_float4(acc[4 * g], acc[4 * g + 1], acc[4 * g + 2], acc[4 * g + 3]);
            }
        }
    }
    __syncthreads();
}

__device__ __forceinline__ void ph_dsa_topk(unsigned char* ws) {
    int tid_ = threadIdx.x; asm volatile("" : "+v"(tid_));
    const int tid = tid_, lane = tid & 63, wave = tid >> 6;
    float* sw = (float*)lds_raw + wave * 4096;
    const float NINF = -__builtin_inff(), PINF = __builtin_inff();
    typedef __attribute__((address_space(1))) const pg8::f32x4 gf4;
    const int nrows = M / (int)gridDim.x;
    LAS int* qctr = (LAS int*)((LAS unsigned char*)lds_raw + LDS_MISC + 3072);
    __syncthreads();
    if (tid == 0) *qctr = NWAVES;
    __syncthreads();
    auto row_of = [&](int j) -> int {
        if (gridDim.x == 256) { const int g = 8 * (int)blockIdx.x + (j & 7), bb = (j >> 3) & 3; return bb * T + ((j < 32) ? (T - 1 - g) : g); }
        return (int)blockIdx.x * nrows + j; };
    pg8::f32x4 xs[16];
    auto fetch = [&](int j) {
        if (j < nrows) { const int m = row_of(j), b = m / T, t = m % T, n = t + 1;
            if (n > TOPK) { const int nq = (n + 255) >> 8; gf4* sg = (gf4*)(SC + sc_off(b, t)) + lane;
#pragma unroll
                for (int i = 0; i < 16; ++i) xs[i] = (i < nq) ? sg[64 * i] : (pg8::f32x4){NINF, NINF, NINF, NINF}; } }
    };
    int jcur = wave;
    fetch(jcur);
    while (jcur < nrows) {
        const int m = row_of(jcur);
        int jn; { int tk = 0; if (lane == 0) tk = __hip_atomic_fetch_add(qctr, 1, __ATOMIC_RELAXED, __HIP_MEMORY_SCOPE_WORKGROUP); jn = __builtin_amdgcn_readfirstlane(tk); }
        jcur = jn;
        const int b = m / T, t = m % T, n = t + 1; (void)b;
        int* sel = SEL + (size_t)m * TOPK;
        if (n <= TOPK) { int l3 = tid; asm volatile("" : "+v"(l3)); l3 &= 63;
            for (int i = l3; i < n; i += 64) sel[i] = i; if (l3 == 0) NSEL[m] = n; fetch(jn); continue; }
        const int nq = (n + 255) >> 8;
        float mn = PINF, mx = NINF;
        {
#pragma unroll
            for (int i = 0; i < 16; ++i) { const int k0 = 4 * (lane + 64 * i); float4 x = make_float4(xs[i][0], xs[i][1], xs[i][2], xs[i][3]);
                x.x = (k0 + 0 < n) ? x.x : NINF; x.y = (k0 + 1 < n) ? x.y : NINF; x.z = (k0 + 2 < n) ? x.z : NINF; x.w = (k0 + 3 < n) ? x.w : NINF;
                *(float4*)(sw + k0) = x;
                mx = fmaxf(fmaxf(mx, x.x), fmaxf(x.y, fmaxf(x.z, x.w)));
                mn = fminf(mn, x.x == NINF ? PINF : x.x); mn = fminf(mn, x.y == NINF ? PINF : x.y); mn = fminf(mn, x.z == NINF ? PINF : x.z); mn = fminf(mn, x.w == NINF ? PINF : x.w); }
        }
        fetch(jn);
        float lo_v = wave_min_dpp(mn), hi_v = wave_max_dpp(mx);
        int c_lo = n, c_hi = 1;
#pragma unroll 1
        for (int it = 0; it < 96; ++it) {
            if (c_lo == TOPK) break;
            float f = 0.5f;
            if ((it & 1) == 0) { f = ((float)(c_lo - TOPK) + 0.5f) / (float)(c_lo - c_hi); f = fminf(fmaxf(f, 0.03f), 0.97f); }
            float mid = lo_v + (hi_v - lo_v) * f;
            if (!(mid > lo_v && mid < hi_v)) { mid = lo_v + (hi_v - lo_v) * 0.5f; if (!(mid > lo_v && mid < hi_v)) break; }
            int c = 0;
#pragma unroll 1
            for (int i0 = 0; i0 < nq; i0 += 8) {
                float4 x8[8];
#pragma unroll
                for (int j = 0; j < 8; ++j) x8[j] = *(const float4*)(sw + 4 * (lane + 64 * (i0 + j)));
#pragma unroll
                for (int j = 0; j < 8; ++j) c += (x8[j].x >= mid) + (x8[j].y >= mid) + (x8[j].z >= mid) + (x8[j].w >= mid);
            }
            c = wave_sum_dpp(c);
            if (c >= TOPK) { lo_v = mid; c_lo = c; } else { hi_v = mid; c_hi = c; }
        }
        float Tv = lo_v;
        int lgt = 0, leq = 0;
#pragma unroll 4
        for (int i = 0; i < nq; ++i) { const float4 x = *(const float4*)(sw + 4 * (lane + 64 * i));
            lgt += (x.x > Tv) + (x.y > Tv) + (x.z > Tv) + (x.w > Tv); leq += (x.x == Tv) + (x.y == Tv) + (x.z == Tv) + (x.w == Tv); }
        int sgt = wave_scan_dpp(lgt), seq = wave_scan_dpp(leq);
        int cgt = __builtin_amdgcn_readlane(sgt, 63), ceq = __builtin_amdgcn_readlane(seq, 63);
        if (cgt > TOPK) {
            Tv = hi_v; lgt = 0; leq = 0;
#pragma unroll 4
            for (int i = 0; i < nq; ++i) { const float4 x = *(const float4*)(sw + 4 * (lane + 64 * i)); leq += (x.x == Tv) + (x.y == Tv) + (x.z == Tv) + (x.w == Tv); }
            cgt = 0; sgt = 0; seq = wave_scan_dpp(leq); ceq = __builtin_amdgcn_readlane(seq, 63);
        }
        const int need = TOPK - cgt;
        LAS int* sl = (LAS int*)((LAS unsigned char*)lds_raw + 131072 + wave * 1024);
        int p = sgt - lgt, q = cgt + seq - leq;
        const bool all_ties = (ceq <= need);
#pragma unroll 2
        for (int i = 0; i < nq; ++i) {
            const int k0 = 4 * (lane + 64 * i); const float4 x = *(const float4*)(sw + k0); const float xv[4] = {x.x, x.y, x.z, x.w};
#pragma unroll
            for (int e2 = 0; e2 < 4; ++e2) { if (xv[e2] > Tv) sl[p++] = k0 + e2; else if (all_ties && xv[e2] == Tv) sl[q++] = k0 + e2; }
        }
        if (!all_ties) {
            int taken_below = -1;
            _Pragma("unroll 1") for (int i2 = 0; i2 < need; ++i2) {
                int best = 0x7fffffff;
                _Pragma("unroll 1") for (int i = 0; i < nq; ++i) { const int k0 = 4 * (lane + 64 * i); const float4 x = *(const float4*)(sw + k0); const float xv[4] = {x.x, x.y, x.z, x.w};
#pragma unroll
                    for (int e2 = 0; e2 < 4; ++e2) { const int key = k0 + e2; if (xv[e2] == Tv && key > taken_below && key < best) best = key; } }
                best = wave_min_i(best);
                if (lane == 0) sl[cgt + i2] = best;
                taken_below = best;
            }
        }
        asm volatile("s_waitcnt lgkmcnt(0)" ::: "memory");
        *(pg8::u32x4*)(sel + 4 * lane) = *(const LAS pg8::u32x4*)(sl + 4 * lane);
        if (lane == 0) NSEL[m] = TOPK;
    }
}

typedef float f32x4v __attribute__((ext_vector_type(4)));
__device__ __forceinline__ void ph_dsa_attn(unsigned char* ws) {
    int tid_ = threadIdx.x; asm volatile("" : "+v"(tid_));
    const int tid = tid_, lane = tid & 63, wave = __builtin_amdgcn_readfirstlane(tid >> 6), n16 = lane & 15, g4 = lane >> 4;
    LAS unsigned char* lds = (LAS unsigned char*)lds_raw;
    LAS unsigned char* kvb = lds + wave * 16384;
    LAS int* sell = (LAS int*)(lds + 131072 + wave * 1024);
    const bf16_t* qall = QALL; const bf16_t* ckv = CKV; const int* selg = SEL; const int* nselg = NSEL; const float* biasT = BIAS_T; bf16_t* olat = OLAT;
    const int NQ = (M + (int)(gridDim.x * NWAVES) - 1) / (int)(gridDim.x * NWAVES);
    for (int it = 0; it < NQ; ++it) {
        int m;
        if (gridDim.x == 256) { const int b = (blockIdx.x & 7) >> 1, wb = ((blockIdx.x & 1) * 32 + (blockIdx.x >> 3)) * NWAVES + wave; m = b * T + wb + 512 * it; }
        else m = (blockIdx.x * NWAVES + wave) + (int)(gridDim.x * NWAVES) * it;
        if (m >= M) continue;
        const int b = m / T, t = m % T;
        const int nsel = __builtin_amdgcn_readfirstlane(ld_mut(nselg + m));
        float zf = 0.f; asm volatile("" : "+v"(zf));
        { int sv[4];
#pragma unroll
          for (int i = 0; i < 4; ++i) sv[i] = selg[(size_t)m * TOPK + lane + 64 * i];
#pragma unroll
          for (int i = 0; i < 4; ++i) { const int k = lane + 64 * i; sell[k] = (k < nsel) ? sv[i] : 0; } }
        s16x8 qf[8];
        { const bf16_t* qrow = qall + (size_t)m * QALD + n16 * KVL + 8 * g4;
#pragma unroll
          for (int s = 0; s < 8; ++s) qf[s] = *(const s16x8*)(qrow + 32 * s); }
        f32x4v o[16];
#pragma unroll
        for (int cb = 0; cb < 16; ++cb) o[cb] = (f32x4v){zf, zf, zf, zf};
        float m_run = -1e30f, l_run = 0.f;
        const int nch = (nsel + 31) >> 5;
        const size_t rowb = (size_t)b * T;
#pragma unroll 1
        for (int ch = 0; ch < nch; ++ch) {
            asm volatile("s_waitcnt lgkmcnt(0)" ::: "memory");
#pragma unroll
            for (int i = 0; i < 16; ++i) { const int row = 2 * i + (lane >> 5), key = sell[ch * 32 + row], c = (lane & 31) ^ (row & 15);
                __builtin_amdgcn_global_load_lds((const unsigned*)(ckv + (rowb + key) * KVL + c * 8), (LAS unsigned*)(kvb + i * 1024), 16, 0, 0); }
            const pg8::u32x4 k0 = *(const LAS pg8::u32x4*)(sell + ch * 32 + 4 * g4), k1 = *(const LAS pg8::u32x4*)(sell + ch * 32 + 16 + 4 * g4);
            float bia[8];
            bia[0] = biasT[(t - (int)k0.x) * 16 + n16]; bia[1] = biasT[(t - (int)k0.y) * 16 + n16]; bia[2] = biasT[(t - (int)k0.z) * 16 + n16]; bia[3] = biasT[(t - (int)k0.w) * 16 + n16];
            bia[4] = biasT[(t - (int)k1.x) * 16 + n16]; bia[5] = biasT[(t - (int)k1.y) * 16 + n16]; bia[6] = biasT[(t - (int)k1.z) * 16 + n16]; bia[7] = biasT[(t - (int)k1.w) * 16 + n16];
            asm volatile("s_waitcnt vmcnt(0)" ::: "memory");
            f32x4v s0 = (f32x4v){0.f, 0.f, 0.f, 0.f}, s1 = (f32x4v){0.f, 0.f, 0.f, 0.f};
#pragma unroll
            for (int s = 0; s < 8; ++s) {
                const int cs = ((4 * s + g4) ^ n16) * 16;
                const s16x8 a0 = *(const LAS s16x8*)(kvb + n16 * 512 + cs), a1 = *(const LAS s16x8*)(kvb + (16 + n16) * 512 + cs);
                s0 = __builtin_amdgcn_mfma_f32_16x16x32_bf16(a0, qf[s], s0, 0, 0, 0); s1 = __builtin_amdgcn_mfma_f32_16x16x32_bf16(a1, qf[s], s1, 0, 0, 0);
            }
            float sc[8]; float tmax = -__builtin_inff();
#pragma unroll
            for (int r = 0; r < 4; ++r) { sc[r] = (ch * 32 + 4 * g4 + r < nsel) ? s0[r] + bia[r] : -__builtin_inff(); sc[4 + r] = (ch * 32 + 16 + 4 * g4 + r < nsel) ? s1[r] + bia[4 + r] : -__builtin_inff(); }
#pragma unroll
            for (int r = 0; r < 8; ++r) tmax = fmaxf(tmax, sc[r]);
            tmax = fmaxf(tmax, __shfl_xor(tmax, 16)); tmax = fmaxf(tmax, __shfl_xor(tmax, 32));
            if (__any(tmax > m_run + 6.f)) {
                const float mnew = fmaxf(m_run, tmax), alpha = __expf(m_run - mnew);
#pragma unroll
                for (int cb = 0; cb < 16; ++cb) o[cb] *= alpha;
                l_run *= alpha; m_run = mnew;
            }
            float p[8]; float psum = 0.f;
#pragma unroll
            for (int r = 0; r < 8; ++r) { p[r] = __expf(sc[r] - m_run); psum += p[r]; }
            l_run += psum;
            s16x8 pb;
            { const unsigned w0 = pg8::cvt_pk_bf16(p[0], p[1]), w1 = pg8::cvt_pk_bf16(p[2], p[3]), w2 = pg8::cvt_pk_bf16(p[4], p[5]), w3 = pg8::cvt_pk_bf16(p[6], p[7]);
              pb[0] = (short)(w0 & 0xffff); pb[1] = (short)(w0 >> 16); pb[2] = (short)(w1 & 0xffff); pb[3] = (short)(w1 >> 16); pb[4] = (short)(w2 & 0xffff); pb[5] = (short)(w2 >> 16); pb[6] = (short)(w3 & 0xffff); pb[7] = (short)(w3 >> 16); }
            {
                const int q4 = n16 >> 2, p4 = n16 & 3, x = 4 * g4 + q4;
                const LAS unsigned char* vb = kvb + x * 512 + (p4 & 1) * 8;
                const int yo = (p4 >> 1) ^ (x & 1), xe = x & 14;
#pragma unroll
                for (int cq = 0; cq < 4; ++cq) {
                    typedef short s16x4 __attribute__((ext_vector_type(4)));
                    s16x4 lo[4], hi4[4];
#pragma unroll
                    for (int u = 0; u < 4; ++u) { const int cb = 4 * cq + u; const int co = (((2 * cb) ^ xe) + yo) * 16;
                        lo[u] = __builtin_bit_cast(s16x4, __builtin_amdgcn_ds_read_tr16_b64_v4i16((LAS s16x4*)(vb + co)));
                        hi4[u] = __builtin_bit_cast(s16x4, __builtin_amdgcn_ds_read_tr16_b64_v4i16((LAS s16x4*)(vb + 16 * 512 + co))); }
#pragma unroll
                    for (int u = 0; u < 4; ++u) { const int cb = 4 * cq + u;
                        s16x8 va; va[0] = lo[u][0]; va[1] = lo[u][1]; va[2] = lo[u][2]; va[3] = lo[u][3]; va[4] = hi4[u][0]; va[5] = hi4[u][1]; va[6] = hi4[u][2]; va[7] = hi4[u][3];
                        o[cb] = __builtin_amdgcn_mfma_f32_16x16x32_bf16(va, pb, o[cb], 0, 0, 0); }
                }
            }
        }
        {
            float lt = l_run; lt += __shfl_xor(lt, 16); lt += __shfl_xor(lt, 32);
            const float inv = 1.f / lt;
            bf16_t* orow = olat + (size_t)m * 4096 + n16 * KVL + 4 * g4;
#pragma unroll
            for (int cb = 0; cb < 16; ++cb) { pg8::u32x2 w; w.x = pg8::cvt_pk_bf16(o[cb][0] * inv, o[cb][1] * inv); w.y = pg8::cvt_pk_bf16(o[cb][2] * inv, o[cb][3] * inv); *(pg8::u32x2*)(orow + 16 * cb) = w; }
        }
    }
    __syncthreads();
}

__device__ __forceinline__ void ph_dsa_topk_attn(unsigned char* ws) {
    int tid_ = threadIdx.x; asm volatile("" : "+v"(tid_));
    const int tid = tid_, lane = tid & 63, wave = __builtin_amdgcn_readfirstlane(tid >> 6), n16 = lane & 15, g4 = lane >> 4;
    LAS unsigned char* lds = (LAS unsigned char*)lds_raw;
    float* sw = (float*)lds_raw + wave * 4096;
    LAS unsigned char* kvb = lds + wave * 16384;
    LAS int* sl = (LAS int*)(lds + 131072 + wave * 1024);
    LAS int* sell = sl;
    const bf16_t* qall = QALL; const bf16_t* ckv = CKV; const float* biasT = BIAS_T; bf16_t* olat = OLAT;
    const float NINF = -__builtin_inff(), PINF = __builtin_inff();
    typedef __attribute__((address_space(1))) const pg8::f32x4 gf4;
    const int nrows = M / (int)gridDim.x;
    LAS int* qctr = (LAS int*)(lds + LDS_MISC + 3072);
    __syncthreads();
    if (tid == 0) *qctr = NWAVES;
    __syncthreads();
    auto row_of = [&](int j) -> int {
        if (gridDim.x == 256) { const int bq = ((int)blockIdx.x & 7) >> 1, wb = (((int)blockIdx.x & 1) * 32 + ((int)blockIdx.x >> 3)) * NWAVES + (j & 7); return bq * T + wb + 512 * (7 - (j >> 3)); }
        return (int)blockIdx.x * nrows + j; };
    pg8::f32x4 xs[16];
    auto fetch = [&](int j) {
        if (j < nrows) { const int m = row_of(j), b = m / T, t = m % T, n = t + 1;
            if (n > TOPK) { const int nq = (n + 255) >> 8; gf4* sg = (gf4*)(SC + sc_off(b, t)) + lane;
#pragma unroll
                for (int i = 0; i < 16; ++i) xs[i] = (i < nq) ? sg[64 * i] : (pg8::f32x4){NINF, NINF, NINF, NINF}; } }
    };
    int jcur = wave;
    fetch(jcur);
    while (jcur < nrows) {
        const int m = row_of(jcur);
        int jn; { int tkv = 0; if (lane == 0) tkv = __hip_atomic_fetch_add(qctr, 1, __ATOMIC_RELAXED, __HIP_MEMORY_SCOPE_WORKGROUP); jn = __builtin_amdgcn_readfirstlane(tkv); }
        jcur = jn;
        const int b = m / T, t = m % T, n = t + 1;
        float zf = 0.f; asm volatile("" : "+v"(zf));
        s16x8 qf[8];
        { const bf16_t* qrow = qall + (size_t)m * QALD + n16 * KVL + 8 * g4;
#pragma unroll
          for (int s = 0; s < 8; ++s) qf[s] = *(const s16x8*)(qrow + 32 * s); }
        int nsel;
        if (n <= TOPK) {
            int l3 = tid; asm volatile("" : "+v"(l3)); l3 &= 63;
#pragma unroll
            for (int i = 0; i < 4; ++i) { const int k = l3 + 64 * i; sl[k] = (k < n) ? k : 0; }
            nsel = n;
        } else {
            const int nq = (n + 255) >> 8;
            float mn = PINF, mx = NINF;
            {
#pragma unroll
                for (int i = 0; i < 16; ++i) { const int k0 = 4 * (lane + 64 * i); float4 x = make_float4(xs[i][0], xs[i][1], xs[i][2], xs[i][3]);
                    x.x = (k0 + 0 < n) ? x.x : NINF; x.y = (k0 + 1 < n) ? x.y : NINF; x.z = (k0 + 2 < n) ? x.z : NINF; x.w = (k0 + 3 < n) ? x.w : NINF;
                    *(float4*)(sw + k0) = x;
                    mx = fmaxf(fmaxf(mx, x.x), fmaxf(x.y, fmaxf(x.z, x.w)));
                    mn = fminf(mn, x.x == NINF ? PINF : x.x); mn = fminf(mn, x.y == NINF ? PINF : x.y); mn = fminf(mn, x.z == NINF ? PINF : x.z); mn = fminf(mn, x.w == NINF ? PINF : x.w); }
            }
            float lo_v = wave_min_dpp(mn), hi_v = wave_max_dpp(mx);
            int c_lo = n, c_hi = 1;
#pragma unroll 1
            for (int it = 0; it < 96; ++it) {
                if (c_lo == TOPK) break;
                float f = 0.5f;
                if ((it & 1) == 0) { f = ((float)(c_lo - TOPK) + 0.5f) / (float)(c_lo - c_hi); f = fminf(fmaxf(f, 0.03f), 0.97f); }
                float mid = lo_v + (hi_v - lo_v) * f;
                if (!(mid > lo_v && mid < hi_v)) { mid = lo_v + (hi_v - lo_v) * 0.5f; if (!(mid > lo_v && mid < hi_v)) break; }
                int c = 0;
#pragma unroll 1
                for (int i0 = 0; i0 < nq; i0 += 8) {
                    float4 x8[8];
#pragma unroll
                    for (int j = 0; j < 8; ++j) x8[j] = *(const float4*)(sw + 4 * (lane + 64 * (i0 + j)));
#pragma unroll
                    for (int j = 0; j < 8; ++j) c += (x8[j].x >= mid) + (x8[j].y >= mid) + (x8[j].z >= mid) + (x8[j].w >= mid);
                }
                c = wave_sum_dpp(c);
                if (c >= TOPK) { lo_v = mid; c_lo = c; } else { hi_v = mid; c_hi = c; }
            }
            float Tv = lo_v;
            int lgt = 0, leq = 0;
#pragma unroll 4
            for (int i = 0; i < nq; ++i) { const float4 x = *(const float4*)(sw + 4 * (lane + 64 * i));
                lgt += (x.x > Tv) + (x.y > Tv) + (x.z > Tv) + (x.w > Tv); leq += (x.x == Tv) + (x.y == Tv) + (x.z == Tv) + (x.w == Tv); }
            int sgt = wave_scan_dpp(lgt), seq = wave_scan_dpp(leq);
            int cgt = __builtin_amdgcn_readlane(sgt, 63), ceq = __builtin_amdgcn_readlane(seq, 63);
            if (cgt > TOPK) {
                Tv = hi_v; lgt = 0; leq = 0;
#pragma unroll 4
                for (int i = 0; i < nq; ++i) { const float4 x = *(const float4*)(sw + 4 * (lane + 64 * i)); leq += (x.x == Tv) + (x.y == Tv) + (x.z == Tv) + (x.w == Tv); }
                cgt = 0; sgt = 0; seq = wave_scan_dpp(leq); ceq = __builtin_amdgcn_readlane(seq, 63);
            }
            const int need = TOPK - cgt;
            int p = sgt - lgt, q = cgt + seq - leq;
            const bool all_ties = (ceq <= need);
#pragma unroll 2
            for (int i = 0; i < nq; ++i) {
                const int k0 = 4 * (lane + 64 * i); const float4 x = *(const float4*)(sw + k0); const float xv[4] = {x.x, x.y, x.z, x.w};
#pragma unroll
                for (int e2 = 0; e2 < 4; ++e2) { if (xv[e2] > Tv) sl[p++] = k0 + e2; else if (all_ties && xv[e2] == Tv) sl[q++] = k0 + e2; }
            }
            if (!all_ties) {
                int taken_below = -1;
                _Pragma("unroll 1") for (int i2 = 0; i2 < need; ++i2) {
                    int best = 0x7fffffff;
                    _Pragma("unroll 1") for (int i = 0; i < nq; ++i) { const int k0 = 4 * (lane + 64 * i); const float4 x = *(const float4*)(sw + k0); const float xv[4] = {x.x, x.y, x.z, x.w};
#pragma unroll
                        for (int e2 = 0; e2 < 4; ++e2) { const int key = k0 + e2; if (xv[e2] == Tv && key > taken_below && key < best) best = key; } }
                    best = wave_min_i(best);
                    if (lane == 0) sl[cgt + i2] = best;
                    taken_below = best;
                }
            }
            nsel = TOPK;
        }
        fetch(jn);
        f32x4v o[16];
#pragma unroll
        for (int cb = 0; cb < 16; ++cb) o[cb] = (f32x4v){zf, zf, zf, zf};
        float m_run = -1e30f, l_run = 0.f;
        const int nch = (nsel + 31) >> 5;
        const size_t rowb = (size_t)b * T;
#pragma unroll 1
        for (int ch = 0; ch < nch; ++ch) {
            asm volatile("s_waitcnt lgkmcnt(0)" ::: "memory");
#pragma unroll
            for (int i = 0; i < 16; ++i) { const int row = 2 * i + (lane >> 5), key = sell[ch * 32 + row], c = (lane & 31) ^ (row & 15);
                __builtin_amdgcn_global_load_lds((const unsigned*)(ckv + (rowb + key) * KVL + c * 8), (LAS unsigned*)(kvb + i * 1024), 16, 0, 0); }
            const pg8::u32x4 k0 = *(const LAS pg8::u32x4*)(sell + ch * 32 + 4 * g4), k1 = *(const LAS pg8::u32x4*)(sell + ch * 32 + 16 + 4 * g4);
            float bia[8];
            bia[0] = biasT[(t - (int)k0.x) * 16 + n16]; bia[1] = biasT[(t - (int)k0.y) * 16 + n16]; bia[2] = biasT[(t - (int)k0.z) * 16 + n16]; bia[3] = biasT[(t - (int)k0.w) * 16 + n16];
            bia[4] = biasT[(t - (int)k1.x) * 16 + n16]; bia[5] = biasT[(t - (int)k1.y) * 16 + n16]; bia[6] = biasT[(t - (int)k1.z) * 16 + n16]; bia[7] = biasT[(t - (int)k1.w) * 16 + n16];
            asm volatile("s_waitcnt vmcnt(0)" ::: "memory");
            f32x4v s0 = (f32x4v){0.f, 0.f, 0.f, 0.f}, s1 = (f32x4v){0.f, 0.f, 0.f, 0.f};
#pragma unroll
            for (int s = 0; s < 8; ++s) {
                const int cs = ((4 * s + g4) ^ n16) * 16;
                const s16x8 a0 = *(const LAS s16x8*)(kvb + n16 * 512 + cs), a1 = *(const LAS s16x8*)(kvb + (16 + n16) * 512 + cs);
                s0 = __builtin_amdgcn_mfma_f32_16x16x32_bf16(a0, qf[s], s0, 0, 0, 0); s1 = __builtin_amdgcn_mfma_f32_16x16x32_bf16(a1, qf[s], s1, 0, 0, 0);
            }
            float sc[8]; float tmax = -__builtin_inff();
#pragma unroll
            for (int r = 0; r < 4; ++r) { sc[r] = (ch * 32 + 4 * g4 + r < nsel) ? s0[r] + bia[r] : -__builtin_inff(); sc[4 + r] = (ch * 32 + 16 + 4 * g4 + r < nsel) ? s1[r] + bia[4 + r] : -__builtin_inff(); }
#pragma unroll
            for (int r = 0; r < 8; ++r) tmax = fmaxf(tmax, sc[r]);
            tmax = fmaxf(tmax, __shfl_xor(tmax, 16)); tmax = fmaxf(tmax, __shfl_xor(tmax, 32));
            if (__any(tmax > m_run + 6.f)) {
                const float mnew = fmaxf(m_run, tmax), alpha = __expf(m_run - mnew);
#pragma unroll
                for (int cb = 0; cb < 16; ++cb) o[cb] *= alpha;
                l_run *= alpha; m_run = mnew;
            }
            float p[8]; float psum = 0.f;
#pragma unroll
            for (int r = 0; r < 8; ++r) { p[r] = __expf(sc[r] - m_run); psum += p[r]; }
            l_run += psum;
            s16x8 pb;
            { const unsigned w0 = pg8::cvt_pk_bf16(p[0], p[1]), w1 = pg8::cvt_pk_bf16(p[2], p[3]), w2 = pg8::cvt_pk_bf16(p[4], p[5]), w3 = pg8::cvt_pk_bf16(p[6], p[7]);
              pb[0] = (short)(w0 & 0xffff); pb[1] = (short)(w0 >> 16); pb[2] = (short)(w1 & 0xffff); pb[3] = (short)(w1 >> 16); pb[4] = (short)(w2 & 0xffff); pb[5] = (short)(w2 >> 16); pb[6] = (short)(w3 & 0xffff); pb[7] = (short)(w3 >> 16); }
            {
                const int q4 = n16 >> 2, p4 = n16 & 3, x = 4 * g4 + q4;
                const LAS unsigned char* vb = kvb + x * 512 + (p4 & 1) * 8;
                const int yo = (p4 >> 1) ^ (x & 1), xe = x & 14;
#pragma unroll
                for (int cq = 0; cq < 4; ++cq) {
                    typedef short s16x4 __attribute__((ext_vector_type(4)));
                    s16x4 lo[4], hi4[4];
#pragma unroll
                    for (int u = 0; u < 4; ++u) { const int cb = 4 * cq + u; const int co = (((2 * cb) ^ xe) + yo) * 16;
                        lo[u] = __builtin_bit_cast(s16x4, __builtin_amdgcn_ds_read_tr16_b64_v4i16((LAS s16x4*)(vb + co)));
                        hi4[u] = __builtin_bit_cast(s16x4, __builtin_amdgcn_ds_read_tr16_b64_v4i16((LAS s16x4*)(vb + 16 * 512 + co))); }
#pragma unroll
                    for (int u = 0; u < 4; ++u) { const int cb = 4 * cq + u;
                        s16x8 va; va[0] = lo[u][0]; va[1] = lo[u][1]; va[2] = lo[u][2]; va[3] = lo[u][3]; va[4] = hi4[u][0]; va[5] = hi4[u][1]; va[6] = hi4[u][2]; va[7] = hi4[u][3];
                        o[cb] = __builtin_amdgcn_mfma_f32_16x16x32_bf16(va, pb, o[cb], 0, 0, 0); }
                }
            }
        }
        {
            float lt = l_run; lt += __shfl_xor(lt, 16); lt += __shfl_xor(lt, 32);
            const float inv = 1.f / lt;
            bf16_t* orow = olat + (size_t)m * 4096 + n16 * KVL + 4 * g4;
#pragma unroll
            for (int cb = 0; cb < 16; ++cb) { pg8::u32x2 w; w.x = pg8::cvt_pk_bf16(o[cb][0] * inv, o[cb][1] * inv); w.y = pg8::cvt_pk_bf16(o[cb][2] * inv, o[cb][3] * inv); *(pg8::u32x2*)(orow + 16 * cb) = w; }
        }
    }
    __syncthreads();
}

__device__ __forceinline__ void ph_dil_attn(unsigned char* ws, unsigned* qbase) {
    int tid_ = threadIdx.x; asm volatile("" : "+v"(tid_));
    const int tid = tid_, lane = tid & 63, wave = __builtin_amdgcn_readfirstlane(tid >> 6), qi = lane & 31, hi = lane >> 5;
    LAS unsigned char* lds = (LAS unsigned char*)lds_raw;
    LAS unsigned char* kbuf = lds + wave * 16384;
    LAS unsigned char* vbuf = kbuf + 8192;
    const int drow = lane >> 4, kc0 = ((lane & 15) ^ drow) * 8, kc1 = ((lane & 15) ^ (4 + drow)) * 8, vc = ((lane & 15) ^ (drow << 2)) * 8;
    LAS float* btab = (LAS float*)(lds + 131072);
    const bf16_t* qkv = QKV; bf16_t* ob = OB; const float* biasT = BIAS_T;
    bf16_t* stb = (bf16_t*)(ws + AR_DST) + (size_t)blockIdx.x * (512 * 128);
    float* mlb = (float*)(ws + AR_DML) + (size_t)blockIdx.x * (512 * 4);
    const int xq = (int)blockIdx.x & 7, nfirst = (int)gridDim.x >> 3;
    LAS int* tkw = (LAS int*)(lds + LDS_MISC + 3072);
    for (int j = (int)blockIdx.x >> 3; j < 64; ) {
        float zf = 0.f; asm volatile("" : "+v"(zf));
        const f32x16 zero16 = {zf, zf, zf, zf, zf, zf, zf, zf, zf, zf, zf, zf, zf, zf, zf, zf};
        const int bhi = (j < 56) ? j / 7 : j - 56, span = (j < 56) ? 1 + j % 7 : 0;
        const int x = xq, u = 8 * bhi + span, bh = x + 8 * (u >> 3), h = bh & 15, s0 = (u & 7) * 512;
        __syncthreads();
        if (tid == 0) *tkw = nfirst + (int)__hip_atomic_fetch_add(qbase + 16 * xq, 1u, __ATOMIC_RELAXED, __HIP_MEMORY_SCOPE_AGENT);
        { int t2 = tid; asm volatile("" : "+v"(t2));
          if (t2 < 387) { const int br = t2 / 129, m = t2 - br * 129, dl = (br == 0) ? 1 : (br == 1 ? 4 : 16); btab[br * 132 + m] = biasT[(dl * m) * 16 + h] * 1.4426950408889634f; } }
        __syncthreads();
        const bf16_t* qbase = qkv + (size_t)bh * T * HD + 8 * hi;
        const bf16_t* kbase = qkv + (size_t)(64 + bh) * T * HD;
        const bf16_t* vbase = qkv + (size_t)(128 + bh) * T * HD;
        s16x8 qf[8], kf[8];
        f32x16 o0 = zero16, o1 = zero16, o2 = zero16, o3 = zero16;
        float m_run = -1e30f, l_run = 0.f;
        int br = 0, gi = 0, kt = 0, tb = s0 + 32 * wave, tq = 0;
        while (tb + (-128 + 32 * kt + 31) < 0) ++kt;
        bool fresh = true;
        {
            const int J0 = -128 + 32 * kt;
#pragma unroll
            for (int i = 0; i < 8; ++i) { int tk = tb + (J0 + 4 * i + drow); tk = tk < 0 ? 0 : tk;
                __builtin_amdgcn_global_load_lds((const unsigned*)(kbase + (size_t)tk * HD + ((i & 1) ? kc1 : kc0)), (LAS unsigned*)(kbuf + i * 1024), 16, 0, 0); }
#pragma unroll
            for (int i = 0; i < 8; ++i) { int tv = tb + (J0 + 4 * i + drow); tv = tv < 0 ? 0 : tv;
                __builtin_amdgcn_global_load_lds((const unsigned*)(vbase + (size_t)tv * HD + vc), (LAS unsigned*)(vbuf + i * 1024), 16, 0, 0); }
        }
#pragma unroll 1
        for (;;) {
            const int shift = 2 * br, J0 = -128 + 32 * kt;
            if (fresh) {
                tq = tb + (qi << shift);
                if (br > 0 && gi == 0) { asm volatile("s_waitcnt vmcnt(0)" ::: "memory"); __syncthreads(); }
                const bf16_t* qrow = qbase + (size_t)tq * HD;
#pragma unroll
                for (int s = 0; s < 8; ++s) qf[s] = *(const s16x8*)(qrow + 16 * s);
                if (br == 0) { o0 = zero16; o1 = zero16; o2 = zero16; o3 = zero16; m_run = -1e30f; l_run = 0.f; }
                else {
                    const int ql = (tq - s0) * 2 + hi;
                    const pg8::u32x4* sp = (const pg8::u32x4*)(stb + (size_t)ql * 64);
                    const float2 ml = *(const float2*)(mlb + ql * 2); m_run = ml.x; l_run = ml.y;
#define DIL_LD(O, DB) { const pg8::u32x4 w0 = sp[2 * (DB)], w1 = sp[2 * (DB) + 1]; \
                        O[0] = __uint_as_float(w0.x << 16); O[1] = __uint_as_float(w0.x & 0xffff0000u); O[2] = __uint_as_float(w0.y << 16); O[3] = __uint_as_float(w0.y & 0xffff0000u); \
                        O[4] = __uint_as_float(w0.z << 16); O[5] = __uint_as_float(w0.z & 0xffff0000u); O[6] = __uint_as_float(w0.w << 16); O[7] = __uint_as_float(w0.w & 0xffff0000u); \
                        O[8] = __uint_as_float(w1.x << 16); O[9] = __uint_as_float(w1.x & 0xffff0000u); O[10] = __uint_as_float(w1.y << 16); O[11] = __uint_as_float(w1.y & 0xffff0000u); \
                        O[12] = __uint_as_float(w1.z << 16); O[13] = __uint_as_float(w1.z & 0xffff0000u); O[14] = __uint_as_float(w1.w << 16); O[15] = __uint_as_float(w1.w & 0xffff0000u); }
                    DIL_LD(o0, 0) DIL_LD(o1, 1) DIL_LD(o2, 2) DIL_LD(o3, 3)
#undef DIL_LD
                }
            }
            const int mmax = min(128, tq >> shift);
            int nbr = br, ngi = gi, nkt = kt + 1, ntb = tb;
            if (nkt == 5) {
                ++ngi; if (ngi == 2) { ngi = 0; ++nbr; }
                nkt = 0;
                if (nbr < 3) { const int g = wave + 8 * ngi, ndl = 1 << (2 * nbr);
                    ntb = s0 + ((nbr == 0) ? 32 * g : (nbr == 1) ? 128 * (g >> 2) + (g & 3) : g);
                    while (ntb + (-128 + 32 * nkt + 31) * ndl < 0) ++nkt; }
            }
            const bool more = nbr < 3, glast = (kt == 4);
            const int mb = qi - J0 - 4 * hi;
            const LAS float* bt = btab + br * 132;
            float bv[16];
#pragma unroll
            for (int r = 0; r < 16; ++r) { const int m = mb - ((r & 3) + 8 * (r >> 2)); bv[r] = bt[min(max(m, 0), 128)]; }
            asm volatile("s_waitcnt vmcnt(8)" ::: "memory");
#pragma unroll
            for (int s = 0; s < 8; ++s) kf[s] = *(const LAS s16x8*)(kbuf + qi * 256 + (((2 * s + hi) ^ (qi & 7)) * 16));
            asm volatile("s_waitcnt lgkmcnt(0)" ::: "memory");
            if (more) {
                const int ndl = 1 << (2 * nbr), nJ0 = -128 + 32 * nkt;
#pragma unroll
                for (int i = 0; i < 8; ++i) { int tk = ntb + (nJ0 + 4 * i + drow) * ndl; tk = tk < 0 ? 0 : tk;
                    __builtin_amdgcn_global_load_lds((const unsigned*)(kbase + (size_t)tk * HD + ((i & 1) ? kc1 : kc0)), (LAS unsigned*)(kbuf + i * 1024), 16, 0, 0); }
            }
            f32x16 sc = __builtin_amdgcn_mfma_f32_32x32x16_bf16(kf[0], qf[0], (f32x16){0.f, 0.f, 0.f, 0.f, 0.f, 0.f, 0.f, 0.f, 0.f, 0.f, 0.f, 0.f, 0.f, 0.f, 0.f, 0.f}, 0, 0, 0);
#pragma unroll
            for (int s = 1; s < 8; ++s) sc = __builtin_amdgcn_mfma_f32_32x32x16_bf16(kf[s], qf[s], sc, 0, 0, 0);
            float tmax = -__builtin_inff();
#pragma unroll
            for (int r = 0; r < 16; ++r) { const int m = mb - ((r & 3) + 8 * (r >> 2));
                sc[r] = ((unsigned)m <= (unsigned)mmax) ? sc[r] + bv[r] : -__builtin_inff(); tmax = fmaxf(tmax, sc[r]); }
            tmax = fmaxf(tmax, __shfl_xor(tmax, 32));
            if (__any(tmax > m_run + 8.f)) {
                const float mnew = fmaxf(m_run, tmax), alpha = __builtin_amdgcn_exp2f(m_run - mnew);
                o0 *= alpha; o1 *= alpha; o2 *= alpha; o3 *= alpha; l_run *= alpha; m_run = mnew;
            }
            float psum = 0.f; unsigned pk[8];
#pragma unroll
            for (int r = 0; r < 16; r += 2) { const float p0 = __builtin_amdgcn_exp2f(sc[r] - m_run), p1 = __builtin_amdgcn_exp2f(sc[r + 1] - m_run); psum += p0 + p1; pk[r >> 1] = pg8::cvt_pk_bf16(p0, p1); }
            l_run += psum;
            if (more) asm volatile("s_waitcnt vmcnt(8)" ::: "memory"); else asm volatile("s_waitcnt vmcnt(0)" ::: "memory");
            {
                const int G4 = lane >> 4, q4 = (lane & 15) >> 2, p4 = lane & 3;
                const LAS unsigned char* vb = vbuf + (4 * (G4 >> 1) + q4) * 256 + (2 * (G4 & 1) + (p4 >> 1)) * 16 + (p4 & 1) * 8;
#pragma unroll
                for (int s2 = 0; s2 < 2; ++s2) {
                    s16x8 pb; pb[0] = (short)(pk[4 * s2] & 0xffff); pb[1] = (short)(pk[4 * s2] >> 16); pb[2] = (short)(pk[4 * s2 + 1] & 0xffff); pb[3] = (short)(pk[4 * s2 + 1] >> 16);
                    pb[4] = (short)(pk[4 * s2 + 2] & 0xffff); pb[5] = (short)(pk[4 * s2 + 2] >> 16); pb[6] = (short)(pk[4 * s2 + 3] & 0xffff); pb[7] = (short)(pk[4 * s2 + 3] >> 16);
                    typedef short s16x4 __attribute__((ext_vector_type(4)));
                    s16x4 lo[4], hi4[4];
#pragma unroll
                    for (int db = 0; db < 4; ++db) { const int sw = (db ^ q4) * 64;
                        lo[db] = __builtin_bit_cast(s16x4, __builtin_amdgcn_ds_read_tr16_b64_v4i16((LAS s16x4*)(vb + (16 * s2) * 256 + sw)));
                        hi4[db] = __builtin_bit_cast(s16x4, __builtin_amdgcn_ds_read_tr16_b64_v4i16((LAS s16x4*)(vb + (16 * s2 + 8) * 256 + sw))); }
#pragma unroll
                    for (int db = 0; db < 4; ++db) {
                        s16x8 va; va[0] = lo[db][0]; va[1] = lo[db][1]; va[2] = lo[db][2]; va[3] = lo[db][3]; va[4] = hi4[db][0]; va[5] = hi4[db][1]; va[6] = hi4[db][2]; va[7] = hi4[db][3];
                        if (db == 0) o0 = __builtin_amdgcn_mfma_f32_32x32x16_bf16(va, pb, o0, 0, 0, 0);
                        else if (db == 1) o1 = __builtin_amdgcn_mfma_f32_32x32x16_bf16(va, pb, o1, 0, 0, 0);
                        else if (db == 2) o2 = __builtin_amdgcn_mfma_f32_32x32x16_bf16(va, pb, o2, 0, 0, 0);
                        else o3 = __builtin_amdgcn_mfma_f32_32x32x16_bf16(va, pb, o3, 0, 0, 0);
                    }
                }
            }
            if (glast) {
                if (br < 2) {
                    const int ql = (tq - s0) * 2 + hi;
                    pg8::u32x4* sp = (pg8::u32x4*)(stb + (size_t)ql * 64);
                    float2 ml; ml.x = m_run; ml.y = l_run; *(float2*)(mlb + ql * 2) = ml;
#define DIL_ST(O, DB) { pg8::u32x4 w0, w1; \
                        w0.x = pg8::cvt_pk_bf16(O[0], O[1]); w0.y = pg8::cvt_pk_bf16(O[2], O[3]); w0.z = pg8::cvt_pk_bf16(O[4], O[5]); w0.w = pg8::cvt_pk_bf16(O[6], O[7]); \
                        w1.x = pg8::cvt_pk_bf16(O[8], O[9]); w1.y = pg8::cvt_pk_bf16(O[10], O[11]); w1.z = pg8::cvt_pk_bf16(O[12], O[13]); w1.w = pg8::cvt_pk_bf16(O[14], O[15]); \
                        sp[2 * (DB)] = w0; sp[2 * (DB) + 1] = w1; }
                    DIL_ST(o0, 0) DIL_ST(o1, 1) DIL_ST(o2, 2) DIL_ST(o3, 3)
#undef DIL_ST
                } else {
                    const float l_tot = l_run + __shfl_xor(l_run, 32), inv = 1.f / l_tot;
                    bf16_t* orow = ob + ((size_t)(bh >> 4) * T + tq) * HW + h * HD + 4 * hi;
#pragma unroll
                    for (int g = 0; g < 4; ++g) {
                        pg8::u32x2 w;
                        w.x = pg8::cvt_pk_bf16(o0[4 * g] * inv, o0[4 * g + 1] * inv); w.y = pg8::cvt_pk_bf16(o0[4 * g + 2] * inv, o0[4 * g + 3] * inv); *(pg8::u32x2*)(orow + 0 + 8 * g) = w;
                        w.x = pg8::cvt_pk_bf16(o1[4 * g] * inv, o1[4 * g + 1] * inv); w.y = pg8::cvt_pk_bf16(o1[4 * g + 2] * inv, o1[4 * g + 3] * inv); *(pg8::u32x2*)(orow + 32 + 8 * g) = w;
                        w.x = pg8::cvt_pk_bf16(o2[4 * g] * inv, o2[4 * g + 1] * inv); w.y = pg8::cvt_pk_bf16(o2[4 * g + 2] * inv, o2[4 * g + 3] * inv); *(pg8::u32x2*)(orow + 64 + 8 * g) = w;
                        w.x = pg8::cvt_pk_bf16(o3[4 * g] * inv, o3[4 * g + 1] * inv); w.y = pg8::cvt_pk_bf16(o3[4 * g + 2] * inv, o3[4 * g + 3] * inv); *(pg8::u32x2*)(orow + 96 + 8 * g) = w;
                    }
                }
            }
            if (!more) break;
            asm volatile("s_waitcnt lgkmcnt(0)" ::: "memory");
            {
                const int ndl = 1 << (2 * nbr), nJ0 = -128 + 32 * nkt;
#pragma unroll
                for (int i = 0; i < 8; ++i) { int tv = ntb + (nJ0 + 4 * i + drow) * ndl; tv = tv < 0 ? 0 : tv;
                    __builtin_amdgcn_global_load_lds((const unsigned*)(vbase + (size_t)tv * HD + vc), (LAS unsigned*)(vbuf + i * 1024), 16, 0, 0); }
            }
            fresh = glast; br = nbr; gi = ngi; kt = nkt; tb = ntb;
        }
        j = __builtin_amdgcn_readfirstlane(*tkw);
    }
    __syncthreads();
}

__device__ __forceinline__ void route_token(const float (&lgt)[16], const float* router_b, int& i1, int& i2, float& g1, float& g2) {
    float mx = lgt[0];
#pragma unroll
    for (int e = 1; e < 16; ++e) mx = fmaxf(mx, lgt[e]);
    float pr[16], sm = 0.f;
#pragma unroll
    for (int e = 0; e < 16; ++e) { pr[e] = __expf(lgt[e] - mx); sm += pr[e]; }
    const float inv = 1.f / sm;
    float sl[16];
#pragma unroll
    for (int e = 0; e < 16; ++e) { pr[e] *= inv; sl[e] = pr[e] + router_b[e]; }
    int bg = 0; float bgs = -__builtin_inff();
#pragma unroll
    for (int g = 0; g < NG; ++g) {
        const float a0 = sl[g * 4], a1 = sl[g * 4 + 1], a2 = sl[g * 4 + 2], a3 = sl[g * 4 + 3];
        const float h1 = fmaxf(a0, a1), l1 = fminf(a0, a1), h2 = fmaxf(a2, a3), l2 = fminf(a2, a3);
        const float gs = fmaxf(h1, h2) + fmaxf(fminf(h1, h2), fmaxf(l1, l2));
        const bool better = gs > bgs; bgs = better ? gs : bgs; bg = better ? g : bg;
    }
    float sg[4], pg[4];
#pragma unroll
    for (int i = 0; i < 4; ++i) { sg[i] = (bg == 0) ? sl[i] : (bg == 1) ? sl[4 + i] : (bg == 2) ? sl[8 + i] : sl[12 + i]; pg[i] = (bg == 0) ? pr[i] : (bg == 1) ? pr[4 + i] : (bg == 2) ? pr[8 + i] : pr[12 + i]; }
    int l1i = 0; float v1 = sg[0], p1 = pg[0];
#pragma unroll
    for (int i = 1; i < 4; ++i) { const bool b = sg[i] > v1; v1 = b ? sg[i] : v1; p1 = b ? pg[i] : p1; l1i = b ? i : l1i; }
    int l2i = 0; float v2 = -__builtin_inff(), p2 = 0.f;
#pragma unroll
    for (int i = 0; i < 4; ++i) { const bool b = (i != l1i) && (sg[i] > v2); v2 = b ? sg[i] : v2; p2 = b ? pg[i] : p2; l2i = b ? i : l2i; }
    i1 = bg * 4 + l1i; i2 = bg * 4 + l2i;
    const float gsum = p1 + p2; g1 = p1 / gsum; g2 = p2 / gsum;
}
__device__ __forceinline__ float reduce16(float (&v)[16], int lane) {
#pragma unroll
    for (int i = 0; i < 8; ++i) { const bool up = lane & 1; const float keep = up ? v[i + 8] : v[i], send = up ? v[i] : v[i + 8]; v[i] = keep + __shfl_xor(send, 1); }
#pragma unroll
    for (int i = 0; i < 4; ++i) { const bool up = lane & 2; const float keep = up ? v[i + 4] : v[i], send = up ? v[i] : v[i + 4]; v[i] = keep + __shfl_xor(send, 2); }
#pragma unroll
    for (int i = 0; i < 2; ++i) { const bool up = lane & 4; const float keep = up ? v[i + 2] : v[i], send = up ? v[i] : v[i + 2]; v[i] = keep + __shfl_xor(send, 4); }
    { const bool up = lane & 8; const float keep = up ? v[1] : v[0], send = up ? v[0] : v[1]; v[0] = keep + __shfl_xor(send, 8); }
    float r = v[0]; r += __shfl_xor(r, 16); r += __shfl_xor(r, 32); return r;
}
__device__ __forceinline__ void route_pair(float x, int lane, const float* router_b, int m, int* expid, float* gatew, int* lh) {
    const int E = lane & 15;
    float mx = x; mx = fmaxf(mx, __shfl_xor(mx, 1)); mx = fmaxf(mx, __shfl_xor(mx, 2)); mx = fmaxf(mx, __shfl_xor(mx, 4)); mx = fmaxf(mx, __shfl_xor(mx, 8));
    const float p = __expf(x - mx);
    float sm = p; sm += __shfl_xor(sm, 1); sm += __shfl_xor(sm, 2); sm += __shfl_xor(sm, 4); sm += __shfl_xor(sm, 8);
    const float pr = p * (1.f / sm), sl = pr + router_b[E];
    const float a = __shfl_xor(sl, 1), h1 = fmaxf(sl, a), l1 = fminf(sl, a), bh = __shfl_xor(h1, 2), bl = __shfl_xor(l1, 2);
    float gs = fmaxf(h1, bh) + fmaxf(fminf(h1, bh), fmaxf(l1, bl));
    int g = E >> 2;
    { const float og = __shfl_xor(gs, 4); const int oi = __shfl_xor(g, 4); const bool t = (og > gs) || (og == gs && oi < g); gs = t ? og : gs; g = t ? oi : g; }
    { const float og = __shfl_xor(gs, 8); const int oi = __shfl_xor(g, 8); const bool t = (og > gs) || (og == gs && oi < g); gs = t ? og : gs; g = t ? oi : g; }
    const bool inb = (E >> 2) == g;
    int rank = 0;
#pragma unroll
    for (int d = 1; d < 4; ++d) { const float os = __shfl_xor(sl, d); const int oe = E ^ d; rank += ((os > sl) || (os == sl && oe < E)) ? 1 : 0; }
    const unsigned long long b1 = __ballot(inb && rank == 0), b2 = __ballot(inb && rank == 1);
    const int pri = __float_as_int(pr);
#pragma unroll
    for (int q = 0; q < 2; ++q) {
        const int i1 = __builtin_ctz(((unsigned)(b1 >> (16 * q)) & 0xffffu) | 0x10000u), i2 = __builtin_ctz(((unsigned)(b2 >> (16 * q)) & 0xffffu) | 0x10000u);
        const float p1 = __int_as_float(__builtin_amdgcn_readlane(pri, 16 * q + (i1 & 15))), p2 = __int_as_float(__builtin_amdgcn_readlane(pri, 16 * q + (i2 & 15)));
        const float gsum = p1 + p2;
        if (lane == 0) { expid[(m + q) * 2] = i1 & 15; expid[(m + q) * 2 + 1] = i2 & 15; gatew[(m + q) * 2] = p1 / gsum; gatew[(m + q) * 2 + 1] = p2 / gsum; atomicAdd(&lh[i1 & 15], 1); atomicAdd(&lh[i2 & 15], 1); }
    }
}
__device__ __forceinline__ void ph_ln1_router(const float* g1, const float* b1, const float* router_w, const float* router_b, unsigned char* ws) {
    int tid_ = threadIdx.x; asm volatile("" : "+v"(tid_));
    const int tid = tid_, lane = tid & 63, wave = __builtin_amdgcn_readfirstlane(tid >> 6);
    LAS unsigned char* lds = (LAS unsigned char*)lds_raw;
    LAS float* stat = (LAS float*)(lds + 131072);
    LAS pg8::f32x4* dpart = (LAS pg8::f32x4*)(lds + 131072 + 1024);
    int* lh = (int*)((unsigned char*)lds_raw + LDS_MISC + 256);
    LAS float* gbl = (LAS float*)(lds + 147456);
    __syncthreads();
    { const float4 gv = *(const float4*)(g1 + 4 * tid), bv = *(const float4*)(b1 + 4 * tid);
      *(LAS pg8::f32x4*)(gbl + 4 * tid) = (pg8::f32x4){gv.x, gv.y, gv.z, gv.w}; *(LAS pg8::f32x4*)(gbl + 2048 + 4 * tid) = (pg8::f32x4){bv.x, bv.y, bv.z, bv.w}; }
    {
        float4 w0[8], w1[8];
#pragma unroll
        for (int q = 0; q < 8; ++q) { const int p = tid + NTHR * q, k = (p >> 2) * 2, e4 = (p & 3) * 4; w0[q] = *(const float4*)(router_w + k * 16 + e4); w1[q] = *(const float4*)(router_w + (k + 1) * 16 + e4); }
#pragma unroll
        for (int q = 0; q < 8; ++q) { const int p = tid + NTHR * q, k = (p >> 2) * 2, e4 = (p & 3) * 4, ks = k >> 5, gg = (k >> 3) & 3, j = k & 7;
            const float a[4] = {w0[q].x, w0[q].y, w0[q].z, w0[q].w}, b[4] = {w1[q].x, w1[q].y, w1[q].z, w1[q].w};
#pragma unroll
            for (int i = 0; i < 4; ++i) { const bf16_t ah = f2bf(a[i]), bh = f2bf(b[i]), al = f2bf(a[i] - bf2f(ah)), bl = f2bf(b[i] - bf2f(bh));
                const int off = ks * 1024 + (e4 + i + 16 * gg) * 16 + j * 2;
                *(LAS unsigned*)(lds + off) = (unsigned)ah | ((unsigned)bh << 16); *(LAS unsigned*)(lds + 65536 + off) = (unsigned)al | ((unsigned)bl << 16); } }
    }
    for (int c = blockIdx.x; c < NCHUNK; c += gridDim.x) {
        __syncthreads();
        if (tid < 16) lh[tid] = 0;
        const int tb = wave >> 1, kh = wave & 1, t = lane & 15, g = lane >> 4, tl = 16 * tb + t, m = c * CHUNK + tl;
        const bf16_t* xrow = XPRE + (size_t)m * D + kh * 1024 + 8 * g;
#define LN1_UNPACK(R, X) { X[0] = __uint_as_float(R.x << 16); X[1] = __uint_as_float(R.x & 0xffff0000u); X[2] = __uint_as_float(R.y << 16); X[3] = __uint_as_float(R.y & 0xffff0000u); \
                           X[4] = __uint_as_float(R.z << 16); X[5] = __uint_as_float(R.z & 0xffff0000u); X[6] = __uint_as_float(R.w << 16); X[7] = __uint_as_float(R.w & 0xffff0000u); }
        float s = 0.f, q2 = 0.f;
#pragma unroll 1
        for (int k16 = 0; k16 < 32; k16 += 16) {
            pg8::u32x4 raw[16];
#pragma unroll
            for (int i = 0; i < 16; ++i) raw[i] = *(const pg8::u32x4*)(xrow + 32 * (k16 + i));
#pragma unroll
            for (int i = 0; i < 16; ++i) { float x[8]; LN1_UNPACK(raw[i], x); s += ((x[0] + x[1]) + (x[2] + x[3])) + ((x[4] + x[5]) + (x[6] + x[7]));
#pragma unroll
                for (int j = 0; j < 8; ++j) q2 = fmaf(x[j], x[j], q2); }
        }
        s += __shfl_xor(s, 16); s += __shfl_xor(s, 32); q2 += __shfl_xor(q2, 16); q2 += __shfl_xor(q2, 32);
        if (g == 0) { stat[kh * 64 + tl] = s; stat[128 + kh * 64 + tl] = q2; }
        __syncthreads();
        const float mu = (stat[tl] + stat[64 + tl]) * (1.f / D);
        const float rstd = rsqrtf(fmaxf((stat[128 + tl] + stat[192 + tl]) * (1.f / D) - mu * mu, 0.f) + EPS);
        pg8::f32x4 acc = {0.f, 0.f, 0.f, 0.f};
        {
            const LAS float* gp = gbl + kh * 1024 + 8 * g; const LAS float* bp = gbl + 2048 + kh * 1024 + 8 * g;
            bf16_t* orow = XB + (size_t)m * D + kh * 1024 + 8 * g;
            const LAS unsigned char* wf = lds + (kh * 32) * 1024 + lane * 16;
            pg8::u32x4 rn[4];
#pragma unroll
            for (int i = 0; i < 4; ++i) rn[i] = *(const pg8::u32x4*)(xrow + 32 * i);
#pragma unroll 1
            for (int k4 = 0; k4 < 32; k4 += 4) {
                pg8::u32x4 raw[4];
#pragma unroll
                for (int i = 0; i < 4; ++i) raw[i] = rn[i];
                if (k4 + 4 < 32) {
#pragma unroll
                    for (int i = 0; i < 4; ++i) rn[i] = *(const pg8::u32x4*)(xrow + 32 * (k4 + 4 + i));
                }
#pragma unroll
                for (int i = 0; i < 4; ++i) {
                    const int ks = k4 + i;
                    float x[8]; LN1_UNPACK(raw[i], x);
                    const pg8::f32x4 ga = *(const LAS pg8::f32x4*)(gp + 32 * ks), gb = *(const LAS pg8::f32x4*)(gp + 32 * ks + 4), ba = *(const LAS pg8::f32x4*)(bp + 32 * ks), bb = *(const LAS pg8::f32x4*)(bp + 32 * ks + 4);
                    const float gm[8] = {ga[0], ga[1], ga[2], ga[3], gb[0], gb[1], gb[2], gb[3]}, bt[8] = {ba[0], ba[1], ba[2], ba[3], bb[0], bb[1], bb[2], bb[3]};
                    float y[8];
#pragma unroll
                    for (int j = 0; j < 8; ++j) y[j] = (x[j] - mu) * rstd * gm[j] + bt[j];
                    pg8::u32x4 hi, lo;
                    hi.x = pg8::cvt_pk_bf16(y[0], y[1]); hi.y = pg8::cvt_pk_bf16(y[2], y[3]); hi.z = pg8::cvt_pk_bf16(y[4], y[5]); hi.w = pg8::cvt_pk_bf16(y[6], y[7]);
                    *(pg8::u32x4*)(orow + 32 * ks) = hi;
                    lo.x = pg8::cvt_pk_bf16(y[0] - __uint_as_float(hi.x << 16), y[1] - __uint_as_float(hi.x & 0xffff0000u));
                    lo.y = pg8::cvt_pk_bf16(y[2] - __uint_as_float(hi.y << 16), y[3] - __uint_as_float(hi.y & 0xffff0000u));
                    lo.z = pg8::cvt_pk_bf16(y[4] - __uint_as_float(hi.z << 16), y[5] - __uint_as_float(hi.z & 0xffff0000u));
                    lo.w = pg8::cvt_pk_bf16(y[6] - __uint_as_float(hi.w << 16), y[7] - __uint_as_float(hi.w & 0xffff0000u));
                    const s16x8 wh = *(const LAS s16x8*)(wf + ks * 1024), wl = *(const LAS s16x8*)(wf + 65536 + ks * 1024);
                    const s16x8 yh = __builtin_bit_cast(s16x8, hi), yl = __builtin_bit_cast(s16x8, lo);
                    acc = __builtin_amdgcn_mfma_f32_16x16x32_bf16(wh, yh, acc, 0, 0, 0);
                    acc = __builtin_amdgcn_mfma_f32_16x16x32_bf16(wh, yl, acc, 0, 0, 0);
                    acc = __builtin_amdgcn_mfma_f32_16x16x32_bf16(wl, yh, acc, 0, 0, 0);
                }
            }
        }
#undef LN1_UNPACK
        if (kh == 1) dpart[tb * 64 + lane] = acc;
        __syncthreads();
        if (kh == 0) {
            const pg8::f32x4 o = dpart[tb * 64 + lane];
            const float x0 = acc[0] + o[0], x1 = acc[1] + o[1], x2 = acc[2] + o[2], x3 = acc[3] + o[3];
            float mx = fmaxf(fmaxf(x0, x1), fmaxf(x2, x3)); mx = fmaxf(mx, __shfl_xor(mx, 16)); mx = fmaxf(mx, __shfl_xor(mx, 32));
            const float p0 = __expf(x0 - mx), p1 = __expf(x1 - mx), p2 = __expf(x2 - mx), p3 = __expf(x3 - mx);
            float sm = (p0 + p1) + (p2 + p3); sm += __shfl_xor(sm, 16); sm += __shfl_xor(sm, 32);
            const float inv = 1.f / sm;
            const float pr[4] = {p0 * inv, p1 * inv, p2 * inv, p3 * inv};
            const float4 rb4 = *(const float4*)(router_b + 4 * g);
            const float sl[4] = {pr[0] + rb4.x, pr[1] + rb4.y, pr[2] + rb4.z, pr[3] + rb4.w};
            const float h1 = fmaxf(sl[0], sl[1]), l1 = fminf(sl[0], sl[1]), h2 = fmaxf(sl[2], sl[3]), l2 = fminf(sl[2], sl[3]);
            float bgs = fmaxf(h1, h2) + fmaxf(fminf(h1, h2), fmaxf(l1, l2));
            int bg = g;
            { const float og = __shfl_xor(bgs, 16); const int oi = __shfl_xor(bg, 16); const bool tk = (og > bgs) || (og == bgs && oi < bg); bgs = tk ? og : bgs; bg = tk ? oi : bg; }
            { const float og = __shfl_xor(bgs, 32); const int oi = __shfl_xor(bg, 32); const bool tk = (og > bgs) || (og == bgs && oi < bg); bgs = tk ? og : bgs; bg = tk ? oi : bg; }
            if (bg == g) {
                int l1i = 0; float v1 = sl[0], q1 = pr[0];
#pragma unroll
                for (int i = 1; i < 4; ++i) { const bool b = sl[i] > v1; v1 = b ? sl[i] : v1; q1 = b ? pr[i] : q1; l1i = b ? i : l1i; }
                int l2i = 0; float v2 = -__builtin_inff(), q2b = 0.f;
#pragma unroll
                for (int i = 0; i < 4; ++i) { const bool b = (i != l1i) && (sl[i] > v2); v2 = b ? sl[i] : v2; q2b = b ? pr[i] : q2b; l2i = b ? i : l2i; }
                const int i1 = 4 * g + l1i, i2 = 4 * g + l2i; const float gsum = q1 + q2b;
                EXPID[m * 2] = i1; EXPID[m * 2 + 1] = i2; GATEW[m * 2] = q1 / gsum; GATEW[m * 2 + 1] = q2b / gsum;
                atomicAdd(&lh[i1], 1); atomicAdd(&lh[i2], 1);
            }
        }
        __syncthreads();
        { int t3 = tid; asm volatile("" : "+v"(t3)); if (t3 < 16) HIST[c * 16 + t3] = lh[t3]; }
    }
}

__device__ __noinline__ void ph_route_pos(unsigned char* ws) {
    const int tid = threadIdx.x, lane = tid & 63, wave = tid >> 6, gw = blockIdx.x * NWAVES + wave, NGW = gridDim.x * NWAVES; float* ldsf = (float*)lds_raw;
    (void)lane; (void)wave; (void)gw; (void)NGW; (void)ldsf;
            int* hl = (int*)ldsf;
            int* tot = hl + NCHUNK * 16;
            int* seg = tot + 16;
            __syncthreads();
            for (int i = tid; i < NCHUNK * 16; i += NTHR) hl[i] = HIST[i];
            __syncthreads();
            if (tid < 16) { int run = 0; for (int c = 0; c < NCHUNK; ++c) { const int h = hl[c * 16 + tid]; hl[c * 16 + tid] = run; run += h; } tot[tid] = run; }
            __syncthreads();
            if (tid == 0) { int s = 0; for (int e = 0; e < 16; ++e) { seg[e] = s; s += (tot[e] + 255) & ~255; } seg[16] = s; }
            __syncthreads();
            for (int c = blockIdx.x; c < NCHUNK; c += gridDim.x) {
                if (wave == 0) {
                    const int m = c * CHUNK + lane;
                    const int e0 = EXPID[m * 2], e1 = EXPID[m * 2 + 1];
                    const unsigned long long lt = (1ull << lane) - 1ull;
                    int r0 = 0, r1 = 0;
                    for (int e = 0; e < 16; ++e) {
                        const unsigned long long m0 = __ballot(e0 == e), m1 = __ballot(e1 == e);
                        const int below = __popcll(m0 & lt) + __popcll(m1 & lt);
                        if (e0 == e) r0 = below;
                        if (e1 == e) r1 = below;
                    }
                    const int p0 = seg[e0] + hl[c * 16 + e0] + r0, p1 = seg[e1] + hl[c * 16 + e1] + r1;
                    POS[m * 2] = p0; POS[m * 2 + 1] = p1;
                    ROWTOK[p0] = m; ROWTOK[p1] = m; ROWGATE[p0] = GATEW[m * 2]; ROWGATE[p1] = GATEW[m * 2 + 1];
                }
            }
            if (blockIdx.x == 0) {
                for (int e = 0; e < 16; ++e) { for (int r = seg[e] + tot[e] + tid; r < seg[e + 1]; r += NTHR) { ROWTOK[r] = 0; ROWGATE[r] = 0.f; } }
                if (tid < 160) { int e = 0; const int row = tid * 256; for (int q = 0; q < 16; ++q) if (row >= seg[q]) e = q; TILEE[tid] = e; }
                __syncthreads();
                if (tid == 0) TILEE[159] = seg[16] / 256;
            }
}

__device__ __forceinline__ void ph_ln2(const float* g2, const float* b2, float* out, int last, unsigned char* ws) {
    int tid_ = threadIdx.x; asm volatile("" : "+v"(tid_));
    const int tid = tid_, lane = tid & 63, wave = tid >> 6, gw = blockIdx.x * NWAVES + wave, NGW = gridDim.x * NWAVES; float* ldsf = (float*)lds_raw;
    (void)lane; (void)wave; (void)gw; (void)NGW; (void)ldsf;
            int m = gw;
            if (m >= M) return;
            uint2 xr[8], y0[8], y1[8];
            int np0 = 0, np1 = 0;
            { const int p0 = POS[m * 2], p1 = POS[m * 2 + 1];
#pragma unroll
              for (int jj = 0; jj < 8; ++jj) { xr[jj] = *(const uint2*)(XB + (size_t)m * D + 4 * lane + 256 * jj); y0[jj] = *(const uint2*)(YS + (size_t)p0 * D + 4 * lane + 256 * jj); y1[jj] = *(const uint2*)(YS + (size_t)p1 * D + 4 * lane + 256 * jj); }
              if (m + NGW < M) { np0 = POS[(m + NGW) * 2]; np1 = POS[(m + NGW) * 2 + 1]; } }
#pragma unroll 1
            for (; m < M; m += NGW) {
                float4 v[8];
#pragma unroll
                for (int jj = 0; jj < 8; ++jj) {
                    v[jj].x = ALPHA * __uint_as_float(xr[jj].x << 16) + __uint_as_float(y0[jj].x << 16) + __uint_as_float(y1[jj].x << 16);
                    v[jj].y = ALPHA * __uint_as_float(xr[jj].x & 0xffff0000u) + __uint_as_float(y0[jj].x & 0xffff0000u) + __uint_as_float(y1[jj].x & 0xffff0000u);
                    v[jj].z = ALPHA * __uint_as_float(xr[jj].y << 16) + __uint_as_float(y0[jj].y << 16) + __uint_as_float(y1[jj].y << 16);
                    v[jj].w = ALPHA * __uint_as_float(xr[jj].y & 0xffff0000u) + __uint_as_float(y0[jj].y & 0xffff0000u) + __uint_as_float(y1[jj].y & 0xffff0000u);
                }
                const int mn = m + NGW;
                if (mn < M) {
                    const int p0 = np0, p1 = np1;
#pragma unroll
                    for (int jj = 0; jj < 8; ++jj) { xr[jj] = *(const uint2*)(XB + (size_t)mn * D + 4 * lane + 256 * jj); y0[jj] = *(const uint2*)(YS + (size_t)p0 * D + 4 * lane + 256 * jj); y1[jj] = *(const uint2*)(YS + (size_t)p1 * D + 4 * lane + 256 * jj); }
                    if (mn + NGW < M) { np0 = POS[(mn + NGW) * 2]; np1 = POS[(mn + NGW) * 2 + 1]; }
                }
                ln_row(v, g2, b2, lane);
                if (last) {
#pragma unroll
                    for (int jj = 0; jj < 8; ++jj) *(float4*)(out + (size_t)m * D + 4 * lane + 256 * jj) = v[jj];
                } else store_row_bf16(XB + (size_t)m * D, v, lane);
            }
}

__global__ void __launch_bounds__(NTHR, 2) mega_fwd(Args a) {
    const int tid0 = threadIdx.x;
    unsigned* ctl = (unsigned*)(a.ws + WS_CTL);
    volatile LAS unsigned* misc = (volatile LAS unsigned*)((LAS unsigned char*)lds_raw + LDS_MISC);
    if (tid0 < 64) misc[tid0] = 0u;
    __syncthreads();
#if MK_SINGLE
    XcdBarrier bar = xcd_barrier_post(ctl + 4096, misc + 8);
#define GRID_BAR() xcd_barrier(bar)
#else
    (void)ctl;
#define GRID_BAR() do { } while (0)
#endif
    const int lo = a.ph_lo, hi = a.ph_hi;
    for (int pc = lo; pc < hi; ++pc) {
        bool ran = true, is_gemm = false; int do_prep = 0;
        pg8::GemmDesc d{};
        const __attribute__((address_space(4))) Args* ap = (const __attribute__((address_space(4))) Args*)__builtin_amdgcn_kernarg_segment_ptr();
        asm volatile("" : "+s"(ap));
#define a (*ap)
        unsigned char* ws = ap->ws;
        if (pc == 0) ph_pre(a.x, a.rel_bias, ws);
        else {
            const int q = pc - 1, L = q / 14, s = q % 14, j = L >> 1; const bool dsa = (L & 1) == 0;
            switch (s) {
            case 0:
                if (L == 0) do_prep = 1; else if (dsa) ph_prep_dsa_fold(a.a_w_uq + (size_t)j * QL * HW, a.a_w_uk + (size_t)j * H * HD * KVL, W_Q(L), W_UV(L)); else ran = false;
                break;
            case 1: is_gemm = true;
                if (dsa) { d.A = XB; d.Bt = W_IN(L); d.K = D; d.lda2 = D * 2; d.ldb2 = D * 2; d.btile = (size_t)256 * D * 2; d.nM = M / 256; d.nN = 4; d.epi = pg8::EPI_F32; d.out = PRAW; d.ldc = 1024; }
                else     { d.A = XB; d.Bt = W_QKV(L); d.K = D; d.lda2 = D * 2; d.ldb2 = D * 2; d.btile = (size_t)256 * D * 2; d.nM = M / 256; d.nN = 3 * HW / 256; d.epi = pg8::EPI_QKVH; d.out = QKV; d.ldc = 3 * HW; }
                break;
            case 2: if (dsa) ph_dsa_norms(a.a_q_norm + (size_t)j * QL, a.a_kv_norm + (size_t)j * KVL, ws); else ran = false; break;
            case 3: if (dsa) { is_gemm = true; d.A = CQ; d.Bt = W_Q(L); d.K = QL; d.lda2 = QL * 2; d.ldb2 = QL * 2; d.btile = (size_t)256 * QL * 2; d.nM = M / 256; d.nN = QALD / 256; d.epi = pg8::EPI_BF16; d.out = QALL; d.ldc = QALD; }
                    else ran = false; break;
            case 4: if (dsa) ph_dsa_index(ws); else ran = false; break;
            case 5: if (dsa) ph_dsa_topk_attn(ws); else ran = false; break;
            case 6: if (dsa) ran = false; else ph_dil_attn(ws, (unsigned*)(ws + WS_CTL) + 12288 + 128 * L); break;
            case 7: if (dsa) { is_gemm = true; d.A = OLAT; d.Bt = W_UV(L); d.K = 512; d.lda2 = 4096 * 2; d.acol2 = 512 * 2; d.ldb2 = 512 * 2; d.btile = (size_t)256 * 512 * 2; d.nM = M / 256; d.nN = HW / 256;
                               d.epi = pg8::EPI_BF16; d.out = OB; d.ldc = HW; }
                    else ran = false; break;
            case 8: is_gemm = true; d.A = OB; d.Bt = dsa ? W_O(L) : W_O_D(L); d.K = HW; d.lda2 = HW * 2; d.ldb2 = HW * 2; d.btile = (size_t)256 * HW * 2; d.nM = M / 256; d.nN = D / 256;
                    d.epi = pg8::EPI_RESID; d.out = XPRE; d.aux = XB; d.ldc = D; d.alpha = ALPHA; break;
            case 9: ph_ln1_router(a.ln1_g + (size_t)L * D, a.ln1_b + (size_t)L * D, a.router_w, a.router_b, ws); break;
            case 10: ph_route_pos(ws); break;
            case 11: is_gemm = true; d.A = XB; d.Bt = W_GU(L); d.K = D; d.lda2 = D * 2; d.ldb2 = D * 2; d.btile = (size_t)256 * D * 2; d.bexp = (size_t)1024 * D * 2; d.nM = __builtin_amdgcn_readfirstlane(ld_mut(TILEE + 159)); d.nN = 4;
                     d.rowtok = ROWTOK; d.tilee = TILEE; d.epi = pg8::EPI_SWIGLU; d.out = HID; d.aux = ROWGATE; d.ldc = DE; if (L + 1 < DEPTH) do_prep = 2; break;
            case 12: is_gemm = true; d.A = HID; d.Bt = W_DN(L); d.K = DE; d.lda2 = DE * 2; d.ldb2 = DE * 2; d.btile = (size_t)256 * DE * 2; d.bexp = (size_t)D * DE * 2; d.nM = __builtin_amdgcn_readfirstlane(ld_mut(TILEE + 159)); d.nN = D / 256;
                     d.tilee = TILEE; d.epi = pg8::EPI_BF16; d.out = YS; d.ldc = D; if (L + 1 < DEPTH) do_prep = 2; break;
            default: ph_ln2(a.ln2_g + (size_t)L * D, a.ln2_b + (size_t)L * D, a.out, L == DEPTH - 1 ? 1 : 0, ws); break;
            }
        }
#undef a
        if (is_gemm) pg8::gemm_run((PG8_LAS unsigned char*)lds_raw, d);
#define a (*ap)
        if (do_prep) {
            const int Lp = (do_prep == 1) ? 0 : (pc - 1) / 14 + 1, jp = Lp >> 1; const bool pdsa = (Lp & 1) == 0;
            unsigned* cnt = (do_prep == 1) ? nullptr : (unsigned*)(ap->ws + WS_CTL) + 8192 + 64 * Lp;
            int pend = -1, seg = 0;
            const float* wg = a.moe_w_gate + (size_t)Lp * NE * D * DE; const float* wu = a.moe_w_up + (size_t)Lp * NE * D * DE; const float* wd = a.moe_w_down + (size_t)Lp * NE * DE * D;
            pend = cvt_matrix(wg, (size_t)D * DE, NE, D, DE, DE, DE, W_GU(Lp), 1.f, 1024, 7, 256, 127, 0, D, 0, cnt, seg, pend); seg += 1024;
            pend = cvt_matrix(wu, (size_t)D * DE, NE, D, DE, DE, DE, W_GU(Lp), 1.f, 1024, 7, 256, 127, 128, D, 0, cnt, seg, pend); seg += 1024;
            pend = cvt_matrix(wd, (size_t)DE * D, NE, DE, D, D, D, W_DN(Lp), 1.f, D, 31, 0, 0x7fffffff, 0, DE, 0, cnt, seg, pend); seg += 1024;
            if (pdsa) {
                const float* w_in = a.a_w_in + (size_t)jp * D * AIN; const float* w_uqi = a.a_w_uq_idx + (size_t)jp * QL * IH * IDM; const float* w_uv = a.a_w_uv + (size_t)jp * H * KVL * HD; const float* w_o = a.a_w_o + (size_t)jp * HW * D;
                pend = cvt_matrix(w_in, 0, 1, D, 1024, AIN, AIN, W_IN(Lp), 1.f, 0, 31, 0, 0x7fffffff, 0, D, 0, cnt, seg, pend); seg += 128;
                pend = cvt_matrix(w_uqi, 0, 1, QL, IH * IDM, IH * IDM, IH * IDM, W_Q(Lp), 0.125f, 0, 31, 0, 0x7fffffff, 4096, QL, 0, cnt, seg, pend); seg += 32;
                pend = cvt_matrix(w_o, 0, 1, HW, D, D, D, W_O(Lp), 1.f, 0, 31, 0, 0x7fffffff, 0, HW, 0, cnt, seg, pend); seg += 256;
                pend = cvt_matrix(w_uv, (size_t)KVL * HD, H, KVL, HD, HD, HD, W_UV(Lp), 1.f, HD, 31, 0, 0x7fffffff, 0, 512, 256, cnt, seg, pend); seg += 32;
                if (do_prep == 1) ph_prep_dsa_fold(a.a_w_uq + (size_t)jp * QL * HW, a.a_w_uk + (size_t)jp * H * HD * KVL, W_Q(Lp), W_UV(Lp));
            } else {
                const float* w_in = a.b_w_in + (size_t)jp * D * 3 * HW; const float* w_o = a.b_w_o + (size_t)jp * HW * D;
                pend = cvt_matrix(w_in, 0, 1, D, HW, HW, 3 * HW, W_QKV(Lp), 0.12751743082459868f  , 0, 31, 0, 0x7fffffff, 0, D, 0, cnt, seg, pend); seg += 256;
                pend = cvt_matrix(w_in + HW, 0, 1, D, 2 * HW, 2 * HW, 3 * HW, W_QKV(Lp), 1.f, 0, 31, 0, 0x7fffffff, HW, D, 0, cnt, seg, pend); seg += 512;
                pend = cvt_matrix(w_o, 0, 1, HW, D, D, D, W_O_D(Lp), 1.f, 0, 31, 0, 0x7fffffff, 0, HW, 0, cnt, seg, pend); seg += 256;
            }
        }
#undef a
        bool skipbar = false;
        if (MK_SINGLE) { if (pc == 0) skipbar = true; else { const int q2 = pc - 1, L2_ = q2 / 14, s2 = q2 % 14; if (s2 == 13 && (L2_ & 1) == 1 && L2_ + 1 < DEPTH) skipbar = true; } }
        if (ran && !skipbar && pc + 1 < hi) GRID_BAR();
    }
}
constexpr int N_PHASES = 1 + DEPTH * 14;
}

extern "C" void kernel_launch(void* const* d_in, const int* in_sizes, int n_in, void* d_out, int out_size, void* d_ws, size_t ws_size, hipStream_t stream) {
    static int grid = 0;
    if (grid == 0) {
        if (n_in != 21 || in_sizes[0] != M * D || out_size != M * D || ws_size < WS_END) {
            fprintf(stderr, "kernel_launch: unexpected shapes: n_in %d in0 %d out %d ws %zu (need %zu)\n", n_in, n_in > 0 ? in_sizes[0] : -1, out_size, ws_size, (size_t)WS_END);
            grid = -1; return; }
        int dev = 0, cus = 0, per_cu = 0;
        if (hipGetDevice(&dev) != hipSuccess || hipDeviceGetAttribute(&cus, hipDeviceAttributeMultiprocessorCount, dev) != hipSuccess) { grid = -1; return; }
        if (hipFuncSetAttribute((const void*)mega_fwd, hipFuncAttributeMaxDynamicSharedMemorySize, LDS_BYTES) != hipSuccess) { fprintf(stderr, "kernel_launch: hipFuncSetAttribute failed\n"); grid = -1; return; }
        if (hipOccupancyMaxActiveBlocksPerMultiprocessor(&per_cu, (const void*)mega_fwd, NTHR, LDS_BYTES) != hipSuccess || per_cu < 1)
            fprintf(stderr, "kernel_launch: occupancy query reports %d workgroups per CU\n", per_cu);
        (void)hipGetLastError();
        grid = cus;
    }
    if (grid < 0) return;
    if (hipMemsetAsync((char*)d_ws + WS_CTL, 0, CTL_BYTES, stream) != hipSuccess) return;
    Args a{};
    a.x = (const float*)d_in[0]; a.rel_bias = (const float*)d_in[1]; a.router_w = (const float*)d_in[2]; a.router_b = (const float*)d_in[3];
    a.a_w_in = (const float*)d_in[4]; a.a_q_norm = (const float*)d_in[5]; a.a_kv_norm = (const float*)d_in[6]; a.a_w_uq = (const float*)d_in[7]; a.a_w_uq_idx = (const float*)d_in[8];
    a.a_w_uk = (const float*)d_in[9]; a.a_w_uv = (const float*)d_in[10]; a.a_w_o = (const float*)d_in[11]; a.b_w_in = (const float*)d_in[12]; a.b_w_o = (const float*)d_in[13];
    a.ln1_g = (const float*)d_in[14]; a.ln1_b = (const float*)d_in[15]; a.ln2_g = (const float*)d_in[16]; a.ln2_b = (const float*)d_in[17];
    a.moe_w_gate = (const float*)d_in[18]; a.moe_w_up = (const float*)d_in[19]; a.moe_w_down = (const float*)d_in[20];
    a.out = (float*)d_out; a.ws = (unsigned char*)d_ws;
#if MK_SINGLE
    a.ph_lo = 0; a.ph_hi = N_PHASES;
    hipLaunchKernelGGL(mega_fwd, dim3(grid), dim3(NTHR), LDS_BYTES, stream, a);
#else
    for (int p = 0; p < N_PHASES; ++p) { a.ph_lo = p; a.ph_hi = p + 1; hipLaunchKernelGGL(mega_fwd, dim3(grid), dim3(NTHR), LDS_BYTES, stream, a); }
#endif
}
```

```cpp
#include <hip/hip_runtime.h>
#include <cstdio>
#include <cstdint>

#ifndef MK_SINGLE
#define MK_SINGLE 1
#endif

namespace {
constexpr int D = 2048, NB_ = 4, T = 4096, DEPTH = 4, M = NB_ * T;
constexpr int H = 16, HD = 128, HW = H * HD, QL = 512, KVL = 256, IH = 16, IDM = 64, TOPK = 256;
constexpr int AIN = QL + KVL + IDM + IH;
constexpr int NBUCK = 32, NE = 16, NG = 4, EPG = 4, DE = 512;
constexpr float ALPHA = 1.6817928305074292f;
constexpr float EPS = 1e-5f;
constexpr int NTHR = 512, NWAVES = 8;
constexpr int RMAX = 36864;
constexpr int NCHUNK = 256, CHUNK = M / NCHUNK;

constexpr size_t MiB = 1u << 20;
constexpr size_t WS_CTL = 0, CTL_BYTES = 1 * MiB;
constexpr size_t WS_BIAS = 1 * MiB;
constexpr size_t WS_EXPID = 2 * MiB;
constexpr size_t WS_GATEW = WS_EXPID + (size_t)M * 2 * 4;
constexpr size_t WS_POS = WS_GATEW + (size_t)M * 2 * 4;
constexpr size_t WS_ROWTOK = WS_POS + (size_t)M * 2 * 4;
constexpr size_t WS_ROWGATE = WS_ROWTOK + (size_t)RMAX * 4;
constexpr size_t WS_HIST = WS_ROWGATE + (size_t)RMAX * 4;
constexpr size_t WS_TILEE = WS_HIST + (size_t)NCHUNK * 16 * 4;
constexpr size_t WS_NSEL = WS_TILEE + 1024;
constexpr size_t WS_XB = 8 * MiB;
constexpr size_t WS_XPRE = 72 * MiB;
constexpr size_t WS_WL = 200 * MiB;
constexpr size_t WL_STRIDE = 128 * MiB;
constexpr size_t WS_AR = 456 * MiB;
constexpr int QALD = 5120;
constexpr size_t WS_END = 1034 * MiB;
constexpr size_t AR_PRAW = WS_AR;
constexpr size_t AR_CQ = WS_AR + 64 * MiB;
constexpr size_t AR_CKV = WS_AR + 80 * MiB;
constexpr size_t AR_KIDX = WS_AR + 88 * MiB;
constexpr size_t AR_WIDX = WS_AR + 90 * MiB;
constexpr size_t AR_SEL = WS_AR + 92 * MiB;
constexpr size_t AR_QALL = WS_AR + 108 * MiB;
constexpr size_t AR_SC = WS_AR + 268 * MiB;
constexpr size_t AR_OLAT = 906 * MiB;
constexpr size_t AR_OB = WS_AR + 0 * MiB;
constexpr size_t AR_QKV = WS_AR + 100 * MiB;
constexpr size_t AR_DST = WS_AR + 300 * MiB;
constexpr size_t AR_DML = WS_AR + 336 * MiB;
constexpr size_t AR_HID = WS_AR + 0 * MiB;
constexpr size_t AR_YS = WS_AR + 40 * MiB;
constexpr size_t SC_PER_B = (size_t)1024 * 128 * 129 / 2;
static_assert(AR_SC + 4 * SC_PER_B * 4 <= WS_END, "arena");
static_assert(AR_YS + (size_t)RMAX * D * 2 <= WS_END, "arena");
constexpr size_t WL_GU = WS_WL;
constexpr size_t WL_DN = WS_WL + 64 * MiB;
constexpr size_t WL_MIX = WS_WL + 96 * MiB;
constexpr size_t WL_WIN = WL_MIX;
constexpr size_t WL_WQ = WL_MIX + 4 * MiB;
constexpr size_t WL_WUV = WL_MIX + 10 * MiB;
constexpr size_t WL_WO = WL_MIX + 12 * MiB;
constexpr size_t WL_WQKV = WL_MIX + 0 * MiB;
constexpr size_t WL_WO_D = WL_MIX + 24 * MiB;
static_assert(WL_WO_D + 8 * MiB <= WS_WL + WL_STRIDE && WS_WL + 2 * WL_STRIDE <= WS_AR, "weight scratch");

constexpr int LDS_BYTES = 163840;
constexpr int LDS_MISC = 143360;

typedef unsigned short bf16_t;
#define LAS __attribute__((address_space(3)))

__device__ __forceinline__ float bf2f(bf16_t v) { return __uint_as_float(((unsigned)v) << 16); }
__device__ __forceinline__ bf16_t f2bf(float f) { unsigned u = __float_as_uint(f); u += 0x7fffu + ((u >> 16) & 1u); return (bf16_t)(u >> 16); }
__device__ __forceinline__ float wave_sum(float v) {
#pragma unroll
    for (int o = 1; o < 64; o <<= 1) v += __shfl_xor(v, o);
    return v;
}
__device__ __forceinline__ int wave_sum_i(int v) {
#pragma unroll
    for (int o = 1; o < 64; o <<= 1) v += __shfl_xor(v, o);
    return v;
}
__device__ __forceinline__ float wave_max(float v) {
#pragma unroll
    for (int o = 1; o < 64; o <<= 1) v = fmaxf(v, __shfl_xor(v, o));
    return v;
}
__device__ __forceinline__ float wave_min(float v) {
#pragma unroll
    for (int o = 1; o < 64; o <<= 1) v = fminf(v, __shfl_xor(v, o));
    return v;
}
__device__ __forceinline__ int wave_min_i(int v) {
#pragma unroll
    for (int o = 1; o < 64; o <<= 1) { int t = __shfl_xor(v, o); v = t < v ? t : v; }
    return v;
}

__device__ __forceinline__ int wave_scan_dpp(int x) {
    x += __builtin_amdgcn_update_dpp(0, x, 0x111, 0xf, 0xf, false);
    x += __builtin_amdgcn_update_dpp(0, x, 0x112, 0xf, 0xf, false);
    x += __builtin_amdgcn_update_dpp(0, x, 0x114, 0xf, 0xf, false);
    x += __builtin_amdgcn_update_dpp(0, x, 0x118, 0xf, 0xf, false);
    x += __builtin_amdgcn_update_dpp(0, x, 0x142, 0xa, 0xf, false);
    x += __builtin_amdgcn_update_dpp(0, x, 0x143, 0xc, 0xf, false);
    return x;
}
__device__ __forceinline__ float wave_max_dpp(float v) {
    const int ninf = __float_as_int(-__builtin_inff());
#define WMX(ctrl, rm) v = fmaxf(v, __int_as_float(__builtin_amdgcn_update_dpp(ninf, __float_as_int(v), ctrl, rm, 0xf, false)))
    WMX(0x111, 0xf); WMX(0x112, 0xf); WMX(0x114, 0xf); WMX(0x118, 0xf); WMX(0x142, 0xa); WMX(0x143, 0xc);
#undef WMX
    return __int_as_float(__builtin_amdgcn_readlane(__float_as_int(v), 63));
}
__device__ __forceinline__ float wave_min_dpp(float v) {
    const int pinf = __float_as_int(__builtin_inff());
#define WMN(ctrl, rm) v = fminf(v, __int_as_float(__builtin_amdgcn_update_dpp(pinf, __float_as_int(v), ctrl, rm, 0xf, false)))
    WMN(0x111, 0xf); WMN(0x112, 0xf); WMN(0x114, 0xf); WMN(0x118, 0xf); WMN(0x142, 0xa); WMN(0x143, 0xc);
#undef WMN
    return __int_as_float(__builtin_amdgcn_readlane(__float_as_int(v), 63));
}
__device__ __forceinline__ int wave_sum_dpp(int x) {
    x += __builtin_amdgcn_update_dpp(0, x, 0x111, 0xf, 0xf, false);
    x += __builtin_amdgcn_update_dpp(0, x, 0x112, 0xf, 0xf, false);
    x += __builtin_amdgcn_update_dpp(0, x, 0x114, 0xf, 0xf, false);
    x += __builtin_amdgcn_update_dpp(0, x, 0x118, 0xf, 0xf, false);
    x += __builtin_amdgcn_update_dpp(0, x, 0x142, 0xa, 0xf, false);
    x += __builtin_amdgcn_update_dpp(0, x, 0x143, 0xc, 0xf, false);
    return __builtin_amdgcn_readlane(x, 63);
}
__device__ __forceinline__ int ld_mut(const int* p) { return __hip_atomic_load(p, __ATOMIC_RELAXED, __HIP_MEMORY_SCOPE_AGENT); }

#define XB_TMO      128
#define XB_XCNT(j)  (256  + 64 * (j))
#define XB_XSUB(j)  (1280 + 64 * (j))
#define XB_XGEN(j)  (2304 + 64 * (j))
#define XB_TOP      3328
#define XB_TOPGEN   3392
#define XCD_BAR_WORDS 3456
#define XB_SPIN_CAP (1u << 18)

__device__ __forceinline__ unsigned xb_ld(unsigned* p)              { return __hip_atomic_load(p, __ATOMIC_RELAXED, __HIP_MEMORY_SCOPE_AGENT); }
__device__ __forceinline__ unsigned xb_add(unsigned* p, unsigned v) { return __hip_atomic_fetch_add(p, v, __ATOMIC_RELAXED, __HIP_MEMORY_SCOPE_AGENT); }
__device__ __forceinline__ unsigned xb_xcc_id() { return (unsigned)__builtin_amdgcn_s_getreg((3 << 11) | 20) & 0xFu; }
#define XB_SPIN(cond, bar) do { unsigned _sp = 0; while (cond) { __builtin_amdgcn_s_sleep(1); \
    if ((++_sp & 255u) == 0u) { if (xb_ld(&(bar)[XB_TMO])) break; if (_sp > XB_SPIN_CAP) { atomicAdd(&(bar)[XB_TMO], 1u); break; } } } } while (0)

struct XcdBarrier {
    unsigned* bar; unsigned x;
    volatile LAS unsigned* st;
};
__device__ __forceinline__ XcdBarrier xcd_barrier_post(unsigned* bar, volatile LAS unsigned* st) {
    XcdBarrier b; b.bar = bar; b.x = xb_xcc_id(); b.st = st;
    if (threadIdx.x == 0) (void)xb_add(&bar[XB_XCNT(b.x)], 1u);
    return b;
}
__device__ __forceinline__ void xcd_barrier_complete(unsigned* bar, unsigned x, unsigned& nloc, unsigned& nx) {
    const unsigned G = gridDim.x * gridDim.y * gridDim.z;
    unsigned sum, cnt, mine, sp = 0u;
    for (;;) {
        sum = 0u; cnt = 0u; mine = 0u;
#pragma unroll
        for (unsigned j = 0; j < 16; ++j) { const unsigned c = xb_ld(&bar[XB_XCNT(j)]); sum += c; cnt += (c > 0u) ? 1u : 0u; mine = (j == x) ? c : mine; }
        if (sum == G) break;
        __builtin_amdgcn_s_sleep(1);
        if ((++sp & 255u) == 0u) { if (xb_ld(&bar[XB_TMO])) break; if (sp > XB_SPIN_CAP) { atomicAdd(&bar[XB_TMO], 1u); break; } }
    }
    nloc = mine > 0u ? mine : 1u; nx = cnt > 0u ? cnt : 1u;
}
__device__ __forceinline__ void xcd_barrier(const XcdBarrier& b) {
    asm volatile("s_waitcnt vmcnt(0)" ::: "memory");
    __syncthreads();
    if (threadIdx.x == 0) {
        unsigned* bar = b.bar;
        __builtin_amdgcn_s_waitcnt(0);
        unsigned nloc = b.st[0], nx = b.st[1];
        if (nloc == 0u) { xcd_barrier_complete(bar, b.x, nloc, nx); b.st[0] = nloc; b.st[1] = nx; }
        const unsigned old = xb_add(&bar[XB_XSUB(b.x)], 1u);
        const unsigned gen = old / nloc;
        if (old + 1u == (gen + 1u) * nloc) {
            __builtin_amdgcn_fence(__ATOMIC_RELEASE, "agent");
            asm volatile("s_waitcnt vmcnt(0)" ::: "memory");
            const unsigned og = xb_add(&bar[XB_TOP], 1u);
            const unsigned tg = og / nx;
            if (og + 1u == (tg + 1u) * nx) xb_add(&bar[XB_TOPGEN], 1u);
            else XB_SPIN(xb_ld(&bar[XB_TOPGEN]) == tg, bar);
            __builtin_amdgcn_fence(__ATOMIC_ACQUIRE, "agent");
            xb_add(&bar[XB_XGEN(b.x)], 1u);
            asm volatile("s_waitcnt vmcnt(0)" ::: "memory");
        } else {
            XB_SPIN(xb_ld(&bar[XB_XGEN(b.x)]) == gen, bar);
            __builtin_amdgcn_fence(__ATOMIC_ACQUIRE, "agent");
            asm volatile("s_waitcnt vmcnt(0)" ::: "memory");
        }
    }
    __syncthreads();
}

template <class AF, class BF, class EF>
__device__ __forceinline__ void gemm_naive(float* lds, int nbatch, int Mr, int N, int K, AF af, BF bf, EF ef) {
    float* As = lds; float* Bs = lds + 16 * 132;
    const int tid = threadIdx.x, ty = tid >> 4, tx = tid & 15;
    const int tm = Mr / 128, tn = (N + 63) / 64, per = tm * tn, total = per * nbatch;
    for (int u = blockIdx.x; u < total; u += gridDim.x) {
        const int bi = u / per, rr = u % per, m0 = (rr / tn) * 128, n0 = (rr % tn) * 64;
        float acc[4][4];
#pragma unroll
        for (int i = 0; i < 4; ++i)
#pragma unroll
            for (int j = 0; j < 4; ++j) acc[i][j] = 0.f;
        for (int k0 = 0; k0 < K; k0 += 16) {
            __syncthreads();
#pragma unroll
            for (int i = 0; i < 4; ++i) { const int e = tid + 512 * i, row = e >> 4, kk = e & 15; As[kk * 132 + row] = af(bi, m0 + row, k0 + kk); }
#pragma unroll
            for (int i = 0; i < 2; ++i) { const int e = tid + 512 * i, kk = e >> 6, n = e & 63; Bs[kk * 68 + n] = (n0 + n < N) ? bf(bi, k0 + kk, n0 + n) : 0.f; }
            __syncthreads();
#pragma unroll
            for (int kk = 0; kk < 16; ++kk) {
                const float4 a = *(const float4*)(As + kk * 132 + ty * 4);
                const float4 b = *(const float4*)(Bs + kk * 68 + tx * 4);
                const float av[4] = {a.x, a.y, a.z, a.w}, bv[4] = {b.x, b.y, b.z, b.w};
#pragma unroll
                for (int i = 0; i < 4; ++i)
#pragma unroll
                    for (int j = 0; j < 4; ++j) acc[i][j] = fmaf(av[i], bv[j], acc[i][j]);
            }
        }
#pragma unroll
        for (int i = 0; i < 4; ++i)
#pragma unroll
            for (int j = 0; j < 4; ++j) { const int n = n0 + tx * 4 + j; if (n < N) ef(bi, m0 + ty * 4 + i, n, acc[i][j]); }
    }
    __syncthreads();
}

__device__ __forceinline__ int t5_bucket(int n) {
    if (n < 16) return n;
    const float nf = (float)n;
    int large = 16 + (int)(logf(nf / 16.0f) / 4.852030263919617f * 16.0f);
    return large < 31 ? large : 31;
}
__device__ __forceinline__ size_t sc_off(int b, int t) { const int qb = t >> 5; return (size_t)b * SC_PER_B + (size_t)512 * qb * (qb + 1) + (size_t)(t & 31) * (32 * (qb + 1)); }

struct Args {
    const float* x; const float* rel_bias; const float* router_w; const float* router_b;
    const float* a_w_in; const float* a_q_norm; const float* a_kv_norm; const float* a_w_uq; const float* a_w_uq_idx;
    const float* a_w_uk; const float* a_w_uv; const float* a_w_o; const float* b_w_in; const float* b_w_o;
    const float* ln1_g; const float* ln1_b; const float* ln2_g; const float* ln2_b;
    const float* moe_w_gate; const float* moe_w_up; const float* moe_w_down;
    float* out; unsigned char* ws; int ph_lo, ph_hi;
};

template <class V4>
__device__ __forceinline__ void ln_row(V4 (&v)[8], const float* g, const float* bta, int lane) {
    float s = 0.f;
#pragma unroll
    for (int j = 0; j < 8; ++j) s += (v[j].x + v[j].y) + (v[j].z + v[j].w);
    const float mu = wave_sum(s) * (1.f / D);
    float q = 0.f;
#pragma unroll
    for (int j = 0; j < 8; ++j) { v[j].x -= mu; v[j].y -= mu; v[j].z -= mu; v[j].w -= mu; q += (v[j].x * v[j].x + v[j].y * v[j].y) + (v[j].z * v[j].z + v[j].w * v[j].w); }
    const float rstd = rsqrtf(wave_sum(q) * (1.f / D) + EPS);
#pragma unroll
    for (int j = 0; j < 8; ++j) {
        const float4 gg = *(const float4*)(g + 4 * lane + 256 * j), bb = *(const float4*)(bta + 4 * lane + 256 * j);
        v[j].x = v[j].x * rstd * gg.x + bb.x; v[j].y = v[j].y * rstd * gg.y + bb.y; v[j].z = v[j].z * rstd * gg.z + bb.z; v[j].w = v[j].w * rstd * gg.w + bb.w;
        if (j == 3) asm volatile("" ::: "memory");
    }
}
template <class V4>
__device__ __forceinline__ void store_row_bf16(bf16_t* dst, const V4 (&v)[8], int lane) {
#pragma unroll
    for (int j = 0; j < 8; ++j) {
        uint2 o; o.x = (unsigned)f2bf(v[j].x) | ((unsigned)f2bf(v[j].y) << 16); o.y = (unsigned)f2bf(v[j].z) | ((unsigned)f2bf(v[j].w) << 16);
        *(uint2*)(dst + 4 * lane + 256 * j) = o;
    }
}

extern __shared__ __attribute__((aligned(16))) unsigned char lds_raw[];
#define BIAS_T ((float*)(ws + WS_BIAS))
#define EXPID ((int*)(ws + WS_EXPID))
#define GATEW ((float*)(ws + WS_GATEW))
#define POS ((int*)(ws + WS_POS))
#define ROWTOK ((int*)(ws + WS_ROWTOK))
#define ROWGATE ((float*)(ws + WS_ROWGATE))
#define HIST ((int*)(ws + WS_HIST))
#define TILEE ((int*)(ws + WS_TILEE))
#define NSEL ((int*)(ws + WS_NSEL))
#define XB ((bf16_t*)(ws + WS_XB))
#define XPRE ((bf16_t*)(ws + WS_XPRE))
#define PRAW ((float*)(ws + AR_PRAW))
#define CQ ((bf16_t*)(ws + AR_CQ))
#define CKV ((bf16_t*)(ws + AR_CKV))
#define KIDX ((bf16_t*)(ws + AR_KIDX))
#define WIDX ((float*)(ws + AR_WIDX))
#define SEL ((int*)(ws + AR_SEL))
#define QALL ((bf16_t*)(ws + AR_QALL))
#define SC ((float*)(ws + AR_SC))
#define OLAT ((bf16_t*)(ws + AR_OLAT))
#define OB ((bf16_t*)(ws + AR_OB))
#define QKV ((bf16_t*)(ws + AR_QKV))
#define HID ((bf16_t*)(ws + AR_HID))
#define YS ((bf16_t*)(ws + AR_YS))
#define W_GU(L) ((bf16_t*)(ws + WL_GU + (size_t)((L) & 1) * WL_STRIDE))
#define W_DN(L) ((bf16_t*)(ws + WL_DN + (size_t)((L) & 1) * WL_STRIDE))
#define W_IN(L) ((bf16_t*)(ws + WL_WIN + (size_t)((L) & 1) * WL_STRIDE))
#define W_Q(L) ((bf16_t*)(ws + WL_WQ + (size_t)((L) & 1) * WL_STRIDE))
#define W_UV(L) ((bf16_t*)(ws + WL_WUV + (size_t)((L) & 1) * WL_STRIDE))
#define W_O(L) ((bf16_t*)(ws + WL_WO + (size_t)((L) & 1) * WL_STRIDE))
#define W_QKV(L) ((bf16_t*)(ws + WL_WQKV + (size_t)((L) & 1) * WL_STRIDE))
#define W_O_D(L) ((bf16_t*)(ws + WL_WO_D + (size_t)((L) & 1) * WL_STRIDE))

namespace pg8 {
#define PG8_LAS __attribute__((address_space(3)))
typedef short bf16x8 __attribute__((ext_vector_type(8)));
typedef float f32x4 __attribute__((ext_vector_type(4)));
typedef unsigned u32x4 __attribute__((ext_vector_type(4)));
typedef unsigned u32x2 __attribute__((ext_vector_type(2)));
constexpr int BM = 256, BK = 64, HALF = 128, HTB = HALF * BK * 2  , STAGE_BYTES = 8 * HTB, NXCD = 8, WGM = 8;

__device__ __forceinline__ int lds_byte(int r, int c) { const int st = (r >> 4) * 2 + (c >> 5), rr = r & 15, cc = c & 31, ob = rr * 64 + cc * 2; return st * 1024 + (ob ^ (((ob >> 9) & 1) << 5)); }
__device__ __forceinline__ void stage_rc(int b, int& R, int& C) { const int st = b / 1024, sb = b % 1024, swz = sb ^ (((sb >> 9) & 1) << 5); R = (st >> 1) * 16 + swz / 64; C = (st & 1) * 32 + (swz % 64) / 2; }
__device__ __forceinline__ int perm32(int rho) { const int n = rho >> 4, i = rho & 15; return 8 * (i >> 2) + 4 * n + (i & 3); }

struct Unit { int pm, pn; };
enum { EPI_F32 = 0, EPI_RESID = 1, EPI_BF16 = 2, EPI_SWIGLU = 3, EPI_QKVH = 4 };
struct GemmDesc {
    const bf16_t* A; const bf16_t* Bt; const int* rowtok; const int* tilee; void* out; const void* aux;
    size_t btile, bexp; unsigned lda2, acol2, ldb2; int K, nM, nN, epi, ldc; float alpha; int pad;
};
struct Order {
    int nM, nN, nwg, G, c;
    __device__ __forceinline__ bool next(int i, Unit& u) const {
        const long L = (long)i * G + c; if (L >= nwg) return false;
        int wgid = (int)L; { const int q = nwg / NXCD, r = nwg % NXCD, xcd = wgid % NXCD, off = wgid / NXCD; wgid = (xcd < r ? xcd * (q + 1) : r * (q + 1) + (xcd - r) * q) + off; }
        const int nig = WGM * nN, gid = wgid / nig, fm = gid * WGM, gsz = (nM - fm) < WGM ? (nM - fm) : WGM;
        u.pm = fm + ((wgid % nig) % gsz); u.pn = (wgid % nig) / gsz; return true;
    }
};
__device__ __forceinline__ unsigned arow_off(const GemmDesc& d, const Unit& u, int r) { const int row = u.pm * BM + r; return (unsigned)(d.rowtok ? d.rowtok[row] : row) * d.lda2 + (unsigned)u.pn * d.acol2; }
__device__ __forceinline__ const char* bptr(const GemmDesc& d, const Unit& u) { return (const char*)d.Bt + (d.tilee ? (size_t)__builtin_amdgcn_readfirstlane(ld_mut(d.tilee + u.pm)) * d.bexp : (size_t)0) + (size_t)u.pn * d.btile; }

__device__ __forceinline__ unsigned cvt_pk_bf16(float lo, float hi) { unsigned r; asm volatile("v_cvt_pk_bf16_f32 %0, %1, %2" : "=v"(r) : "v"(lo), "v"(hi)); return r; }

__device__ __forceinline__ void epi_f32(const f32x4 (&acc)[2][2][4][2], const Unit& u, int wr, int wc, int fr, int fq, float* C, int ldc) {
    const int row0 = u.pm * BM + wr * 64 + fr, col0 = u.pn * BM + wc * 32 + 4 * fq;
#pragma unroll
    for (int ai = 0; ai < 2; ++ai)
#pragma unroll
        for (int m = 0; m < 4; ++m) { float* rowp = C + (size_t)(row0 + ai * HALF + m * 16) * ldc + col0;
#pragma unroll
            for (int bj = 0; bj < 2; ++bj)
#pragma unroll
                for (int n = 0; n < 2; ++n) *(f32x4*)(rowp + bj * HALF + n * 16) = acc[ai][bj][m][n]; }
}
__device__ __forceinline__ void epi_resid(const f32x4 (&acc)[2][2][4][2], const Unit& u, int wr, int wc, int fr, int fq, bf16_t* C, const bf16_t* X, int ldc, float alpha) {
    const int row0 = u.pm * BM + wr * 64 + fr, col0 = u.pn * BM + wc * 32 + 8 * fq;
#pragma unroll
    for (int ai = 0; ai < 2; ++ai)
#pragma unroll
        for (int m = 0; m < 4; ++m) { const size_t ro = (size_t)(row0 + ai * HALF + m * 16) * ldc + col0;
#pragma unroll
            for (int bj = 0; bj < 2; ++bj) { const u32x4 xr = *(const u32x4*)(X + ro + bj * HALF); const f32x4 a0 = acc[ai][bj][m][0], a1 = acc[ai][bj][m][1];
                u32x4 w;
                w.x = cvt_pk_bf16(alpha * __uint_as_float(xr.x << 16) + a0[0], alpha * __uint_as_float(xr.x & 0xffff0000u) + a0[1]);
                w.y = cvt_pk_bf16(alpha * __uint_as_float(xr.y << 16) + a0[2], alpha * __uint_as_float(xr.y & 0xffff0000u) + a0[3]);
                w.z = cvt_pk_bf16(alpha * __uint_as_float(xr.z << 16) + a1[0], alpha * __uint_as_float(xr.z & 0xffff0000u) + a1[1]);
                w.w = cvt_pk_bf16(alpha * __uint_as_float(xr.w << 16) + a1[2], alpha * __uint_as_float(xr.w & 0xffff0000u) + a1[3]);
                *(u32x4*)(C + ro + bj * HALF) = w; } }
}
__device__ __forceinline__ void epi_bf16(const f32x4 (&acc)[2][2][4][2], const Unit& u, int wr, int wc, int fr, int fq, bf16_t* O, int ldc) {
    const int row0 = u.pm * BM + wr * 64 + fr, col0 = u.pn * BM + wc * 32 + 8 * fq;
#pragma unroll
    for (int ai = 0; ai < 2; ++ai)
#pragma unroll
        for (int m = 0; m < 4; ++m) { bf16_t* rowp = O + (size_t)(row0 + ai * HALF + m * 16) * ldc + col0;
#pragma unroll
            for (int bj = 0; bj < 2; ++bj) { const f32x4 v0 = acc[ai][bj][m][0], v1 = acc[ai][bj][m][1];
                u32x4 w; w.x = cvt_pk_bf16(v0[0], v0[1]); w.y = cvt_pk_bf16(v0[2], v0[3]); w.z = cvt_pk_bf16(v1[0], v1[1]); w.w = cvt_pk_bf16(v1[2], v1[3]);
                *(u32x4*)(rowp + bj * HALF) = w; } }
}
__device__ __forceinline__ void epi_swiglu(const f32x4 (&acc)[2][2][4][2], const Unit& u, int wr, int wc, int fr, int fq, bf16_t* Hd, const float* rowgate) {
    const int row0 = u.pm * BM + wr * 64 + fr, col0 = u.pn * HALF + wc * 32 + 8 * fq;
#pragma unroll
    for (int ai = 0; ai < 2; ++ai)
#pragma unroll
        for (int m = 0; m < 4; ++m) { const int row = row0 + ai * HALF + m * 16; const float gw = rowgate[row];
            float h[8];
#pragma unroll
            for (int n = 0; n < 2; ++n)
#pragma unroll
                for (int e = 0; e < 4; ++e) { const float g = acc[ai][0][m][n][e], uu = acc[ai][1][m][n][e]; h[n * 4 + e] = g / (1.f + __expf(-g)) * uu * gw; }
            u32x4 w; w.x = cvt_pk_bf16(h[0], h[1]); w.y = cvt_pk_bf16(h[2], h[3]); w.z = cvt_pk_bf16(h[4], h[5]); w.w = cvt_pk_bf16(h[6], h[7]);
            *(u32x4*)(Hd + (size_t)row * 512 + col0) = w; }
}
__device__ __forceinline__ void epi_qkvh(const f32x4 (&acc)[2][2][4][2], const Unit& u, int wr, int wc, int fr, int fq, bf16_t* O) {
    const int row0 = u.pm * BM + wr * 64 + fr;
#pragma unroll
    for (int ai = 0; ai < 2; ++ai)
#pragma unroll
        for (int m = 0; m < 4; ++m) { const int row = row0 + ai * HALF + m * 16, b = row >> 12, t = row & 4095;
#pragma unroll
            for (int bj = 0; bj < 2; ++bj) { const int col = u.pn * BM + bj * HALF + wc * 32 + 8 * fq, which = col >> 11, head = (col >> 7) & 15, dim = col & 127;
                const f32x4 v0 = acc[ai][bj][m][0], v1 = acc[ai][bj][m][1];
                u32x4 w; w.x = cvt_pk_bf16(v0[0], v0[1]); w.y = cvt_pk_bf16(v0[2], v0[3]); w.z = cvt_pk_bf16(v1[0], v1[1]); w.w = cvt_pk_bf16(v1[2], v1[3]);
                *(u32x4*)(O + ((size_t)((which * 64 + b * 16 + head) * 4096 + t)) * 128 + dim) = w; } }
}
__device__ __forceinline__ void epi_any(const f32x4 (&acc)[2][2][4][2], const Unit& u, int wr, int wc, int fr, int fq, const GemmDesc& d) {
    if (d.epi == EPI_F32) epi_f32(acc, u, wr, wc, fr, fq, (float*)d.out, d.ldc);
    else if (d.epi == EPI_RESID) epi_resid(acc, u, wr, wc, fr, fq, (bf16_t*)d.out, (const bf16_t*)d.aux, d.ldc, d.alpha);
    else if (d.epi == EPI_BF16) epi_bf16(acc, u, wr, wc, fr, fq, (bf16_t*)d.out, d.ldc);
    else if (d.epi == EPI_QKVH) epi_qkvh(acc, u, wr, wc, fr, fq, (bf16_t*)d.out);
    else epi_swiglu(acc, u, wr, wc, fr, fq, (bf16_t*)d.out, (const float*)d.aux);
}

template <bool ALIGN_EPI = true, bool SP2 = true>
__device__ __forceinline__ void gemm_run(PG8_LAS unsigned char* lds, const GemmDesc& d) {
    Order S; S.nM = d.nM; S.nN = d.nN; S.nwg = d.nM * d.nN; S.G = (int)gridDim.x; S.c = (int)blockIdx.x;
    const unsigned ldb2 = d.ldb2; const bool perm = d.epi != EPI_F32;
    int tid_l = threadIdx.x; asm volatile("" : "+v"(tid_l));
    const int tid = tid_l, wid = __builtin_amdgcn_readfirstlane(tid >> 6), lane = tid & 63, wr = wid >> 2, wc = wid & 3, fr = lane & 15, fq = lane >> 4;
    const int K = d.K, nt = K / BK;
    int RA[2]; unsigned CA2[2], voffB[2];
#pragma unroll
    for (int i = 0; i < 2; ++i) { int R, C; stage_rc(tid * 16 + i * 8192, R, C); const int Rb = perm ? ((R & ~31) + perm32(R & 31)) : R;
        RA[i] = R; CA2[i] = (unsigned)C * 2u; voffB[i] = (unsigned)Rb * ldb2 + (unsigned)C * 2u; }
    const size_t kstep = (size_t)(BK * 2);
    const size_t hstepB = (size_t)HALF * ldb2;
    const unsigned ldsw = (unsigned)wid * 1024u;
    const int aoff = lds_byte(wr * 64 + fr, fq * 8), boff = lds_byte(wc * 32 + fr, fq * 8);
#define PG8_SA(b, h) (((b) * 2 + (h)) * HTB)
#define PG8_SB(b, h) ((4 + (b) * 2 + (h)) * HTB)
#define PG8_STAGE(bufoff, gbase, voff) do { _Pragma("unroll") for (int _i = 0; _i < 2; ++_i) \
        __builtin_amdgcn_global_load_lds((const unsigned*)((const char*)(gbase) + (voff)[_i]), (PG8_LAS unsigned*)(lds + (bufoff) + ldsw + _i * 8192), 16, 0, 0); } while (0)
#define PG8_STAGEA(bufoff, gbase, v0, v1) do { \
        __builtin_amdgcn_global_load_lds((const unsigned*)((const char*)(gbase) + (v0)), (PG8_LAS unsigned*)(lds + (bufoff) + ldsw), 16, 0, 0); \
        __builtin_amdgcn_global_load_lds((const unsigned*)((const char*)(gbase) + (v1)), (PG8_LAS unsigned*)(lds + (bufoff) + ldsw + 8192), 16, 0, 0); } while (0)
#define PG8_LDA(dst, b, h) do { _Pragma("unroll") for (int m = 0; m < 4; ++m) _Pragma("unroll") for (int k = 0; k < 2; ++k) dst[m][k] = *(const PG8_LAS bf16x8*)(lds + PG8_SA(b, h) + aoff + m * 2048 + k * 1024); } while (0)
#define PG8_LDB(dst, b, h) do { _Pragma("unroll") for (int n = 0; n < 2; ++n) _Pragma("unroll") for (int k = 0; k < 2; ++k) dst[n][k] = *(const PG8_LAS bf16x8*)(lds + PG8_SB(b, h) + boff + n * 2048 + k * 1024); } while (0)
#define PG8_MMA(ai, bj, At, Bt) do { __builtin_amdgcn_s_setprio(1); _Pragma("unroll") for (int m = 0; m < 4; ++m) _Pragma("unroll") for (int n = 0; n < 2; ++n) _Pragma("unroll") for (int k = 0; k < 2; ++k) \
        acc[ai][bj][m][n] = __builtin_amdgcn_mfma_f32_16x16x32_bf16(Bt[n][k], At[m][k], acc[ai][bj][m][n], 0, 0, 0); __builtin_amdgcn_s_setprio(0); } while (0)
#define PG8_WAIT_V(n) asm volatile("s_waitcnt vmcnt(" #n ")" ::: "memory")
#define PG8_WAIT_L(n) asm volatile("s_waitcnt lgkmcnt(" #n ")" ::: "memory")
#define PG8_BAR __builtin_amdgcn_s_barrier()
#define PG8_SCHED __builtin_amdgcn_sched_barrier(0)
    Unit cur, nxt; int ui = 0;
    if (!S.next(0, cur)) return;
    f32x4 acc[2][2][4][2];
#pragma unroll
    for (int a = 0; a < 2; ++a)
#pragma unroll
        for (int b = 0; b < 2; ++b)
#pragma unroll
            for (int m = 0; m < 4; ++m)
#pragma unroll
                for (int n = 0; n < 2; ++n) acc[a][b][m][n] = (f32x4){0.f, 0.f, 0.f, 0.f};
    bf16x8 At[4][2], B0[2][2], B1[2][2];
    unsigned c00 = arow_off(d, cur, RA[0]) + CA2[0], c01 = arow_off(d, cur, RA[1]) + CA2[1], c10 = arow_off(d, cur, HALF + RA[0]) + CA2[0], c11 = arow_off(d, cur, HALF + RA[1]) + CA2[1];
    unsigned n00 = c00, n01 = c01, n10 = c10, n11 = c11;
    const char* const gA = (const char*)d.A;
    const char* cB = bptr(d, cur);
    if constexpr (SP2) {
        PG8_STAGE(PG8_SB(0, 0), cB, voffB); PG8_STAGE(PG8_SB(0, 1), cB + hstepB, voffB); PG8_STAGEA(PG8_SA(0, 0), gA, c00, c01); PG8_STAGEA(PG8_SA(0, 1), gA, c10, c11);
        if (wr == 1) PG8_BAR;
        PG8_WAIT_V(2); PG8_BAR;
        PG8_STAGE(PG8_SB(1, 0), cB + kstep, voffB); PG8_STAGEA(PG8_SA(1, 0), gA + kstep, c00, c01); PG8_STAGE(PG8_SB(1, 1), cB + hstepB + kstep, voffB);
        PG8_WAIT_V(6); PG8_BAR;
    } else {
        PG8_STAGE(PG8_SB(0, 0), cB, voffB); PG8_STAGEA(PG8_SA(0, 0), gA, c00, c01); PG8_STAGE(PG8_SB(0, 1), cB + hstepB, voffB); PG8_STAGEA(PG8_SA(0, 1), gA, c10, c11);
        if (wr == 1) PG8_BAR;
        PG8_WAIT_V(4); PG8_BAR;
        PG8_STAGE(PG8_SB(1, 0), cB + kstep, voffB); PG8_STAGEA(PG8_SA(1, 0), gA + kstep, c00, c01); PG8_STAGE(PG8_SB(1, 1), cB + hstepB + kstep, voffB);
        PG8_WAIT_V(6); PG8_BAR;
    }
    for (;;) {
        const bool has_next = S.next(ui + 1, nxt);
        const char* nB = cB;
        if (has_next) {
            int tl = tid; asm volatile("" : "+v"(tl)); int R0, C0, R1, C1; stage_rc(tl * 16, R0, C0); stage_rc(tl * 16 + 8192, R1, C1);
            n00 = arow_off(d, nxt, R0) + (unsigned)C0 * 2u; n01 = arow_off(d, nxt, R1) + (unsigned)C1 * 2u; n10 = arow_off(d, nxt, HALF + R0) + (unsigned)C0 * 2u; n11 = arow_off(d, nxt, HALF + R1) + (unsigned)C1 * 2u; nB = bptr(d, nxt); }
        else { n00 = c00; n01 = c01; n10 = c10; n11 = c11; }
        for (int t = 0; t < nt; t += 2) {
            const bool last = (t == nt - 2);
            const char* a1 = gA + (size_t)(t + 1) * kstep;
            const char* a2 = last ? gA : gA + (size_t)(t + 2) * kstep; const char* b2 = last ? nB : cB + (size_t)(t + 2) * kstep;
            const char* a3 = a2 + kstep; const char* b3 = b2 + kstep;
            const unsigned s00 = last ? n00 : c00, s01 = last ? n01 : c01, s10 = last ? n10 : c10, s11 = last ? n11 : c11;
            if constexpr (SP2) {
            PG8_LDB(B0, 0, 0); PG8_LDB(B1, 0, 1); PG8_SCHED; PG8_LDA(At, 0, 0); PG8_STAGEA(PG8_SA(1, 1), a1, c10, c11);
            PG8_WAIT_V(8); PG8_WAIT_L(0); PG8_BAR; PG8_MMA(0, 0, At, B0); PG8_MMA(0, 1, At, B1); PG8_BAR; PG8_SCHED;
            PG8_LDA(At, 0, 1); PG8_STAGE(PG8_SB(0, 0), b2, voffB); PG8_STAGE(PG8_SB(0, 1), b2 + hstepB, voffB); PG8_STAGEA(PG8_SA(0, 0), a2, s00, s01);
            PG8_WAIT_V(8); PG8_WAIT_L(0); PG8_BAR; PG8_MMA(1, 0, At, B0); PG8_MMA(1, 1, At, B1); PG8_BAR; PG8_SCHED;
            PG8_LDB(B0, 1, 0); PG8_LDB(B1, 1, 1); PG8_SCHED; PG8_LDA(At, 1, 0); PG8_STAGEA(PG8_SA(0, 1), a2, s10, s11);
            PG8_WAIT_V(8); PG8_WAIT_L(0); PG8_BAR; PG8_MMA(0, 0, At, B0); PG8_MMA(0, 1, At, B1); PG8_BAR; PG8_SCHED;
            PG8_LDA(At, 1, 1); PG8_STAGE(PG8_SB(1, 0), b3, voffB); PG8_STAGE(PG8_SB(1, 1), b3 + hstepB, voffB); PG8_STAGEA(PG8_SA(1, 0), a3, s00, s01);
            PG8_WAIT_V(8); PG8_WAIT_L(0); PG8_BAR; PG8_MMA(1, 0, At, B0); PG8_MMA(1, 1, At, B1); PG8_BAR; PG8_SCHED;
            } else {
            PG8_LDB(B0, 0, 0); PG8_SCHED; PG8_LDA(At, 0, 0); PG8_STAGEA(PG8_SA(1, 1), a1, c10, c11);
            PG8_WAIT_L(8); PG8_BAR; PG8_WAIT_L(0); PG8_MMA(0, 0, At, B0); PG8_BAR; PG8_SCHED;
            PG8_LDB(B1, 0, 1); PG8_STAGE(PG8_SB(0, 0), b2, voffB);
            PG8_BAR; PG8_WAIT_L(0); PG8_MMA(0, 1, At, B1); PG8_BAR;
            PG8_LDA(At, 0, 1); PG8_STAGEA(PG8_SA(0, 0), a2, s00, s01);
            PG8_BAR; PG8_WAIT_L(0); PG8_MMA(1, 0, At, B0); PG8_BAR; PG8_SCHED;
            PG8_STAGE(PG8_SB(0, 1), b2 + hstepB, voffB);
            PG8_WAIT_V(6); PG8_BAR; PG8_MMA(1, 1, At, B1); PG8_BAR;
            PG8_LDB(B0, 1, 0); PG8_SCHED; PG8_LDA(At, 1, 0); PG8_STAGEA(PG8_SA(0, 1), a2, s10, s11);
            PG8_WAIT_L(8); PG8_BAR; PG8_WAIT_L(0); PG8_MMA(0, 0, At, B0); PG8_BAR; PG8_SCHED;
            PG8_LDB(B1, 1, 1); PG8_STAGE(PG8_SB(1, 0), b3, voffB);
            PG8_BAR; PG8_WAIT_L(0); PG8_MMA(0, 1, At, B1); PG8_BAR;
            PG8_LDA(At, 1, 1); PG8_STAGEA(PG8_SA(1, 0), a3, s00, s01);
            PG8_BAR; PG8_WAIT_L(0); PG8_MMA(1, 0, At, B0); PG8_BAR; PG8_SCHED;
            PG8_STAGE(PG8_SB(1, 1), b3 + hstepB, voffB);
            PG8_WAIT_V(6); PG8_BAR; PG8_MMA(1, 1, At, B1); PG8_BAR;
            }
        }
        if constexpr (ALIGN_EPI) { if (wr == 0) PG8_BAR; }
        { int tl = tid; asm volatile("" : "+v"(tl)); const int wid_ = __builtin_amdgcn_readfirstlane(tl >> 6), ln_ = tl & 63;
          epi_any(acc, cur, wid_ >> 2, wid_ & 3, ln_ & 15, ln_ >> 4, d); }
        if (!has_next) break;
#pragma unroll
        for (int a = 0; a < 2; ++a)
#pragma unroll
            for (int b = 0; b < 2; ++b)
#pragma unroll
                for (int m = 0; m < 4; ++m)
#pragma unroll
                    for (int n = 0; n < 2; ++n) acc[a][b][m][n] = (f32x4){0.f, 0.f, 0.f, 0.f};
        cur = nxt; cB = nB; c00 = n00; c01 = n01; c10 = n10; c11 = n11; ++ui;
        if constexpr (ALIGN_EPI) { if (wr == 1) PG8_BAR; }
    }
    PG8_WAIT_V(0);
    if constexpr (!ALIGN_EPI) { if (wr == 0) PG8_BAR; }
    PG8_BAR;
#undef PG8_SA
#undef PG8_SB
#undef PG8_STAGE
#undef PG8_STAGEA
#undef PG8_LDA
#undef PG8_LDB
#undef PG8_MMA
#undef PG8_WAIT_V
#undef PG8_WAIT_L
#undef PG8_BAR
#undef PG8_SCHED
}
}

template <class RF>
__device__ __forceinline__ void cvt_block(const float* W, int ldw, int nvalid, int k0, int n0, bf16_t* WT, float scale, RF rowoff, float* scr, int lane) {
    const int c4 = 4 * (lane & 15), r4 = lane >> 4;
    const bool ok = (n0 + c4) < nvalid;
    float4 v[16];
#pragma unroll
    for (int i = 0; i < 16; ++i) v[i] = ok ? *(const float4*)(W + (size_t)(k0 + 4 * i + r4) * ldw + n0 + c4) : make_float4(0.f, 0.f, 0.f, 0.f);
#pragma unroll
    for (int i = 0; i < 16; ++i) { float* d = scr + (4 * i + r4) * 65 + c4; d[0] = v[i].x * scale; d[1] = v[i].y * scale; d[2] = v[i].z * scale; d[3] = v[i].w * scale; }
    asm volatile("s_waitcnt lgkmcnt(0)" ::: "memory");
    const int c = lane & 7;
#pragma unroll
    for (int jj = 0; jj < 8; ++jj) { const int n = (lane >> 3) + 8 * jj; const float* s = scr + (8 * c) * 65 + n;
        uint4 o; o.x = (unsigned)f2bf(s[0]) | ((unsigned)f2bf(s[65]) << 16); o.y = (unsigned)f2bf(s[2 * 65]) | ((unsigned)f2bf(s[3 * 65]) << 16);
        o.z = (unsigned)f2bf(s[4 * 65]) | ((unsigned)f2bf(s[5 * 65]) << 16); o.w = (unsigned)f2bf(s[6 * 65]) | ((unsigned)f2bf(s[7 * 65]) << 16);
        *(uint4*)(WT + rowoff(n0 + n) + k0 + 8 * c) = o; }
    asm volatile("s_waitcnt lgkmcnt(0)" ::: "memory");
}
__device__ __noinline__ int cvt_matrix(const float* W, size_t wstride, int nbatch, int K, int N, int nvalid, int ldw, bf16_t* WT, float scale, int rb, int sh, int rs, int mask, int r0, int ldt, int c1,
                                       unsigned* counter, int seg_lo, int pending) {
    const int tid = threadIdx.x, lane = tid & 63, wave = tid >> 6, gw = blockIdx.x * NWAVES + wave, NGW = gridDim.x * NWAVES;
    float* scr = (float*)lds_raw + wave * (64 * 65);
    const int nkb = K / 64, nnb = N / 64, per = nkb * nnb, total = per * nbatch;
    if (counter == nullptr) {
        for (int it = gw; it < total; it += NGW) { const int b = it / per, r = it % per, kb = r / nnb, nb = r % nnb;
            cvt_block(W + (size_t)b * wstride, ldw, nvalid, kb * 64, nb * 64, WT, scale, [=](int n) { return (size_t)(b * rb + (n >> sh) * rs + (n & mask) + r0) * ldt + (b & 1) * c1; }, scr, lane); }
        return 0;
    }
    const int seg_hi = seg_lo + (total + 3) / 4;
    int idx = pending;
    for (;;) {
        if (idx < 0) { unsigned v = 0; if (lane == 0) v = __hip_atomic_fetch_add(counter, 1u, __ATOMIC_RELAXED, __HIP_MEMORY_SCOPE_AGENT); idx = (int)__builtin_amdgcn_readfirstlane(v); }
        if (idx >= seg_hi) return idx;
        const int c0 = (idx - seg_lo) * 4, c1e = (c0 + 4 < total) ? c0 + 4 : total;
        for (int it = c0; it < c1e; ++it) { const int b = it / per, r = it % per, kb = r / nnb, nb = r % nnb;
            cvt_block(W + (size_t)b * wstride, ldw, nvalid, kb * 64, nb * 64, WT, scale, [=](int n) { return (size_t)(b * rb + (n >> sh) * rs + (n & mask) + r0) * ldt + (b & 1) * c1; }, scr, lane); }
        idx = -1;
    }
}
__device__ __noinline__ void ph_pre(const float* x, const float* rel_bias, unsigned char* ws) {
    const int tid = threadIdx.x, lane = tid & 63, wave = tid >> 6, gw = blockIdx.x * NWAVES + wave, NGW = gridDim.x * NWAVES; float* ldsf = (float*)lds_raw;
    (void)lane; (void)wave; (void)gw; (void)NGW; (void)ldsf;
        {
            const size_t stride = (size_t)gridDim.x * NTHR, n4 = (size_t)M * D / 4;
            for (size_t i = (size_t)blockIdx.x * NTHR + tid; i < n4; i += 4 * stride) {
                float4 v[4];
#pragma unroll
                for (int q = 0; q < 4; ++q) v[q] = (i + q * stride < n4) ? ((const float4*)x)[i + q * stride] : make_float4(0.f, 0.f, 0.f, 0.f);
#pragma unroll
                for (int q = 0; q < 4; ++q) if (i + q * stride < n4) { uint2 o; o.x = (unsigned)f2bf(v[q].x) | ((unsigned)f2bf(v[q].y) << 16); o.y = (unsigned)f2bf(v[q].z) | ((unsigned)f2bf(v[q].w) << 16); ((uint2*)XB)[i + q * stride] = o; }
            }
        }
        for (int i = blockIdx.x * NTHR + tid; i < 4096 * 16; i += gridDim.x * NTHR) { const int d = i >> 4, h = i & 15; BIAS_T[i] = rel_bias[t5_bucket(d) * 16 + h]; }
}

__device__ __noinline__ void ph_prep_dsa_fold(const float* w_uq, const float* w_uk, bf16_t* wq, bf16_t* wuv) {
    const int tid = threadIdx.x; float* ldsf = (float*)lds_raw;
    for (int i = blockIdx.x * NTHR + tid; i < HW * 32; i += gridDim.x * NTHR) { const int row = i >> 5, ch = i & 31, h = row >> 7; *(uint4*)(wuv + (size_t)row * 512 + ((h & 1) ^ 1) * 256 + ch * 8) = make_uint4(0u, 0u, 0u, 0u); }
    gemm_naive(ldsf, H, KVL, QL, HD,
        [=](int h, int c, int d) { return w_uk[((size_t)h * HD + d) * KVL + c]; },
        [=](int h, int d, int k) { return w_uq[(size_t)k * HW + h * HD + d]; },
        [=](int h, int c, int k, float v) { wq[(size_t)(h * KVL + c) * QL + k] = f2bf(v * 0.08838834764831845f); });
}

__device__ __noinline__ void ph_dsa_norms(const float* qn, const float* kn, unsigned char* ws) {
    const int tid = threadIdx.x, lane = tid & 63, wave = tid >> 6, gw = blockIdx.x * NWAVES + wave, NGW = gridDim.x * NWAVES; float* ldsf = (float*)lds_raw;
    (void)lane; (void)wave; (void)gw; (void)NGW; (void)ldsf;
                for (int m = gw; m < M; m += NGW) {
                    const float* p = PRAW + (size_t)m * 1024;
                    float v[8]; float s = 0.f;
#pragma unroll
                    for (int i = 0; i < 8; ++i) { v[i] = p[lane + 64 * i]; s += v[i] * v[i]; }
                    float r = rsqrtf(wave_sum(s) * (1.f / QL) + EPS);
#pragma unroll
                    for (int i = 0; i < 8; ++i) CQ[(size_t)m * QL + lane + 64 * i] = f2bf(v[i] * r * qn[lane + 64 * i]);
                    s = 0.f;
#pragma unroll
                    for (int i = 0; i < 4; ++i) { v[i] = p[QL + lane + 64 * i]; s += v[i] * v[i]; }
                    r = rsqrtf(wave_sum(s) * (1.f / KVL) + EPS);
#pragma unroll
                    for (int i = 0; i < 4; ++i) CKV[(size_t)m * KVL + lane + 64 * i] = f2bf(v[i] * r * kn[lane + 64 * i]);
                    KIDX[(size_t)m * IDM + lane] = f2bf(p[QL + KVL + lane]);
                    if (lane < IH) WIDX[(size_t)m * IH + lane] = p[QL + KVL + IDM + lane] * 0.25f;
                }
}

typedef short s16x8 __attribute__((ext_vector_type(8)));
typedef float f32x16 __attribute__((ext_vector_type(16)));
__device__ __forceinline__ void ph_dsa_index(unsigned char* ws) {
    int tid_ = threadIdx.x; asm volatile("" : "+v"(tid_));
    const int tid = tid_, lane = tid & 63, wave = __builtin_amdgcn_readfirstlane(tid >> 6);
    LAS unsigned char* lds = (LAS unsigned char*)lds_raw;
    const bf16_t* qall = QALL; const bf16_t* kidx = KIDX; const float* widx = WIDX; float* scb = SC;
    for (int unit = blockIdx.x; unit < NB_ * 64; unit += gridDim.x) {
        const int b = unit & 3, p = unit >> 2;
#pragma unroll 1
        for (int half = 0; half < 2; ++half) {
            const int qb = half ? p : 127 - p;
            const size_t qrow0 = (size_t)b * T + (size_t)qb * 32;
            __syncthreads();
#pragma unroll
            for (int i = 0; i < 8; ++i) { const int item = tid + 512 * i, q = item >> 7, hc = item & 127, h = hc >> 3, c = hc & 7;
                const uint4 v = *(const uint4*)(qall + (qrow0 + q) * QALD + 4096 + h * 64 + c * 8);
                *(LAS pg8::u32x4*)(lds + ((h * 4 + (c >> 1)) * 64 + q + 32 * (c & 1)) * 16) = (pg8::u32x4){v.x, v.y, v.z, v.w}; }
            if (tid < 256) {
                const int q = tid >> 3, c = tid & 7; float acc8[8];
#pragma unroll
                for (int e2 = 0; e2 < 8; ++e2) acc8[e2] = 0.f;
#pragma unroll 4
                for (int h = 0; h < 16; ++h) { const float w = widx[(qrow0 + q) * 16 + h]; const uint4 v = *(const uint4*)(qall + (qrow0 + q) * QALD + 4096 + h * 64 + c * 8); const unsigned w4[4] = {v.x, v.y, v.z, v.w};
#pragma unroll
                    for (int e2 = 0; e2 < 4; ++e2) { acc8[2 * e2] = fmaf(w, __uint_as_float(w4[e2] << 16), acc8[2 * e2]); acc8[2 * e2 + 1] = fmaf(w, __uint_as_float(w4[e2] & 0xffff0000u), acc8[2 * e2 + 1]); } }
                pg8::u32x4 o; o.x = (unsigned)f2bf(acc8[0]) | ((unsigned)f2bf(acc8[1]) << 16); o.y = (unsigned)f2bf(acc8[2]) | ((unsigned)f2bf(acc8[3]) << 16);
                o.z = (unsigned)f2bf(acc8[4]) | ((unsigned)f2bf(acc8[5]) << 16); o.w = (unsigned)f2bf(acc8[6]) | ((unsigned)f2bf(acc8[7]) << 16);
                *(LAS pg8::u32x4*)(lds + ((16 * 4 + (c >> 1)) * 64 + q + 32 * (c & 1)) * 16) = o;
            }
            if (tid < 512) { const int h = tid >> 5, q = tid & 31; *(LAS float*)(lds + 69632 + (h * 32 + q) * 4) = widx[(qrow0 + q) * 16 + h]; }
            __syncthreads();
            float* const scq = scb + (size_t)b * SC_PER_B + (size_t)512 * qb * (qb + 1) + (size_t)(lane & 31) * (32 * (qb + 1)) + 4 * (lane >> 5);
#pragma unroll 1
            for (int kb = wave; kb <= qb; kb += NWAVES) {
                s16x8 ka[4];
                { const bf16_t* kp = kidx + ((size_t)b * T + kb * 32 + (lane & 31)) * IDM + 8 * (lane >> 5);
#pragma unroll
                  for (int s = 0; s < 4; ++s) ka[s] = *(const s16x8*)(kp + 16 * s); }
                f32x16 acc;
                {
                    const f32x16 z = {0.f, 0.f, 0.f, 0.f, 0.f, 0.f, 0.f, 0.f, 0.f, 0.f, 0.f, 0.f, 0.f, 0.f, 0.f, 0.f};
                    acc = __builtin_amdgcn_mfma_f32_32x32x16_bf16(ka[0], *(const LAS s16x8*)(lds + ((16 * 4 + 0) * 64 + lane) * 16), z, 0, 0, 0);
#pragma unroll
                    for (int s = 1; s < 4; ++s) acc = __builtin_amdgcn_mfma_f32_32x32x16_bf16(ka[s], *(const LAS s16x8*)(lds + ((16 * 4 + s) * 64 + lane) * 16), acc, 0, 0, 0);
                }
#pragma unroll 2
                for (int h = 0; h < 16; ++h) {
                    const f32x16 z = {0.f, 0.f, 0.f, 0.f, 0.f, 0.f, 0.f, 0.f, 0.f, 0.f, 0.f, 0.f, 0.f, 0.f, 0.f, 0.f};
                    f32x16 sv = __builtin_amdgcn_mfma_f32_32x32x16_bf16(ka[0], *(const LAS s16x8*)(lds + ((h * 4 + 0) * 64 + lane) * 16), z, 0, 0, 0);
#pragma unroll
                    for (int s = 1; s < 4; ++s) sv = __builtin_amdgcn_mfma_f32_32x32x16_bf16(ka[s], *(const LAS s16x8*)(lds + ((h * 4 + s) * 64 + lane) * 16), sv, 0, 0, 0);
                    const float w = *(const LAS float*)(lds + 69632 + (h * 32 + (lane & 31)) * 4);
#pragma unroll
                    for (int r = 0; r < 16; ++r) acc[r] = fmaf(__builtin_fabsf(sv[r]), w, acc[r]);
                }
#pragma unroll
                for (int g = 0; g < 4; ++g) *(float4*)(scq + kb * 32 + 8 * g) = make_float4(acc[4 * g], acc[4 * g + 1], acc[4 * g + 2], acc[4 * g + 3]);
            }
        }
    }
    __syncthreads();
}


typedef float f32x4v __attribute__((ext_vector_type(4)));

__device__ __forceinline__ void ph_dsa_topk_attn(unsigned char* ws) {
    int tid_ = threadIdx.x; asm volatile("" : "+v"(tid_));
    const int tid = tid_, lane = tid & 63, wave = __builtin_amdgcn_readfirstlane(tid >> 6), n16 = lane & 15, g4 = lane >> 4;
    LAS unsigned char* lds = (LAS unsigned char*)lds_raw;
    float* sw = (float*)lds_raw + wave * 4096;
    LAS unsigned char* kvb = lds + wave * 16384;
    LAS int* sl = (LAS int*)(lds + 131072 + wave * 1024);
    LAS int* sell = sl;
    const bf16_t* qall = QALL; const bf16_t* ckv = CKV; const float* biasT = BIAS_T; bf16_t* olat = OLAT;
    const float NINF = -__builtin_inff(), PINF = __builtin_inff();
    typedef __attribute__((address_space(1))) const pg8::f32x4 gf4;
    const int nrows = M / (int)gridDim.x;
    LAS int* qctr = (LAS int*)(lds + LDS_MISC + 3072);
    __syncthreads();
    if (tid == 0) *qctr = NWAVES;
    __syncthreads();
    auto row_of = [&](int j) -> int {
        if (gridDim.x == 256) { const int bq = ((int)blockIdx.x & 7) >> 1, wb = (((int)blockIdx.x & 1) * 32 + ((int)blockIdx.x >> 3)) * NWAVES + (j & 7); return bq * T + wb + 512 * (7 - (j >> 3)); }
        return (int)blockIdx.x * nrows + j; };
    pg8::f32x4 xs[16];
    auto fetch = [&](int j) {
        if (j < nrows) { const int m = row_of(j), b = m / T, t = m % T, n = t + 1;
            if (n > TOPK) { const int nq = (n + 255) >> 8; gf4* sg = (gf4*)(SC + sc_off(b, t)) + lane;
#pragma unroll
                for (int i = 0; i < 16; ++i) xs[i] = (i < nq) ? sg[64 * i] : (pg8::f32x4){NINF, NINF, NINF, NINF}; } }
    };
    int jcur = wave;
    fetch(jcur);
    while (jcur < nrows) {
        const int m = row_of(jcur);
        int jn; { int tkv = 0; if (lane == 0) tkv = __hip_atomic_fetch_add(qctr, 1, __ATOMIC_RELAXED, __HIP_MEMORY_SCOPE_WORKGROUP); jn = __builtin_amdgcn_readfirstlane(tkv); }
        jcur = jn;
        const int b = m / T, t = m % T, n = t + 1;
        float zf = 0.f; asm volatile("" : "+v"(zf));
        s16x8 qf[8];
        { const bf16_t* qrow = qall + (size_t)m * QALD + n16 * KVL + 8 * g4;
#pragma unroll
          for (int s = 0; s < 8; ++s) qf[s] = *(const s16x8*)(qrow + 32 * s); }
        int nsel;
        if (n <= TOPK) {
            int l3 = tid; asm volatile("" : "+v"(l3)); l3 &= 63;
#pragma unroll
            for (int i = 0; i < 4; ++i) { const int k = l3 + 64 * i; sl[k] = (k < n) ? k : 0; }
            nsel = n;
        } else {
            const int nq = (n + 255) >> 8;
            float mn = PINF, mx = NINF;
            {
#pragma unroll
                for (int i = 0; i < 16; ++i) { const int k0 = 4 * (lane + 64 * i); float4 x = make_float4(xs[i][0], xs[i][1], xs[i][2], xs[i][3]);
                    x.x = (k0 + 0 < n) ? x.x : NINF; x.y = (k0 + 1 < n) ? x.y : NINF; x.z = (k0 + 2 < n) ? x.z : NINF; x.w = (k0 + 3 < n) ? x.w : NINF;
                    *(float4*)(sw + k0) = x;
                    mx = fmaxf(fmaxf(mx, x.x), fmaxf(x.y, fmaxf(x.z, x.w)));
                    mn = fminf(mn, x.x == NINF ? PINF : x.x); mn = fminf(mn, x.y == NINF ? PINF : x.y); mn = fminf(mn, x.z == NINF ? PINF : x.z); mn = fminf(mn, x.w == NINF ? PINF : x.w); }
            }
            float lo_v = wave_min_dpp(mn), hi_v = wave_max_dpp(mx);
            int c_lo = n, c_hi = 1;
#pragma unroll 1
            for (int it = 0; it < 96; ++it) {
                if (c_lo == TOPK) break;
                float f = 0.5f;
                if ((it & 1) == 0) { f = ((float)(c_lo - TOPK) + 0.5f) / (float)(c_lo - c_hi); f = fminf(fmaxf(f, 0.03f), 0.97f); }
                float mid = lo_v + (hi_v - lo_v) * f;
                if (!(mid > lo_v && mid < hi_v)) { mid = lo_v + (hi_v - lo_v) * 0.5f; if (!(mid > lo_v && mid < hi_v)) break; }
                int c = 0;
#pragma unroll 1
                for (int i0 = 0; i0 < nq; i0 += 8) {
                    float4 x8[8];
#pragma unroll
                    for (int j = 0; j < 8; ++j) x8[j] = *(const float4*)(sw + 4 * (lane + 64 * (i0 + j)));
#pragma unroll
                    for (int j = 0; j < 8; ++j) c += (x8[j].x >= mid) + (x8[j].y >= mid) + (x8[j].z >= mid) + (x8[j].w >= mid);
                }
                c = wave_sum_dpp(c);
                if (c >= TOPK) { lo_v = mid; c_lo = c; } else { hi_v = mid; c_hi = c; }
            }
            float Tv = lo_v;
            int lgt = 0, leq = 0;
#pragma unroll 4
            for (int i = 0; i < nq; ++i) { const float4 x = *(const float4*)(sw + 4 * (lane + 64 * i));
                lgt += (x.x > Tv) + (x.y > Tv) + (x.z > Tv) + (x.w > Tv); leq += (x.x == Tv) + (x.y == Tv) + (x.z == Tv) + (x.w == Tv); }
            int sgt = wave_scan_dpp(lgt), seq = wave_scan_dpp(leq);
            int cgt = __builtin_amdgcn_readlane(sgt, 63), ceq = __builtin_amdgcn_readlane(seq, 63);
            if (cgt > TOPK) {
                Tv = hi_v; lgt = 0; leq = 0;
#pragma unroll 4
                for (int i = 0; i < nq; ++i) { const float4 x = *(const float4*)(sw + 4 * (lane + 64 * i)); leq += (x.x == Tv) + (x.y == Tv) + (x.z == Tv) + (x.w == Tv); }
                cgt = 0; sgt = 0; seq = wave_scan_dpp(leq); ceq = __builtin_amdgcn_readlane(seq, 63);
            }
            const int need = TOPK - cgt;
            int p = sgt - lgt, q = cgt + seq - leq;
            const bool all_ties = (ceq <= need);
#pragma unroll 2
            for (int i = 0; i < nq; ++i) {
                const int k0 = 4 * (lane + 64 * i); const float4 x = *(const float4*)(sw + k0); const float xv[4] = {x.x, x.y, x.z, x.w};
#pragma unroll
                for (int e2 = 0; e2 < 4; ++e2) { if (xv[e2] > Tv) sl[p++] = k0 + e2; else if (all_ties && xv[e2] == Tv) sl[q++] = k0 + e2; }
            }
            if (!all_ties) {
                int taken_below = -1;
                _Pragma("unroll 1") for (int i2 = 0; i2 < need; ++i2) {
                    int best = 0x7fffffff;
                    _Pragma("unroll 1") for (int i = 0; i < nq; ++i) { const int k0 = 4 * (lane + 64 * i); const float4 x = *(const float4*)(sw + k0); const float xv[4] = {x.x, x.y, x.z, x.w};
#pragma unroll
                        for (int e2 = 0; e2 < 4; ++e2) { const int key = k0 + e2; if (xv[e2] == Tv && key > taken_below && key < best) best = key; } }
                    best = wave_min_i(best);
                    if (lane == 0) sl[cgt + i2] = best;
                    taken_below = best;
                }
            }
            nsel = TOPK;
        }
        fetch(jn);
        f32x4v o[16];
#pragma unroll
        for (int cb = 0; cb < 16; ++cb) o[cb] = (f32x4v){zf, zf, zf, zf};
        float m_run = -1e30f, l_run = 0.f;
        const int nch = (nsel + 31) >> 5;
        const size_t rowb = (size_t)b * T;
#pragma unroll 1
        for (int ch = 0; ch < nch; ++ch) {
            asm volatile("s_waitcnt lgkmcnt(0)" ::: "memory");
#pragma unroll
            for (int i = 0; i < 16; ++i) { const int row = 2 * i + (lane >> 5), key = sell[ch * 32 + row], c = (lane & 31) ^ (row & 15);
                __builtin_amdgcn_global_load_lds((const unsigned*)(ckv + (rowb + key) * KVL + c * 8), (LAS unsigned*)(kvb + i * 1024), 16, 0, 0); }
            const pg8::u32x4 k0 = *(const LAS pg8::u32x4*)(sell + ch * 32 + 4 * g4), k1 = *(const LAS pg8::u32x4*)(sell + ch * 32 + 16 + 4 * g4);
            float bia[8];
            bia[0] = biasT[(t - (int)k0.x) * 16 + n16]; bia[1] = biasT[(t - (int)k0.y) * 16 + n16]; bia[2] = biasT[(t - (int)k0.z) * 16 + n16]; bia[3] = biasT[(t - (int)k0.w) * 16 + n16];
            bia[4] = biasT[(t - (int)k1.x) * 16 + n16]; bia[5] = biasT[(t - (int)k1.y) * 16 + n16]; bia[6] = biasT[(t - (int)k1.z) * 16 + n16]; bia[7] = biasT[(t - (int)k1.w) * 16 + n16];
            asm volatile("s_waitcnt vmcnt(0)" ::: "memory");
            f32x4v s0 = (f32x4v){0.f, 0.f, 0.f, 0.f}, s1 = (f32x4v){0.f, 0.f, 0.f, 0.f};
#pragma unroll
            for (int s = 0; s < 8; ++s) {
                const int cs = ((4 * s + g4) ^ n16) * 16;
                const s16x8 a0 = *(const LAS s16x8*)(kvb + n16 * 512 + cs), a1 = *(const LAS s16x8*)(kvb + (16 + n16) * 512 + cs);
                s0 = __builtin_amdgcn_mfma_f32_16x16x32_bf16(a0, qf[s], s0, 0, 0, 0); s1 = __builtin_amdgcn_mfma_f32_16x16x32_bf16(a1, qf[s], s1, 0, 0, 0);
            }
            float sc[8]; float tmax = -__builtin_inff();
#pragma unroll
            for (int r = 0; r < 4; ++r) { sc[r] = (ch * 32 + 4 * g4 + r < nsel) ? s0[r] + bia[r] : -__builtin_inff(); sc[4 + r] = (ch * 32 + 16 + 4 * g4 + r < nsel) ? s1[r] + bia[4 + r] : -__builtin_inff(); }
#pragma unroll
            for (int r = 0; r < 8; ++r) tmax = fmaxf(tmax, sc[r]);
            tmax = fmaxf(tmax, __shfl_xor(tmax, 16)); tmax = fmaxf(tmax, __shfl_xor(tmax, 32));
            if (__any(tmax > m_run + 6.f)) {
                const float mnew = fmaxf(m_run, tmax), alpha = __expf(m_run - mnew);
#pragma unroll
                for (int cb = 0; cb < 16; ++cb) o[cb] *= alpha;
                l_run *= alpha; m_run = mnew;
            }
            float p[8]; float psum = 0.f;
#pragma unroll
            for (int r = 0; r < 8; ++r) { p[r] = __expf(sc[r] - m_run); psum += p[r]; }
            l_run += psum;
            s16x8 pb;
            { const unsigned w0 = pg8::cvt_pk_bf16(p[0], p[1]), w1 = pg8::cvt_pk_bf16(p[2], p[3]), w2 = pg8::cvt_pk_bf16(p[4], p[5]), w3 = pg8::cvt_pk_bf16(p[6], p[7]);
              pb[0] = (short)(w0 & 0xffff); pb[1] = (short)(w0 >> 16); pb[2] = (short)(w1 & 0xffff); pb[3] = (short)(w1 >> 16); pb[4] = (short)(w2 & 0xffff); pb[5] = (short)(w2 >> 16); pb[6] = (short)(w3 & 0xffff); pb[7] = (short)(w3 >> 16); }
            {
                const int q4 = n16 >> 2, p4 = n16 & 3, x = 4 * g4 + q4;
                const LAS unsigned char* vb = kvb + x * 512 + (p4 & 1) * 8;
                const int yo = (p4 >> 1) ^ (x & 1), xe = x & 14;
#pragma unroll
                for (int cq = 0; cq < 4; ++cq) {
                    typedef short s16x4 __attribute__((ext_vector_type(4)));
                    s16x4 lo[4], hi4[4];
#pragma unroll
                    for (int u = 0; u < 4; ++u) { const int cb = 4 * cq + u; const int co = (((2 * cb) ^ xe) + yo) * 16;
                        lo[u] = __builtin_bit_cast(s16x4, __builtin_amdgcn_ds_read_tr16_b64_v4i16((LAS s16x4*)(vb + co)));
                        hi4[u] = __builtin_bit_cast(s16x4, __builtin_amdgcn_ds_read_tr16_b64_v4i16((LAS s16x4*)(vb + 16 * 512 + co))); }
#pragma unroll
                    for (int u = 0; u < 4; ++u) { const int cb = 4 * cq + u;
                        s16x8 va; va[0] = lo[u][0]; va[1] = lo[u][1]; va[2] = lo[u][2]; va[3] = lo[u][3]; va[4] = hi4[u][0]; va[5] = hi4[u][1]; va[6] = hi4[u][2]; va[7] = hi4[u][3];
                        o[cb] = __builtin_amdgcn_mfma_f32_16x16x32_bf16(va, pb, o[cb], 0, 0, 0); }
                }
            }
        }
        {
            float lt = l_run; lt += __shfl_xor(lt, 16); lt += __shfl_xor(lt, 32);
            const float inv = 1.f / lt;
            bf16_t* orow = olat + (size_t)m * 4096 + n16 * KVL + 4 * g4;
#pragma unroll
            for (int cb = 0; cb < 16; ++cb) { pg8::u32x2 w; w.x = pg8::cvt_pk_bf16(o[cb][0] * inv, o[cb][1] * inv); w.y = pg8::cvt_pk_bf16(o[cb][2] * inv, o[cb][3] * inv); *(pg8::u32x2*)(orow + 16 * cb) = w; }
        }
    }
    __syncthreads();
}

__device__ __forceinline__ void ph_dil_attn(unsigned char* ws, unsigned* qbase) {
    int tid_ = threadIdx.x; asm volatile("" : "+v"(tid_));
    const int tid = tid_, lane = tid & 63, wave = __builtin_amdgcn_readfirstlane(tid >> 6), qi = lane & 31, hi = lane >> 5;
    LAS unsigned char* lds = (LAS unsigned char*)lds_raw;
    LAS unsigned char* kbuf = lds + wave * 16384;
    LAS unsigned char* vbuf = kbuf + 8192;
    const int drow = lane >> 4, kc0 = ((lane & 15) ^ drow) * 8, kc1 = ((lane & 15) ^ (4 + drow)) * 8, vc = ((lane & 15) ^ (drow << 2)) * 8;
    LAS float* btab = (LAS float*)(lds + 131072);
    const bf16_t* qkv = QKV; bf16_t* ob = OB; const float* biasT = BIAS_T;
    bf16_t* stb = (bf16_t*)(ws + AR_DST) + (size_t)blockIdx.x * (512 * 128);
    float* mlb = (float*)(ws + AR_DML) + (size_t)blockIdx.x * (512 * 4);
    const int xq = (int)blockIdx.x & 7, nfirst = (int)gridDim.x >> 3;
    LAS int* tkw = (LAS int*)(lds + LDS_MISC + 3072);
    for (int j = (int)blockIdx.x >> 3; j < 64; ) {
        float zf = 0.f; asm volatile("" : "+v"(zf));
        const f32x16 zero16 = {zf, zf, zf, zf, zf, zf, zf, zf, zf, zf, zf, zf, zf, zf, zf, zf};
        const int bhi = (j < 56) ? j / 7 : j - 56, span = (j < 56) ? 1 + j % 7 : 0;
        const int x = xq, u = 8 * bhi + span, bh = x + 8 * (u >> 3), h = bh & 15, s0 = (u & 7) * 512;
        __syncthreads();
        if (tid == 0) *tkw = nfirst + (int)__hip_atomic_fetch_add(qbase + 16 * xq, 1u, __ATOMIC_RELAXED, __HIP_MEMORY_SCOPE_AGENT);
        { int t2 = tid; asm volatile("" : "+v"(t2));
          if (t2 < 387) { const int br = t2 / 129, m = t2 - br * 129, dl = (br == 0) ? 1 : (br == 1 ? 4 : 16); btab[br * 132 + m] = biasT[(dl * m) * 16 + h] * 1.4426950408889634f; } }
        __syncthreads();
        const bf16_t* qbase = qkv + (size_t)bh * T * HD + 8 * hi;
        const bf16_t* kbase = qkv + (size_t)(64 + bh) * T * HD;
        const bf16_t* vbase = qkv + (size_t)(128 + bh) * T * HD;
        s16x8 qf[8], kf[8];
        f32x16 o0 = zero16, o1 = zero16, o2 = zero16, o3 = zero16;
        float m_run = -1e30f, l_run = 0.f;
        int br = 0, gi = 0, kt = 0, tb = s0 + 32 * wave, tq = 0;
        while (tb + (-128 + 32 * kt + 31) < 0) ++kt;
        bool fresh = true;
        {
            const int J0 = -128 + 32 * kt;
#pragma unroll
            for (int i = 0; i < 8; ++i) { int tk = tb + (J0 + 4 * i + drow); tk = tk < 0 ? 0 : tk;
                __builtin_amdgcn_global_load_lds((const unsigned*)(kbase + (size_t)tk * HD + ((i & 1) ? kc1 : kc0)), (LAS unsigned*)(kbuf + i * 1024), 16, 0, 0); }
#pragma unroll
            for (int i = 0; i < 8; ++i) { int tv = tb + (J0 + 4 * i + drow); tv = tv < 0 ? 0 : tv;
                __builtin_amdgcn_global_load_lds((const unsigned*)(vbase + (size_t)tv * HD + vc), (LAS unsigned*)(vbuf + i * 1024), 16, 0, 0); }
        }
#pragma unroll 1
        for (;;) {
            const int shift = 2 * br, J0 = -128 + 32 * kt;
            if (fresh) {
                tq = tb + (qi << shift);
                if (br > 0 && gi == 0) { asm volatile("s_waitcnt vmcnt(0)" ::: "memory"); __syncthreads(); }
                const bf16_t* qrow = qbase + (size_t)tq * HD;
#pragma unroll
                for (int s = 0; s < 8; ++s) qf[s] = *(const s16x8*)(qrow + 16 * s);
                if (br == 0) { o0 = zero16; o1 = zero16; o2 = zero16; o3 = zero16; m_run = -1e30f; l_run = 0.f; }
                else {
                    const int ql = (tq - s0) * 2 + hi;
                    const pg8::u32x4* sp = (const pg8::u32x4*)(stb + (size_t)ql * 64);
                    const float2 ml = *(const float2*)(mlb + ql * 2); m_run = ml.x; l_run = ml.y;
#define DIL_LD(O, DB) { const pg8::u32x4 w0 = sp[2 * (DB)], w1 = sp[2 * (DB) + 1]; \
                        O[0] = __uint_as_float(w0.x << 16); O[1] = __uint_as_float(w0.x & 0xffff0000u); O[2] = __uint_as_float(w0.y << 16); O[3] = __uint_as_float(w0.y & 0xffff0000u); \
                        O[4] = __uint_as_float(w0.z << 16); O[5] = __uint_as_float(w0.z & 0xffff0000u); O[6] = __uint_as_float(w0.w << 16); O[7] = __uint_as_float(w0.w & 0xffff0000u); \
                        O[8] = __uint_as_float(w1.x << 16); O[9] = __uint_as_float(w1.x & 0xffff0000u); O[10] = __uint_as_float(w1.y << 16); O[11] = __uint_as_float(w1.y & 0xffff0000u); \
                        O[12] = __uint_as_float(w1.z << 16); O[13] = __uint_as_float(w1.z & 0xffff0000u); O[14] = __uint_as_float(w1.w << 16); O[15] = __uint_as_float(w1.w & 0xffff0000u); }
                    DIL_LD(o0, 0) DIL_LD(o1, 1) DIL_LD(o2, 2) DIL_LD(o3, 3)
#undef DIL_LD
                }
            }
            const int mmax = min(128, tq >> shift);
            int nbr = br, ngi = gi, nkt = kt + 1, ntb = tb;
            if (nkt == 5) {
                ++ngi; if (ngi == 2) { ngi = 0; ++nbr; }
                nkt = 0;
                if (nbr < 3) { const int g = wave + 8 * ngi, ndl = 1 << (2 * nbr);
                    ntb = s0 + ((nbr == 0) ? 32 * g : (nbr == 1) ? 128 * (g >> 2) + (g & 3) : g);
                    while (ntb + (-128 + 32 * nkt + 31) * ndl < 0) ++nkt; }
            }
            const bool more = nbr < 3, glast = (kt == 4);
            const int mb = qi - J0 - 4 * hi;
            const LAS float* bt = btab + br * 132;
            float bv[16];
#pragma unroll
            for (int r = 0; r < 16; ++r) { const int m = mb - ((r & 3) + 8 * (r >> 2)); bv[r] = bt[min(max(m, 0), 128)]; }
            asm volatile("s_waitcnt vmcnt(8)" ::: "memory");
#pragma unroll
            for (int s = 0; s < 8; ++s) kf[s] = *(const LAS s16x8*)(kbuf + qi * 256 + (((2 * s + hi) ^ (qi & 7)) * 16));
            asm volatile("s_waitcnt lgkmcnt(0)" ::: "memory");
            if (more) {
                const int ndl = 1 << (2 * nbr), nJ0 = -128 + 32 * nkt;
#pragma unroll
                for (int i = 0; i < 8; ++i) { int tk = ntb + (nJ0 + 4 * i + drow) * ndl; tk = tk < 0 ? 0 : tk;
                    __builtin_amdgcn_global_load_lds((const unsigned*)(kbase + (size_t)tk * HD + ((i & 1) ? kc1 : kc0)), (LAS unsigned*)(kbuf + i * 1024), 16, 0, 0); }
            }
            f32x16 sc = __builtin_amdgcn_mfma_f32_32x32x16_bf16(kf[0], qf[0], (f32x16){0.f, 0.f, 0.f, 0.f, 0.f, 0.f, 0.f, 0.f, 0.f, 0.f, 0.f, 0.f, 0.f, 0.f, 0.f, 0.f}, 0, 0, 0);
#pragma unroll
            for (int s = 1; s < 8; ++s) sc = __builtin_amdgcn_mfma_f32_32x32x16_bf16(kf[s], qf[s], sc, 0, 0, 0);
            float tmax = -__builtin_inff();
#pragma unroll
            for (int r = 0; r < 16; ++r) { const int m = mb - ((r & 3) + 8 * (r >> 2));
                sc[r] = ((unsigned)m <= (unsigned)mmax) ? sc[r] + bv[r] : -__builtin_inff(); tmax = fmaxf(tmax, sc[r]); }
            tmax = fmaxf(tmax, __shfl_xor(tmax, 32));
            if (__any(tmax > m_run + 8.f)) {
                const float mnew = fmaxf(m_run, tmax), alpha = __builtin_amdgcn_exp2f(m_run - mnew);
                o0 *= alpha; o1 *= alpha; o2 *= alpha; o3 *= alpha; l_run *= alpha; m_run = mnew;
            }
            float psum = 0.f; unsigned pk[8];
#pragma unroll
            for (int r = 0; r < 16; r += 2) { const float p0 = __builtin_amdgcn_exp2f(sc[r] - m_run), p1 = __builtin_amdgcn_exp2f(sc[r + 1] - m_run); psum += p0 + p1; pk[r >> 1] = pg8::cvt_pk_bf16(p0, p1); }
            l_run += psum;
            if (more) asm volatile("s_waitcnt vmcnt(8)" ::: "memory"); else asm volatile("s_waitcnt vmcnt(0)" ::: "memory");
            {
                const int G4 = lane >> 4, q4 = (lane & 15) >> 2, p4 = lane & 3;
                const LAS unsigned char* vb = vbuf + (4 * (G4 >> 1) + q4) * 256 + (2 * (G4 & 1) + (p4 >> 1)) * 16 + (p4 & 1) * 8;
#pragma unroll
                for (int s2 = 0; s2 < 2; ++s2) {
                    s16x8 pb; pb[0] = (short)(pk[4 * s2] & 0xffff); pb[1] = (short)(pk[4 * s2] >> 16); pb[2] = (short)(pk[4 * s2 + 1] & 0xffff); pb[3] = (short)(pk[4 * s2 + 1] >> 16);
                    pb[4] = (short)(pk[4 * s2 + 2] & 0xffff); pb[5] = (short)(pk[4 * s2 + 2] >> 16); pb[6] = (short)(pk[4 * s2 + 3] & 0xffff); pb[7] = (short)(pk[4 * s2 + 3] >> 16);
                    typedef short s16x4 __attribute__((ext_vector_type(4)));
                    s16x4 lo[4], hi4[4];
#pragma unroll
                    for (int db = 0; db < 4; ++db) { const int sw = (db ^ q4) * 64;
                        lo[db] = __builtin_bit_cast(s16x4, __builtin_amdgcn_ds_read_tr16_b64_v4i16((LAS s16x4*)(vb + (16 * s2) * 256 + sw)));
                        hi4[db] = __builtin_bit_cast(s16x4, __builtin_amdgcn_ds_read_tr16_b64_v4i16((LAS s16x4*)(vb + (16 * s2 + 8) * 256 + sw))); }
#pragma unroll
                    for (int db = 0; db < 4; ++db) {
                        s16x8 va; va[0] = lo[db][0]; va[1] = lo[db][1]; va[2] = lo[db][2]; va[3] = lo[db][3]; va[4] = hi4[db][0]; va[5] = hi4[db][1]; va[6] = hi4[db][2]; va[7] = hi4[db][3];
                        if (db == 0) o0 = __builtin_amdgcn_mfma_f32_32x32x16_bf16(va, pb, o0, 0, 0, 0);
                        else if (db == 1) o1 = __builtin_amdgcn_mfma_f32_32x32x16_bf16(va, pb, o1, 0, 0, 0);
                        else if (db == 2) o2 = __builtin_amdgcn_mfma_f32_32x32x16_bf16(va, pb, o2, 0, 0, 0);
                        else o3 = __builtin_amdgcn_mfma_f32_32x32x16_bf16(va, pb, o3, 0, 0, 0);
                    }
                }
            }
            if (glast) {
                if (br < 2) {
                    const int ql = (tq - s0) * 2 + hi;
                    pg8::u32x4* sp = (pg8::u32x4*)(stb + (size_t)ql * 64);
                    float2 ml; ml.x = m_run; ml.y = l_run; *(float2*)(mlb + ql * 2) = ml;
#define DIL_ST(O, DB) { pg8::u32x4 w0, w1; \
                        w0.x = pg8::cvt_pk_bf16(O[0], O[1]); w0.y = pg8::cvt_pk_bf16(O[2], O[3]); w0.z = pg8::cvt_pk_bf16(O[4], O[5]); w0.w = pg8::cvt_pk_bf16(O[6], O[7]); \
                        w1.x = pg8::cvt_pk_bf16(O[8], O[9]); w1.y = pg8::cvt_pk_bf16(O[10], O[11]); w1.z = pg8::cvt_pk_bf16(O[12], O[13]); w1.w = pg8::cvt_pk_bf16(O[14], O[15]); \
                        sp[2 * (DB)] = w0; sp[2 * (DB) + 1] = w1; }
                    DIL_ST(o0, 0) DIL_ST(o1, 1) DIL_ST(o2, 2) DIL_ST(o3, 3)
#undef DIL_ST
                } else {
                    const float l_tot = l_run + __shfl_xor(l_run, 32), inv = 1.f / l_tot;
                    bf16_t* orow = ob + ((size_t)(bh >> 4) * T + tq) * HW + h * HD + 4 * hi;
#pragma unroll
                    for (int g = 0; g < 4; ++g) {
                        pg8::u32x2 w;
                        w.x = pg8::cvt_pk_bf16(o0[4 * g] * inv, o0[4 * g + 1] * inv); w.y = pg8::cvt_pk_bf16(o0[4 * g + 2] * inv, o0[4 * g + 3] * inv); *(pg8::u32x2*)(orow + 0 + 8 * g) = w;
                        w.x = pg8::cvt_pk_bf16(o1[4 * g] * inv, o1[4 * g + 1] * inv); w.y = pg8::cvt_pk_bf16(o1[4 * g + 2] * inv, o1[4 * g + 3] * inv); *(pg8::u32x2*)(orow + 32 + 8 * g) = w;
                        w.x = pg8::cvt_pk_bf16(o2[4 * g] * inv, o2[4 * g + 1] * inv); w.y = pg8::cvt_pk_bf16(o2[4 * g + 2] * inv, o2[4 * g + 3] * inv); *(pg8::u32x2*)(orow + 64 + 8 * g) = w;
                        w.x = pg8::cvt_pk_bf16(o3[4 * g] * inv, o3[4 * g + 1] * inv); w.y = pg8::cvt_pk_bf16(o3[4 * g + 2] * inv, o3[4 * g + 3] * inv); *(pg8::u32x2*)(orow + 96 + 8 * g) = w;
                    }
                }
            }
            if (!more) break;
            asm volatile("s_waitcnt lgkmcnt(0)" ::: "memory");
            {
                const int ndl = 1 << (2 * nbr), nJ0 = -128 + 32 * nkt;
#pragma unroll
                for (int i = 0; i < 8; ++i) { int tv = ntb + (nJ0 + 4 * i + drow) * ndl; tv = tv < 0 ? 0 : tv;
                    __builtin_amdgcn_global_load_lds((const unsigned*)(vbase + (size_t)tv * HD + vc), (LAS unsigned*)(vbuf + i * 1024), 16, 0, 0); }
            }
            fresh = glast; br = nbr; gi = ngi; kt = nkt; tb = ntb;
        }
        j = __builtin_amdgcn_readfirstlane(*tkw);
    }
    __syncthreads();
}

__device__ __forceinline__ void route_token(const float (&lgt)[16], const float* router_b, int& i1, int& i2, float& g1, float& g2) {
    float mx = lgt[0];
#pragma unroll
    for (int e = 1; e < 16; ++e) mx = fmaxf(mx, lgt[e]);
    float pr[16], sm = 0.f;
#pragma unroll
    for (int e = 0; e < 16; ++e) { pr[e] = __expf(lgt[e] - mx); sm += pr[e]; }
    const float inv = 1.f / sm;
    float sl[16];
#pragma unroll
    for (int e = 0; e < 16; ++e) { pr[e] *= inv; sl[e] = pr[e] + router_b[e]; }
    int bg = 0; float bgs = -__builtin_inff();
#pragma unroll
    for (int g = 0; g < NG; ++g) {
        const float a0 = sl[g * 4], a1 = sl[g * 4 + 1], a2 = sl[g * 4 + 2], a3 = sl[g * 4 + 3];
        const float h1 = fmaxf(a0, a1), l1 = fminf(a0, a1), h2 = fmaxf(a2, a3), l2 = fminf(a2, a3);
        const float gs = fmaxf(h1, h2) + fmaxf(fminf(h1, h2), fmaxf(l1, l2));
        const bool better = gs > bgs; bgs = better ? gs : bgs; bg = better ? g : bg;
    }
    float sg[4], pg[4];
#pragma unroll
    for (int i = 0; i < 4; ++i) { sg[i] = (bg == 0) ? sl[i] : (bg == 1) ? sl[4 + i] : (bg == 2) ? sl[8 + i] : sl[12 + i]; pg[i] = (bg == 0) ? pr[i] : (bg == 1) ? pr[4 + i] : (bg == 2) ? pr[8 + i] : pr[12 + i]; }
    int l1i = 0; float v1 = sg[0], p1 = pg[0];
#pragma unroll
    for (int i = 1; i < 4; ++i) { const bool b = sg[i] > v1; v1 = b ? sg[i] : v1; p1 = b ? pg[i] : p1; l1i = b ? i : l1i; }
    int l2i = 0; float v2 = -__builtin_inff(), p2 = 0.f;
#pragma unroll
    for (int i = 0; i < 4; ++i) { const bool b = (i != l1i) && (sg[i] > v2); v2 = b ? sg[i] : v2; p2 = b ? pg[i] : p2; l2i = b ? i : l2i; }
    i1 = bg * 4 + l1i; i2 = bg * 4 + l2i;
    const float gsum = p1 + p2; g1 = p1 / gsum; g2 = p2 / gsum;
}
__device__ __forceinline__ float reduce16(float (&v)[16], int lane) {
#pragma unroll
    for (int i = 0; i < 8; ++i) { const bool up = lane & 1; const float keep = up ? v[i + 8] : v[i], send = up ? v[i] : v[i + 8]; v[i] = keep + __shfl_xor(send, 1); }
#pragma unroll
    for (int i = 0; i < 4; ++i) { const bool up = lane & 2; const float keep = up ? v[i + 4] : v[i], send = up ? v[i] : v[i + 4]; v[i] = keep + __shfl_xor(send, 2); }
#pragma unroll
    for (int i = 0; i < 2; ++i) { const bool up = lane & 4; const float keep = up ? v[i + 2] : v[i], send = up ? v[i] : v[i + 2]; v[i] = keep + __shfl_xor(send, 4); }
    { const bool up = lane & 8; const float keep = up ? v[1] : v[0], send = up ? v[0] : v[1]; v[0] = keep + __shfl_xor(send, 8); }
    float r = v[0]; r += __shfl_xor(r, 16); r += __shfl_xor(r, 32); return r;
}
__device__ __forceinline__ void route_pair(float x, int lane, const float* router_b, int m, int* expid, float* gatew, int* lh) {
    const int E = lane & 15;
    float mx = x; mx = fmaxf(mx, __shfl_xor(mx, 1)); mx = fmaxf(mx, __shfl_xor(mx, 2)); mx = fmaxf(mx, __shfl_xor(mx, 4)); mx = fmaxf(mx, __shfl_xor(mx, 8));
    const float p = __expf(x - mx);
    float sm = p; sm += __shfl_xor(sm, 1); sm += __shfl_xor(sm, 2); sm += __shfl_xor(sm, 4); sm += __shfl_xor(sm, 8);
    const float pr = p * (1.f / sm), sl = pr + router_b[E];
    const float a = __shfl_xor(sl, 1), h1 = fmaxf(sl, a), l1 = fminf(sl, a), bh = __shfl_xor(h1, 2), bl = __shfl_xor(l1, 2);
    float gs = fmaxf(h1, bh) + fmaxf(fminf(h1, bh), fmaxf(l1, bl));
    int g = E >> 2;
    { const float og = __shfl_xor(gs, 4); const int oi = __shfl_xor(g, 4); const bool t = (og > gs) || (og == gs && oi < g); gs = t ? og : gs; g = t ? oi : g; }
    { const float og = __shfl_xor(gs, 8); const int oi = __shfl_xor(g, 8); const bool t = (og > gs) || (og == gs && oi < g); gs = t ? og : gs; g = t ? oi : g; }
    const bool inb = (E >> 2) == g;
    int rank = 0;
#pragma unroll
    for (int d = 1; d < 4; ++d) { const float os = __shfl_xor(sl, d); const int oe = E ^ d; rank += ((os > sl) || (os == sl && oe < E)) ? 1 : 0; }
    const unsigned long long b1 = __ballot(inb && rank == 0), b2 = __ballot(inb && rank == 1);
    const int pri = __float_as_int(pr);
#pragma unroll
    for (int q = 0; q < 2; ++q) {
        const int i1 = __builtin_ctz(((unsigned)(b1 >> (16 * q)) & 0xffffu) | 0x10000u), i2 = __builtin_ctz(((unsigned)(b2 >> (16 * q)) & 0xffffu) | 0x10000u);
        const float p1 = __int_as_float(__builtin_amdgcn_readlane(pri, 16 * q + (i1 & 15))), p2 = __int_as_float(__builtin_amdgcn_readlane(pri, 16 * q + (i2 & 15)));
        const float gsum = p1 + p2;
        if (lane == 0) { expid[(m + q) * 2] = i1 & 15; expid[(m + q) * 2 + 1] = i2 & 15; gatew[(m + q) * 2] = p1 / gsum; gatew[(m + q) * 2 + 1] = p2 / gsum; atomicAdd(&lh[i1 & 15], 1); atomicAdd(&lh[i2 & 15], 1); }
    }
}
__device__ __forceinline__ void ph_ln1_router(const float* g1, const float* b1, const float* router_w, const float* router_b, unsigned char* ws) {
    int tid_ = threadIdx.x; asm volatile("" : "+v"(tid_));
    const int tid = tid_, lane = tid & 63, wave = __builtin_amdgcn_readfirstlane(tid >> 6);
    LAS unsigned char* lds = (LAS unsigned char*)lds_raw;
    LAS float* stat = (LAS float*)(lds + 131072);
    LAS pg8::f32x4* dpart = (LAS pg8::f32x4*)(lds + 131072 + 1024);
    int* lh = (int*)((unsigned char*)lds_raw + LDS_MISC + 256);
    LAS float* gbl = (LAS float*)(lds + 147456);
    __syncthreads();
    { const float4 gv = *(const float4*)(g1 + 4 * tid), bv = *(const float4*)(b1 + 4 * tid);
      *(LAS pg8::f32x4*)(gbl + 4 * tid) = (pg8::f32x4){gv.x, gv.y, gv.z, gv.w}; *(LAS pg8::f32x4*)(gbl + 2048 + 4 * tid) = (pg8::f32x4){bv.x, bv.y, bv.z, bv.w}; }
    {
        float4 w0[8], w1[8];
#pragma unroll
        for (int q = 0; q < 8; ++q) { const int p = tid + NTHR * q, k = (p >> 2) * 2, e4 = (p & 3) * 4; w0[q] = *(const float4*)(router_w + k * 16 + e4); w1[q] = *(const float4*)(router_w + (k + 1) * 16 + e4); }
#pragma unroll
        for (int q = 0; q < 8; ++q) { const int p = tid + NTHR * q, k = (p >> 2) * 2, e4 = (p & 3) * 4, ks = k >> 5, gg = (k >> 3) & 3, j = k & 7;
            const float a[4] = {w0[q].x, w0[q].y, w0[q].z, w0[q].w}, b[4] = {w1[q].x, w1[q].y, w1[q].z, w1[q].w};
#pragma unroll
            for (int i = 0; i < 4; ++i) { const bf16_t ah = f2bf(a[i]), bh = f2bf(b[i]), al = f2bf(a[i] - bf2f(ah)), bl = f2bf(b[i] - bf2f(bh));
                const int off = ks * 1024 + (e4 + i + 16 * gg) * 16 + j * 2;
                *(LAS unsigned*)(lds + off) = (unsigned)ah | ((unsigned)bh << 16); *(LAS unsigned*)(lds + 65536 + off) = (unsigned)al | ((unsigned)bl << 16); } }
    }
    for (int c = blockIdx.x; c < NCHUNK; c += gridDim.x) {
        __syncthreads();
        if (tid < 16) lh[tid] = 0;
        const int tb = wave >> 1, kh = wave & 1, t = lane & 15, g = lane >> 4, tl = 16 * tb + t, m = c * CHUNK + tl;
        const bf16_t* xrow = XPRE + (size_t)m * D + kh * 1024 + 8 * g;
#define LN1_UNPACK(R, X) { X[0] = __uint_as_float(R.x << 16); X[1] = __uint_as_float(R.x & 0xffff0000u); X[2] = __uint_as_float(R.y << 16); X[3] = __uint_as_float(R.y & 0xffff0000u); \
                           X[4] = __uint_as_float(R.z << 16); X[5] = __uint_as_float(R.z & 0xffff0000u); X[6] = __uint_as_float(R.w << 16); X[7] = __uint_as_float(R.w & 0xffff0000u); }
        float s = 0.f, q2 = 0.f;
#pragma unroll 1
        for (int k16 = 0; k16 < 32; k16 += 16) {
            pg8::u32x4 raw[16];
#pragma unroll
            for (int i = 0; i < 16; ++i) raw[i] = *(const pg8::u32x4*)(xrow + 32 * (k16 + i));
#pragma unroll
            for (int i = 0; i < 16; ++i) { float x[8]; LN1_UNPACK(raw[i], x); s += ((x[0] + x[1]) + (x[2] + x[3])) + ((x[4] + x[5]) + (x[6] + x[7]));
#pragma unroll
                for (int j = 0; j < 8; ++j) q2 = fmaf(x[j], x[j], q2); }
        }
        s += __shfl_xor(s, 16); s += __shfl_xor(s, 32); q2 += __shfl_xor(q2, 16); q2 += __shfl_xor(q2, 32);
        if (g == 0) { stat[kh * 64 + tl] = s; stat[128 + kh * 64 + tl] = q2; }
        __syncthreads();
        const float mu = (stat[tl] + stat[64 + tl]) * (1.f / D);
        const float rstd = rsqrtf(fmaxf((stat[128 + tl] + stat[192 + tl]) * (1.f / D) - mu * mu, 0.f) + EPS);
        pg8::f32x4 acc = {0.f, 0.f, 0.f, 0.f};
        {
            const LAS float* gp = gbl + kh * 1024 + 8 * g; const LAS float* bp = gbl + 2048 + kh * 1024 + 8 * g;
            bf16_t* orow = XB + (size_t)m * D + kh * 1024 + 8 * g;
            const LAS unsigned char* wf = lds + (kh * 32) * 1024 + lane * 16;
            pg8::u32x4 rn[4];
#pragma unroll
            for (int i = 0; i < 4; ++i) rn[i] = *(const pg8::u32x4*)(xrow + 32 * i);
#pragma unroll 1
            for (int k4 = 0; k4 < 32; k4 += 4) {
                pg8::u32x4 raw[4];
#pragma unroll
                for (int i = 0; i < 4; ++i) raw[i] = rn[i];
                if (k4 + 4 < 32) {
#pragma unroll
                    for (int i = 0; i < 4; ++i) rn[i] = *(const pg8::u32x4*)(xrow + 32 * (k4 + 4 + i));
                }
#pragma unroll
                for (int i = 0; i < 4; ++i) {
                    const int ks = k4 + i;
                    float x[8]; LN1_UNPACK(raw[i], x);
                    const pg8::f32x4 ga = *(const LAS pg8::f32x4*)(gp + 32 * ks), gb = *(const LAS pg8::f32x4*)(gp + 32 * ks + 4), ba = *(const LAS pg8::f32x4*)(bp + 32 * ks), bb = *(const LAS pg8::f32x4*)(bp + 32 * ks + 4);
                    const float gm[8] = {ga[0], ga[1], ga[2], ga[3], gb[0], gb[1], gb[2], gb[3]}, bt[8] = {ba[0], ba[1], ba[2], ba[3], bb[0], bb[1], bb[2], bb[3]};
                    float y[8];
#pragma unroll
                    for (int j = 0; j < 8; ++j) y[j] = (x[j] - mu) * rstd * gm[j] + bt[j];
                    pg8::u32x4 hi, lo;
                    hi.x = pg8::cvt_pk_bf16(y[0], y[1]); hi.y = pg8::cvt_pk_bf16(y[2], y[3]); hi.z = pg8::cvt_pk_bf16(y[4], y[5]); hi.w = pg8::cvt_pk_bf16(y[6], y[7]);
                    *(pg8::u32x4*)(orow + 32 * ks) = hi;
                    lo.x = pg8::cvt_pk_bf16(y[0] - __uint_as_float(hi.x << 16), y[1] - __uint_as_float(hi.x & 0xffff0000u));
                    lo.y = pg8::cvt_pk_bf16(y[2] - __uint_as_float(hi.y << 16), y[3] - __uint_as_float(hi.y & 0xffff0000u));
                    lo.z = pg8::cvt_pk_bf16(y[4] - __uint_as_float(hi.z << 16), y[5] - __uint_as_float(hi.z & 0xffff0000u));
                    lo.w = pg8::cvt_pk_bf16(y[6] - __uint_as_float(hi.w << 16), y[7] - __uint_as_float(hi.w & 0xffff0000u));
                    const s16x8 wh = *(const LAS s16x8*)(wf + ks * 1024), wl = *(const LAS s16x8*)(wf + 65536 + ks * 1024);
                    const s16x8 yh = __builtin_bit_cast(s16x8, hi), yl = __builtin_bit_cast(s16x8, lo);
                    acc = __builtin_amdgcn_mfma_f32_16x16x32_bf16(wh, yh, acc, 0, 0, 0);
                    acc = __builtin_amdgcn_mfma_f32_16x16x32_bf16(wh, yl, acc, 0, 0, 0);
                    acc = __builtin_amdgcn_mfma_f32_16x16x32_bf16(wl, yh, acc, 0, 0, 0);
                }
            }
        }
#undef LN1_UNPACK
        if (kh == 1) dpart[tb * 64 + lane] = acc;
        __syncthreads();
        if (kh == 0) {
            const pg8::f32x4 o = dpart[tb * 64 + lane];
            const float x0 = acc[0] + o[0], x1 = acc[1] + o[1], x2 = acc[2] + o[2], x3 = acc[3] + o[3];
            float mx = fmaxf(fmaxf(x0, x1), fmaxf(x2, x3)); mx = fmaxf(mx, __shfl_xor(mx, 16)); mx = fmaxf(mx, __shfl_xor(mx, 32));
            const float p0 = __expf(x0 - mx), p1 = __expf(x1 - mx), p2 = __expf(x2 - mx), p3 = __expf(x3 - mx);
            float sm = (p0 + p1) + (p2 + p3); sm += __shfl_xor(sm, 16); sm += __shfl_xor(sm, 32);
            const float inv = 1.f / sm;
            const float pr[4] = {p0 * inv, p1 * inv, p2 * inv, p3 * inv};
            const float4 rb4 = *(const float4*)(router_b + 4 * g);
            const float sl[4] = {pr[0] + rb4.x, pr[1] + rb4.y, pr[2] + rb4.z, pr[3] + rb4.w};
            const float h1 = fmaxf(sl[0], sl[1]), l1 = fminf(sl[0], sl[1]), h2 = fmaxf(sl[2], sl[3]), l2 = fminf(sl[2], sl[3]);
            float bgs = fmaxf(h1, h2) + fmaxf(fminf(h1, h2), fmaxf(l1, l2));
            int bg = g;
            { const float og = __shfl_xor(bgs, 16); const int oi = __shfl_xor(bg, 16); const bool tk = (og > bgs) || (og == bgs && oi < bg); bgs = tk ? og : bgs; bg = tk ? oi : bg; }
            { const float og = __shfl_xor(bgs, 32); const int oi = __shfl_xor(bg, 32); const bool tk = (og > bgs) || (og == bgs && oi < bg); bgs = tk ? og : bgs; bg = tk ? oi : bg; }
            if (bg == g) {
                int l1i = 0; float v1 = sl[0], q1 = pr[0];
#pragma unroll
                for (int i = 1; i < 4; ++i) { const bool b = sl[i] > v1; v1 = b ? sl[i] : v1; q1 = b ? pr[i] : q1; l1i = b ? i : l1i; }
                int l2i = 0; float v2 = -__builtin_inff(), q2b = 0.f;
#pragma unroll
                for (int i = 0; i < 4; ++i) { const bool b = (i != l1i) && (sl[i] > v2); v2 = b ? sl[i] : v2; q2b = b ? pr[i] : q2b; l2i = b ? i : l2i; }
                const int i1 = 4 * g + l1i, i2 = 4 * g + l2i; const float gsum = q1 + q2b;
                EXPID[m * 2] = i1; EXPID[m * 2 + 1] = i2; GATEW[m * 2] = q1 / gsum; GATEW[m * 2 + 1] = q2b / gsum;
                atomicAdd(&lh[i1], 1); atomicAdd(&lh[i2], 1);
            }
        }
        __syncthreads();
        { int t3 = tid; asm volatile("" : "+v"(t3)); if (t3 < 16) HIST[c * 16 + t3] = lh[t3]; }
    }
}

__device__ __noinline__ void ph_route_pos(unsigned char* ws) {
    const int tid = threadIdx.x, lane = tid & 63, wave = tid >> 6, gw = blockIdx.x * NWAVES + wave, NGW = gridDim.x * NWAVES; float* ldsf = (float*)lds_raw;
    (void)lane; (void)wave; (void)gw; (void)NGW; (void)ldsf;
            int* hl = (int*)ldsf;
            int* tot = hl + NCHUNK * 16;
            int* seg = tot + 16;
            __syncthreads();
            for (int i = tid; i < NCHUNK * 16; i += NTHR) hl[i] = HIST[i];
            __syncthreads();
            if (tid < 16) { int run = 0; for (int c = 0; c < NCHUNK; ++c) { const int h = hl[c * 16 + tid]; hl[c * 16 + tid] = run; run += h; } tot[tid] = run; }
            __syncthreads();
            if (tid == 0) { int s = 0; for (int e = 0; e < 16; ++e) { seg[e] = s; s += (tot[e] + 255) & ~255; } seg[16] = s; }
            __syncthreads();
            for (int c = blockIdx.x; c < NCHUNK; c += gridDim.x) {
                if (wave == 0) {
                    const int m = c * CHUNK + lane;
                    const int e0 = EXPID[m * 2], e1 = EXPID[m * 2 + 1];
                    const unsigned long long lt = (1ull << lane) - 1ull;
                    int r0 = 0, r1 = 0;
                    for (int e = 0; e < 16; ++e) {
                        const unsigned long long m0 = __ballot(e0 == e), m1 = __ballot(e1 == e);
                        const int below = __popcll(m0 & lt) + __popcll(m1 & lt);
                        if (e0 == e) r0 = below;
                        if (e1 == e) r1 = below;
                    }
                    const int p0 = seg[e0] + hl[c * 16 + e0] + r0, p1 = seg[e1] + hl[c * 16 + e1] + r1;
                    POS[m * 2] = p0; POS[m * 2 + 1] = p1;
                    ROWTOK[p0] = m; ROWTOK[p1] = m; ROWGATE[p0] = GATEW[m * 2]; ROWGATE[p1] = GATEW[m * 2 + 1];
                }
            }
            if (blockIdx.x == 0) {
                for (int e = 0; e < 16; ++e) { for (int r = seg[e] + tot[e] + tid; r < seg[e + 1]; r += NTHR) { ROWTOK[r] = 0; ROWGATE[r] = 0.f; } }
                if (tid < 160) { int e = 0; const int row = tid * 256; for (int q = 0; q < 16; ++q) if (row >= seg[q]) e = q; TILEE[tid] = e; }
                __syncthreads();
                if (tid == 0) TILEE[159] = seg[16] / 256;
            }
}

__device__ __forceinline__ void ph_ln2(const float* g2, const float* b2, float* out, int last, unsigned char* ws) {
    int tid_ = threadIdx.x; asm volatile("" : "+v"(tid_));
    const int tid = tid_, lane = tid & 63, wave = tid >> 6, gw = blockIdx.x * NWAVES + wave, NGW = gridDim.x * NWAVES; float* ldsf = (float*)lds_raw;
    (void)lane; (void)wave; (void)gw; (void)NGW; (void)ldsf;
            int m = gw;
            if (m >= M) return;
            uint2 xr[8], y0[8], y1[8];
            int np0 = 0, np1 = 0;
            { const int p0 = POS[m * 2], p1 = POS[m * 2 + 1];
#pragma unroll
              for (int jj = 0; jj < 8; ++jj) { xr[jj] = *(const uint2*)(XB + (size_t)m * D + 4 * lane + 256 * jj); y0[jj] = *(const uint2*)(YS + (size_t)p0 * D + 4 * lane + 256 * jj); y1[jj] = *(const uint2*)(YS + (size_t)p1 * D + 4 * lane + 256 * jj); }
              if (m + NGW < M) { np0 = POS[(m + NGW) * 2]; np1 = POS[(m + NGW) * 2 + 1]; } }
#pragma unroll 1
            for (; m < M; m += NGW) {
                float4 v[8];
#pragma unroll
                for (int jj = 0; jj < 8; ++jj) {
                    v[jj].x = ALPHA * __uint_as_float(xr[jj].x << 16) + __uint_as_float(y0[jj].x << 16) + __uint_as_float(y1[jj].x << 16);
                    v[jj].y = ALPHA * __uint_as_float(xr[jj].x & 0xffff0000u) + __uint_as_float(y0[jj].x & 0xffff0000u) + __uint_as_float(y1[jj].x & 0xffff0000u);
                    v[jj].z = ALPHA * __uint_as_float(xr[jj].y << 16) + __uint_as_float(y0[jj].y << 16) + __uint_as_float(y1[jj].y << 16);
                    v[jj].w = ALPHA * __uint_as_float(xr[jj].y & 0xffff0000u) + __uint_as_float(y0[jj].y & 0xffff0000u) + __uint_as_float(y1[jj].y & 0xffff0000u);
                }
                const int mn = m + NGW;
                if (mn < M) {
                    const int p0 = np0, p1 = np1;
#pragma unroll
                    for (int jj = 0; jj < 8; ++jj) { xr[jj] = *(const uint2*)(XB + (size_t)mn * D + 4 * lane + 256 * jj); y0[jj] = *(const uint2*)(YS + (size_t)p0 * D + 4 * lane + 256 * jj); y1[jj] = *(const uint2*)(YS + (size_t)p1 * D + 4 * lane + 256 * jj); }
                    if (mn + NGW < M) { np0 = POS[(mn + NGW) * 2]; np1 = POS[(mn + NGW) * 2 + 1]; }
                }
                ln_row(v, g2, b2, lane);
                if (last) {
#pragma unroll
                    for (int jj = 0; jj < 8; ++jj) *(float4*)(out + (size_t)m * D + 4 * lane + 256 * jj) = v[jj];
                } else store_row_bf16(XB + (size_t)m * D, v, lane);
            }
}

__global__ void __launch_bounds__(NTHR, 2) mega_fwd(Args a) {
    const int tid0 = threadIdx.x;
    unsigned* ctl = (unsigned*)(a.ws + WS_CTL);
    volatile LAS unsigned* misc = (volatile LAS unsigned*)((LAS unsigned char*)lds_raw + LDS_MISC);
    if (tid0 < 64) misc[tid0] = 0u;
    __syncthreads();
#if MK_SINGLE
    XcdBarrier bar = xcd_barrier_post(ctl + 4096, misc + 8);
#define GRID_BAR() xcd_barrier(bar)
#else
    (void)ctl;
#define GRID_BAR() do { } while (0)
#endif
    const int lo = a.ph_lo, hi = a.ph_hi;
    for (int pc = lo; pc < hi; ++pc) {
        bool ran = true, is_gemm = false; int do_prep = 0;
        pg8::GemmDesc d{};
        const __attribute__((address_space(4))) Args* ap = (const __attribute__((address_space(4))) Args*)__builtin_amdgcn_kernarg_segment_ptr();
        asm volatile("" : "+s"(ap));
#define a (*ap)
        unsigned char* ws = ap->ws;
        if (pc == 0) ph_pre(a.x, a.rel_bias, ws);
        else {
            const int q = pc - 1, L = q / 14, s = q % 14, j = L >> 1; const bool dsa = (L & 1) == 0;
            switch (s) {
            case 0:
                if (L == 0) do_prep = 1; else if (dsa) ph_prep_dsa_fold(a.a_w_uq + (size_t)j * QL * HW, a.a_w_uk + (size_t)j * H * HD * KVL, W_Q(L), W_UV(L)); else ran = false;
                break;
            case 1: is_gemm = true;
                if (dsa) { d.A = XB; d.Bt = W_IN(L); d.K = D; d.lda2 = D * 2; d.ldb2 = D * 2; d.btile = (size_t)256 * D * 2; d.nM = M / 256; d.nN = 4; d.epi = pg8::EPI_F32; d.out = PRAW; d.ldc = 1024; }
                else     { d.A = XB; d.Bt = W_QKV(L); d.K = D; d.lda2 = D * 2; d.ldb2 = D * 2; d.btile = (size_t)256 * D * 2; d.nM = M / 256; d.nN = 3 * HW / 256; d.epi = pg8::EPI_QKVH; d.out = QKV; d.ldc = 3 * HW; }
                break;
            case 2: if (dsa) ph_dsa_norms(a.a_q_norm + (size_t)j * QL, a.a_kv_norm + (size_t)j * KVL, ws); else ran = false; break;
            case 3: if (dsa) { is_gemm = true; d.A = CQ; d.Bt = W_Q(L); d.K = QL; d.lda2 = QL * 2; d.ldb2 = QL * 2; d.btile = (size_t)256 * QL * 2; d.nM = M / 256; d.nN = QALD / 256; d.epi = pg8::EPI_BF16; d.out = QALL; d.ldc = QALD; }
                    else ran = false; break;
            case 4: if (dsa) ph_dsa_index(ws); else ran = false; break;
            case 5: if (dsa) ph_dsa_topk_attn(ws); else ran = false; break;
            case 6: if (dsa) ran = false; else ph_dil_attn(ws, (unsigned*)(ws + WS_CTL) + 12288 + 128 * L); break;
            case 7: if (dsa) { is_gemm = true; d.A = OLAT; d.Bt = W_UV(L); d.K = 512; d.lda2 = 4096 * 2; d.acol2 = 512 * 2; d.ldb2 = 512 * 2; d.btile = (size_t)256 * 512 * 2; d.nM = M / 256; d.nN = HW / 256;
                               d.epi = pg8::EPI_BF16; d.out = OB; d.ldc = HW; }
                    else ran = false; break;
            case 8: is_gemm = true; d.A = OB; d.Bt = dsa ? W_O(L) : W_O_D(L); d.K = HW; d.lda2 = HW * 2; d.ldb2 = HW * 2; d.btile = (size_t)256 * HW * 2; d.nM = M / 256; d.nN = D / 256;
                    d.epi = pg8::EPI_RESID; d.out = XPRE; d.aux = XB; d.ldc = D; d.alpha = ALPHA; break;
            case 9: ph_ln1_router(a.ln1_g + (size_t)L * D, a.ln1_b + (size_t)L * D, a.router_w, a.router_b, ws); break;
            case 10: ph_route_pos(ws); break;
            case 11: is_gemm = true; d.A = XB; d.Bt = W_GU(L); d.K = D; d.lda2 = D * 2; d.ldb2 = D * 2; d.btile = (size_t)256 * D * 2; d.bexp = (size_t)1024 * D * 2; d.nM = __builtin_amdgcn_readfirstlane(ld_mut(TILEE + 159)); d.nN = 4;
                     d.rowtok = ROWTOK; d.tilee = TILEE; d.epi = pg8::EPI_SWIGLU; d.out = HID; d.aux = ROWGATE; d.ldc = DE; if (L + 1 < DEPTH) do_prep = 2; break;
            case 12: is_gemm = true; d.A = HID; d.Bt = W_DN(L); d.K = DE; d.lda2 = DE * 2; d.ldb2 = DE * 2; d.btile = (size_t)256 * DE * 2; d.bexp = (size_t)D * DE * 2; d.nM = __builtin_amdgcn_readfirstlane(ld_mut(TILEE + 159)); d.nN = D / 256;
                     d.tilee = TILEE; d.epi = pg8::EPI_BF16; d.out = YS; d.ldc = D; if (L + 1 < DEPTH) do_prep = 2; break;
            default: ph_ln2(a.ln2_g + (size_t)L * D, a.ln2_b + (size_t)L * D, a.out, L == DEPTH - 1 ? 1 : 0, ws); break;
            }
        }
#undef a
        if (is_gemm) pg8::gemm_run((PG8_LAS unsigned char*)lds_raw, d);
#define a (*ap)
        if (do_prep) {
            const int Lp = (do_prep == 1) ? 0 : (pc - 1) / 14 + 1, jp = Lp >> 1; const bool pdsa = (Lp & 1) == 0;
            unsigned* cnt = (do_prep == 1) ? nullptr : (unsigned*)(ap->ws + WS_CTL) + 8192 + 64 * Lp;
            int pend = -1, seg = 0;
            const float* wg = a.moe_w_gate + (size_t)Lp * NE * D * DE; const float* wu = a.moe_w_up + (size_t)Lp * NE * D * DE; const float* wd = a.moe_w_down + (size_t)Lp * NE * DE * D;
            pend = cvt_matrix(wg, (size_t)D * DE, NE, D, DE, DE, DE, W_GU(Lp), 1.f, 1024, 7, 256, 127, 0, D, 0, cnt, seg, pend); seg += 1024;
            pend = cvt_matrix(wu, (size_t)D * DE, NE, D, DE, DE, DE, W_GU(Lp), 1.f, 1024, 7, 256, 127, 128, D, 0, cnt, seg, pend); seg += 1024;
            pend = cvt_matrix(wd, (size_t)DE * D, NE, DE, D, D, D, W_DN(Lp), 1.f, D, 31, 0, 0x7fffffff, 0, DE, 0, cnt, seg, pend); seg += 1024;
            if (pdsa) {
                const float* w_in = a.a_w_in + (size_t)jp * D * AIN; const float* w_uqi = a.a_w_uq_idx + (size_t)jp * QL * IH * IDM; const float* w_uv = a.a_w_uv + (size_t)jp * H * KVL * HD; const float* w_o = a.a_w_o + (size_t)jp * HW * D;
                pend = cvt_matrix(w_in, 0, 1, D, 1024, AIN, AIN, W_IN(Lp), 1.f, 0, 31, 0, 0x7fffffff, 0, D, 0, cnt, seg, pend); seg += 128;
                pend = cvt_matrix(w_uqi, 0, 1, QL, IH * IDM, IH * IDM, IH * IDM, W_Q(Lp), 0.125f, 0, 31, 0, 0x7fffffff, 4096, QL, 0, cnt, seg, pend); seg += 32;
                pend = cvt_matrix(w_o, 0, 1, HW, D, D, D, W_O(Lp), 1.f, 0, 31, 0, 0x7fffffff, 0, HW, 0, cnt, seg, pend); seg += 256;
                pend = cvt_matrix(w_uv, (size_t)KVL * HD, H, KVL, HD, HD, HD, W_UV(Lp), 1.f, HD, 31, 0, 0x7fffffff, 0, 512, 256, cnt, seg, pend); seg += 32;
                if (do_prep == 1) ph_prep_dsa_fold(a.a_w_uq + (size_t)jp * QL * HW, a.a_w_uk + (size_t)jp * H * HD * KVL, W_Q(Lp), W_UV(Lp));
            } else {
                const float* w_in = a.b_w_in + (size_t)jp * D * 3 * HW; const float* w_o = a.b_w_o + (size_t)jp * HW * D;
                pend = cvt_matrix(w_in, 0, 1, D, HW, HW, 3 * HW, W_QKV(Lp), 0.12751743082459868f  , 0, 31, 0, 0x7fffffff, 0, D, 0, cnt, seg, pend); seg += 256;
                pend = cvt_matrix(w_in + HW, 0, 1, D, 2 * HW, 2 * HW, 3 * HW, W_QKV(Lp), 1.f, 0, 31, 0, 0x7fffffff, HW, D, 0, cnt, seg, pend); seg += 512;
                pend = cvt_matrix(w_o, 0, 1, HW, D, D, D, W_O_D(Lp), 1.f, 0, 31, 0, 0x7fffffff, 0, HW, 0, cnt, seg, pend); seg += 256;
            }
        }
#undef a
        bool skipbar = false;
        if (MK_SINGLE) { if (pc == 0) skipbar = true; else { const int q2 = pc - 1, L2_ = q2 / 14, s2 = q2 % 14; if (s2 == 13 && (L2_ & 1) == 1 && L2_ + 1 < DEPTH) skipbar = true; } }
        if (ran && !skipbar && pc + 1 < hi) GRID_BAR();
    }
}
constexpr int N_PHASES = 1 + DEPTH * 14;
}

extern "C" void kernel_launch(void* const* d_in, const int* in_sizes, int n_in, void* d_out, int out_size, void* d_ws, size_t ws_size, hipStream_t stream) {
    static int grid = 0;
    if (grid == 0) {
        if (n_in != 21 || in_sizes[0] != M * D || out_size != M * D || ws_size < WS_END) {
            fprintf(stderr, "kernel_launch: unexpected shapes: n_in %d in0 %d out %d ws %zu (need %zu)\n", n_in, n_in > 0 ? in_sizes[0] : -1, out_size, ws_size, (size_t)WS_END);
            grid = -1; return; }
        int dev = 0, cus = 0, per_cu = 0;
        if (hipGetDevice(&dev) != hipSuccess || hipDeviceGetAttribute(&cus, hipDeviceAttributeMultiprocessorCount, dev) != hipSuccess) { grid = -1; return; }
        if (hipFuncSetAttribute((const void*)mega_fwd, hipFuncAttributeMaxDynamicSharedMemorySize, LDS_BYTES) != hipSuccess) { fprintf(stderr, "kernel_launch: hipFuncSetAttribute failed\n"); grid = -1; return; }
        if (hipOccupancyMaxActiveBlocksPerMultiprocessor(&per_cu, (const void*)mega_fwd, NTHR, LDS_BYTES) != hipSuccess || per_cu < 1)
            fprintf(stderr, "kernel_launch: occupancy query reports %d workgroups per CU\n", per_cu);
        (void)hipGetLastError();
        grid = cus;
    }
    if (grid < 0) return;
    if (hipMemsetAsync((char*)d_ws + WS_CTL, 0, CTL_BYTES, stream) != hipSuccess) return;
    Args a{};
    a.x = (const float*)d_in[0]; a.rel_bias = (const float*)d_in[1]; a.router_w = (const float*)d_in[2]; a.router_b = (const float*)d_in[3];
    a.a_w_in = (const float*)d_in[4]; a.a_q_norm = (const float*)d_in[5]; a.a_kv_norm = (const float*)d_in[6]; a.a_w_uq = (const float*)d_in[7]; a.a_w_uq_idx = (const float*)d_in[8];
    a.a_w_uk = (const float*)d_in[9]; a.a_w_uv = (const float*)d_in[10]; a.a_w_o = (const float*)d_in[11]; a.b_w_in = (const float*)d_in[12]; a.b_w_o = (const float*)d_in[13];
    a.ln1_g = (const float*)d_in[14]; a.ln1_b = (const float*)d_in[15]; a.ln2_g = (const float*)d_in[16]; a.ln2_b = (const float*)d_in[17];
    a.moe_w_gate = (const float*)d_in[18]; a.moe_w_up = (const float*)d_in[19]; a.moe_w_down = (const float*)d_in[20];
    a.out = (float*)d_out; a.ws = (unsigned char*)d_ws;
#if MK_SINGLE
    a.ph_lo = 0; a.ph_hi = N_PHASES;
    hipLaunchKernelGGL(mega_fwd, dim3(grid), dim3(NTHR), LDS_BYTES, stream, a);
#else
    for (int p = 0; p < N_PHASES; ++p) { a.ph_lo = p; a.ph_hi = p + 1; hipLaunchKernelGGL(mega_fwd, dim3(grid), dim3(NTHR), LDS_BYTES, stream, a); }
#endif
}
```

```cpp
#include <hip/hip_runtime.h>
#include <cstdio>
#include <cstdint>

#ifndef MK_SINGLE
#define MK_SINGLE 1
#endif

namespace {
constexpr int D = 2048, NB_ = 4, T = 4096, DEPTH = 4, M = NB_ * T;
constexpr int H = 16, HD = 128, HW = H * HD, QL = 512, KVL = 256, IH = 16, IDM = 64, TOPK = 256;
constexpr int AIN = QL + KVL + IDM + IH;
constexpr int NBUCK = 32, NE = 16, NG = 4, EPG = 4, DE = 512;
constexpr float ALPHA = 1.6817928305074292f;
constexpr float EPS = 1e-5f;
constexpr int NTHR = 512, NWAVES = 8;
constexpr int RMAX = 36864;
constexpr int NCHUNK = 256, CHUNK = M / NCHUNK;

constexpr size_t MiB = 1u << 20;
constexpr size_t WS_CTL = 0, CTL_BYTES = 1 * MiB;
constexpr size_t WS_BIAS = 1 * MiB;
constexpr size_t WS_EXPID = 2 * MiB;
constexpr size_t WS_GATEW = WS_EXPID + (size_t)M * 2 * 4;
constexpr size_t WS_POS = WS_GATEW + (size_t)M * 2 * 4;
constexpr size_t WS_ROWTOK = WS_POS + (size_t)M * 2 * 4;
constexpr size_t WS_ROWGATE = WS_ROWTOK + (size_t)RMAX * 4;
constexpr size_t WS_HIST = WS_ROWGATE + (size_t)RMAX * 4;
constexpr size_t WS_TILEE = WS_HIST + (size_t)NCHUNK * 16 * 4;
constexpr size_t WS_NSEL = WS_TILEE + 1024;
constexpr size_t WS_XB = 8 * MiB;
constexpr size_t WS_XPRE = 72 * MiB;
constexpr size_t WS_WL = 200 * MiB;
constexpr size_t WL_STRIDE = 128 * MiB;
constexpr size_t WS_AR = 456 * MiB;
constexpr int QALD = 5120;
constexpr size_t WS_END = 1034 * MiB;
constexpr size_t AR_PRAW = WS_AR;
constexpr size_t AR_CQ = WS_AR + 64 * MiB;
constexpr size_t AR_CKV = WS_AR + 80 * MiB;
constexpr size_t AR_KIDX = WS_AR + 88 * MiB;
constexpr size_t AR_WIDX = WS_AR + 90 * MiB;
constexpr size_t AR_SEL = WS_AR + 92 * MiB;
constexpr size_t AR_QALL = WS_AR + 108 * MiB;
constexpr size_t AR_SC = WS_AR + 268 * MiB;
constexpr size_t AR_OLAT = 906 * MiB;
constexpr size_t AR_OB = WS_AR + 0 * MiB;
constexpr size_t AR_QKV = WS_AR + 100 * MiB;
constexpr size_t AR_DST = WS_AR + 300 * MiB;
constexpr size_t AR_DML = WS_AR + 336 * MiB;
constexpr size_t AR_HID = WS_AR + 0 * MiB;
constexpr size_t AR_YS = WS_AR + 40 * MiB;
constexpr size_t SC_PER_B = (size_t)1024 * 128 * 129 / 2;
static_assert(AR_SC + 4 * SC_PER_B * 4 <= WS_END, "arena");
static_assert(AR_YS + (size_t)RMAX * D * 2 <= WS_END, "arena");
constexpr size_t WL_GU = WS_WL;
constexpr size_t WL_DN = WS_WL + 64 * MiB;
constexpr size_t WL_MIX = WS_WL + 96 * MiB;
constexpr size_t WL_WIN = WL_MIX;
constexpr size_t WL_WQ = WL_MIX + 4 * MiB;
constexpr size_t WL_WUV = WL_MIX + 10 * MiB;
constexpr size_t WL_WO = WL_MIX + 12 * MiB;
constexpr size_t WL_WQKV = WL_MIX + 0 * MiB;
constexpr size_t WL_WO_D = WL_MIX + 24 * MiB;
static_assert(WL_WO_D + 8 * MiB <= WS_WL + WL_STRIDE && WS_WL + 2 * WL_STRIDE <= WS_AR, "weight scratch");

constexpr int LDS_BYTES = 163840;
constexpr int MK_TID_TABLE = 143360 + 3328;
constexpr int LDS_MISC = 143360;

typedef unsigned short bf16_t;
#define LAS __attribute__((address_space(3)))
extern __shared__ __attribute__((aligned(16))) unsigned char lds_raw[];
__device__ __forceinline__ int mk_tid() {
    const unsigned hw = (unsigned)__builtin_amdgcn_s_getreg((5 << 11) | 4) & 63u;
    const int w = __builtin_amdgcn_readfirstlane(((volatile LAS int*)((LAS unsigned char*)lds_raw + MK_TID_TABLE))[hw]);
    int l; asm volatile("v_mbcnt_lo_u32_b32 %0, -1, 0\n\tv_mbcnt_hi_u32_b32 %0, -1, %0" : "=v"(l));
    return (w << 6) | l;
}

__device__ __forceinline__ float bf2f(bf16_t v) { return __uint_as_float(((unsigned)v) << 16); }
__device__ __forceinline__ bf16_t f2bf(float f) { unsigned u = __float_as_uint(f); u += 0x7fffu + ((u >> 16) & 1u); return (bf16_t)(u >> 16); }
__device__ __forceinline__ float wave_sum(float v) {
#pragma unroll
    for (int o = 1; o < 64; o <<= 1) v += __shfl_xor(v, o);
    return v;
}
__device__ __forceinline__ int wave_sum_i(int v) {
#pragma unroll
    for (int o = 1; o < 64; o <<= 1) v += __shfl_xor(v, o);
    return v;
}
__device__ __forceinline__ float wave_max(float v) {
#pragma unroll
    for (int o = 1; o < 64; o <<= 1) v = fmaxf(v, __shfl_xor(v, o));
    return v;
}
__device__ __forceinline__ float wave_min(float v) {
#pragma unroll
    for (int o = 1; o < 64; o <<= 1) v = fminf(v, __shfl_xor(v, o));
    return v;
}
__device__ __forceinline__ int wave_min_i(int v) {
#pragma unroll
    for (int o = 1; o < 64; o <<= 1) { int t = __shfl_xor(v, o); v = t < v ? t : v; }
    return v;
}

__device__ __forceinline__ int wave_scan_dpp(int x) {
    x += __builtin_amdgcn_update_dpp(0, x, 0x111, 0xf, 0xf, false);
    x += __builtin_amdgcn_update_dpp(0, x, 0x112, 0xf, 0xf, false);
    x += __builtin_amdgcn_update_dpp(0, x, 0x114, 0xf, 0xf, false);
    x += __builtin_amdgcn_update_dpp(0, x, 0x118, 0xf, 0xf, false);
    x += __builtin_amdgcn_update_dpp(0, x, 0x142, 0xa, 0xf, false);
    x += __builtin_amdgcn_update_dpp(0, x, 0x143, 0xc, 0xf, false);
    return x;
}
__device__ __forceinline__ float wave_max_dpp(float v) {
    const int ninf = __float_as_int(-__builtin_inff());
#define WMX(ctrl, rm) v = fmaxf(v, __int_as_float(__builtin_amdgcn_update_dpp(ninf, __float_as_int(v), ctrl, rm, 0xf, false)))
    WMX(0x111, 0xf); WMX(0x112, 0xf); WMX(0x114, 0xf); WMX(0x118, 0xf); WMX(0x142, 0xa); WMX(0x143, 0xc);
#undef WMX
    return __int_as_float(__builtin_amdgcn_readlane(__float_as_int(v), 63));
}
__device__ __forceinline__ float wave_min_dpp(float v) {
    const int pinf = __float_as_int(__builtin_inff());
#define WMN(ctrl, rm) v = fminf(v, __int_as_float(__builtin_amdgcn_update_dpp(pinf, __float_as_int(v), ctrl, rm, 0xf, false)))
    WMN(0x111, 0xf); WMN(0x112, 0xf); WMN(0x114, 0xf); WMN(0x118, 0xf); WMN(0x142, 0xa); WMN(0x143, 0xc);
#undef WMN
    return __int_as_float(__builtin_amdgcn_readlane(__float_as_int(v), 63));
}
__device__ __forceinline__ int wave_sum_dpp(int x) {
    x += __builtin_amdgcn_update_dpp(0, x, 0x111, 0xf, 0xf, false);
    x += __builtin_amdgcn_update_dpp(0, x, 0x112, 0xf, 0xf, false);
    x += __builtin_amdgcn_update_dpp(0, x, 0x114, 0xf, 0xf, false);
    x += __builtin_amdgcn_update_dpp(0, x, 0x118, 0xf, 0xf, false);
    x += __builtin_amdgcn_update_dpp(0, x, 0x142, 0xa, 0xf, false);
    x += __builtin_amdgcn_update_dpp(0, x, 0x143, 0xc, 0xf, false);
    return __builtin_amdgcn_readlane(x, 63);
}
__device__ __forceinline__ int ld_mut(const int* p) { return __hip_atomic_load(p, __ATOMIC_RELAXED, __HIP_MEMORY_SCOPE_AGENT); }

#define XB_TMO      128
#define XB_XCNT(j)  (256  + 64 * (j))
#define XB_XSUB(j)  (1280 + 64 * (j))
#define XB_XGEN(j)  (2304 + 64 * (j))
#define XB_TOP      3328
#define XB_TOPGEN   3392
#define XCD_BAR_WORDS 3456
#define XB_SPIN_CAP (1u << 18)

__device__ __forceinline__ unsigned xb_ld(unsigned* p)              { return __hip_atomic_load(p, __ATOMIC_RELAXED, __HIP_MEMORY_SCOPE_AGENT); }
__device__ __forceinline__ unsigned xb_add(unsigned* p, unsigned v) { return __hip_atomic_fetch_add(p, v, __ATOMIC_RELAXED, __HIP_MEMORY_SCOPE_AGENT); }
__device__ __forceinline__ unsigned xb_xcc_id() { return (unsigned)__builtin_amdgcn_s_getreg((3 << 11) | 20) & 0xFu; }
#define XB_SPIN(cond, bar) do { unsigned _sp = 0; while (cond) { __builtin_amdgcn_s_sleep(1); \
    if ((++_sp & 255u) == 0u) { if (xb_ld(&(bar)[XB_TMO])) break; if (_sp > XB_SPIN_CAP) { atomicAdd(&(bar)[XB_TMO], 1u); break; } } } } while (0)

struct XcdBarrier {
    unsigned* bar; unsigned x;
    volatile LAS unsigned* st;
};
__device__ __forceinline__ XcdBarrier xcd_barrier_post(unsigned* bar, volatile LAS unsigned* st) {
    XcdBarrier b; b.bar = bar; b.x = xb_xcc_id(); b.st = st;
    if (mk_tid() == 0) (void)xb_add(&bar[XB_XCNT(b.x)], 1u);
    return b;
}
__device__ __forceinline__ void xcd_barrier_complete(unsigned* bar, unsigned x, unsigned& nloc, unsigned& nx) {
    const unsigned G = gridDim.x * gridDim.y * gridDim.z;
    unsigned sum, cnt, mine, sp = 0u;
    for (;;) {
        sum = 0u; cnt = 0u; mine = 0u;
#pragma unroll
        for (unsigned j = 0; j < 16; ++j) { const unsigned c = xb_ld(&bar[XB_XCNT(j)]); sum += c; cnt += (c > 0u) ? 1u : 0u; mine = (j == x) ? c : mine; }
        if (sum == G) break;
        __builtin_amdgcn_s_sleep(1);
        if ((++sp & 255u) == 0u) { if (xb_ld(&bar[XB_TMO])) break; if (sp > XB_SPIN_CAP) { atomicAdd(&bar[XB_TMO], 1u); break; } }
    }
    nloc = mine > 0u ? mine : 1u; nx = cnt > 0u ? cnt : 1u;
}
__device__ __forceinline__ void xcd_barrier(const XcdBarrier& b) {
    asm volatile("s_waitcnt vmcnt(0)" ::: "memory");
    __syncthreads();
    if (mk_tid() == 0) {
        unsigned* bar = b.bar;
        __builtin_amdgcn_s_waitcnt(0);
        unsigned nloc = b.st[0], nx = b.st[1];
        if (nloc == 0u) { xcd_barrier_complete(bar, b.x, nloc, nx); b.st[0] = nloc; b.st[1] = nx; }
        const unsigned old = xb_add(&bar[XB_XSUB(b.x)], 1u);
        const unsigned gen = old / nloc;
        if (old + 1u == (gen + 1u) * nloc) {
            __builtin_amdgcn_fence(__ATOMIC_RELEASE, "agent");
            asm volatile("s_waitcnt vmcnt(0)" ::: "memory");
            const unsigned og = xb_add(&bar[XB_TOP], 1u);
            const unsigned tg = og / nx;
            if (og + 1u == (tg + 1u) * nx) xb_add(&bar[XB_TOPGEN], 1u);
            else XB_SPIN(xb_ld(&bar[XB_TOPGEN]) == tg, bar);
            __builtin_amdgcn_fence(__ATOMIC_ACQUIRE, "agent");
            xb_add(&bar[XB_XGEN(b.x)], 1u);
            asm volatile("s_waitcnt vmcnt(0)" ::: "memory");
        } else {
            XB_SPIN(xb_ld(&bar[XB_XGEN(b.x)]) == gen, bar);
            __builtin_amdgcn_fence(__ATOMIC_ACQUIRE, "agent");
            asm volatile("s_waitcnt vmcnt(0)" ::: "memory");
        }
    }
    __syncthreads();
}

template <class AF, class BF, class EF>
__device__ __forceinline__ void gemm_naive(float* lds, int nbatch, int Mr, int N, int K, AF af, BF bf, EF ef) {
    float* As = lds; float* Bs = lds + 16 * 132;
    const int tid = mk_tid(), ty = tid >> 4, tx = tid & 15;
    const int tm = Mr / 128, tn = (N + 63) / 64, per = tm * tn, total = per * nbatch;
    for (int u = blockIdx.x; u < total; u += gridDim.x) {
        const int bi = u / per, rr = u % per, m0 = (rr / tn) * 128, n0 = (rr % tn) * 64;
        float acc[4][4];
#pragma unroll
        for (int i = 0; i < 4; ++i)
#pragma unroll
            for (int j = 0; j < 4; ++j) acc[i][j] = 0.f;
        for (int k0 = 0; k0 < K; k0 += 16) {
            __syncthreads();
#pragma unroll
            for (int i = 0; i < 4; ++i) { const int e = tid + 512 * i, row = e >> 4, kk = e & 15; As[kk * 132 + row] = af(bi, m0 + row, k0 + kk); }
#pragma unroll
            for (int i = 0; i < 2; ++i) { const int e = tid + 512 * i, kk = e >> 6, n = e & 63; Bs[kk * 68 + n] = (n0 + n < N) ? bf(bi, k0 + kk, n0 + n) : 0.f; }
            __syncthreads();
#pragma unroll
            for (int kk = 0; kk < 16; ++kk) {
                const float4 a = *(const float4*)(As + kk * 132 + ty * 4);
                const float4 b = *(const float4*)(Bs + kk * 68 + tx * 4);
                const float av[4] = {a.x, a.y, a.z, a.w}, bv[4] = {b.x, b.y, b.z, b.w};
#pragma unroll
                for (int i = 0; i < 4; ++i)
#pragma unroll
                    for (int j = 0; j < 4; ++j) acc[i][j] = fmaf(av[i], bv[j], acc[i][j]);
            }
        }
#pragma unroll
        for (int i = 0; i < 4; ++i)
#pragma unroll
            for (int j = 0; j < 4; ++j) { const int n = n0 + tx * 4 + j; if (n < N) ef(bi, m0 + ty * 4 + i, n, acc[i][j]); }
    }
    __syncthreads();
}

__device__ __forceinline__ int t5_bucket(int n) {
    if (n < 16) return n;
    const float nf = (float)n;
    int large = 16 + (int)(logf(nf / 16.0f) / 4.852030263919617f * 16.0f);
    return large < 31 ? large : 31;
}
__device__ __forceinline__ size_t sc_off(int b, int t) { const int qb = t >> 5; return (size_t)b * SC_PER_B + (size_t)512 * qb * (qb + 1) + (size_t)(t & 31) * (32 * (qb + 1)); }

struct Args {
    const float* x; const float* rel_bias; const float* router_w; const float* router_b;
    const float* a_w_in; const float* a_q_norm; const float* a_kv_norm; const float* a_w_uq; const float* a_w_uq_idx;
    const float* a_w_uk; const float* a_w_uv; const float* a_w_o; const float* b_w_in; const float* b_w_o;
    const float* ln1_g; const float* ln1_b; const float* ln2_g; const float* ln2_b;
    const float* moe_w_gate; const float* moe_w_up; const float* moe_w_down;
    float* out; unsigned char* ws; int ph_lo, ph_hi;
};

template <class V4>
__device__ __forceinline__ void ln_row(V4 (&v)[8], const float* g, const float* bta, int lane) {
    float s = 0.f;
#pragma unroll
    for (int j = 0; j < 8; ++j) s += (v[j].x + v[j].y) + (v[j].z + v[j].w);
    const float mu = wave_sum(s) * (1.f / D);
    float q = 0.f;
#pragma unroll
    for (int j = 0; j < 8; ++j) { v[j].x -= mu; v[j].y -= mu; v[j].z -= mu; v[j].w -= mu; q += (v[j].x * v[j].x + v[j].y * v[j].y) + (v[j].z * v[j].z + v[j].w * v[j].w); }
    const float rstd = rsqrtf(wave_sum(q) * (1.f / D) + EPS);
#pragma unroll
    for (int j = 0; j < 8; ++j) {
        const float4 gg = *(const float4*)(g + 4 * lane + 256 * j), bb = *(const float4*)(bta + 4 * lane + 256 * j);
        v[j].x = v[j].x * rstd * gg.x + bb.x; v[j].y = v[j].y * rstd * gg.y + bb.y; v[j].z = v[j].z * rstd * gg.z + bb.z; v[j].w = v[j].w * rstd * gg.w + bb.w;
        if (j == 3) asm volatile("" ::: "memory");
    }
}
template <class V4>
__device__ __forceinline__ void store_row_bf16(bf16_t* dst, const V4 (&v)[8], int lane) {
#pragma unroll
    for (int j = 0; j < 8; ++j) {
        uint2 o; o.x = (unsigned)f2bf(v[j].x) | ((unsigned)f2bf(v[j].y) << 16); o.y = (unsigned)f2bf(v[j].z) | ((unsigned)f2bf(v[j].w) << 16);
        *(uint2*)(dst + 4 * lane + 256 * j) = o;
    }
}

#define BIAS_T ((float*)(ws + WS_BIAS))
#define EXPID ((int*)(ws + WS_EXPID))
#define GATEW ((float*)(ws + WS_GATEW))
#define POS ((int*)(ws + WS_POS))
#define ROWTOK ((int*)(ws + WS_ROWTOK))
#define ROWGATE ((float*)(ws + WS_ROWGATE))
#define HIST ((int*)(ws + WS_HIST))
#define TILEE ((int*)(ws + WS_TILEE))
#define NSEL ((int*)(ws + WS_NSEL))
#define XB ((bf16_t*)(ws + WS_XB))
#define XPRE ((bf16_t*)(ws + WS_XPRE))
#define PRAW ((float*)(ws + AR_PRAW))
#define CQ ((bf16_t*)(ws + AR_CQ))
#define CKV ((bf16_t*)(ws + AR_CKV))
#define KIDX ((bf16_t*)(ws + AR_KIDX))
#define WIDX ((float*)(ws + AR_WIDX))
#define SEL ((int*)(ws + AR_SEL))
#define QALL ((bf16_t*)(ws + AR_QALL))
#define SC ((float*)(ws + AR_SC))
#define OLAT ((bf16_t*)(ws + AR_OLAT))
#define OB ((bf16_t*)(ws + AR_OB))
#define QKV ((bf16_t*)(ws + AR_QKV))
#define HID ((bf16_t*)(ws + AR_HID))
#define YS ((bf16_t*)(ws + AR_YS))
#define W_GU(L) ((bf16_t*)(ws + WL_GU + (size_t)((L) & 1) * WL_STRIDE))
#define W_DN(L) ((bf16_t*)(ws + WL_DN + (size_t)((L) & 1) * WL_STRIDE))
#define W_IN(L) ((bf16_t*)(ws + WL_WIN + (size_t)((L) & 1) * WL_STRIDE))
#define W_Q(L) ((bf16_t*)(ws + WL_WQ + (size_t)((L) & 1) * WL_STRIDE))
#define W_UV(L) ((bf16_t*)(ws + WL_WUV + (size_t)((L) & 1) * WL_STRIDE))
#define W_O(L) ((bf16_t*)(ws + WL_WO + (size_t)((L) & 1) * WL_STRIDE))
#define W_QKV(L) ((bf16_t*)(ws + WL_WQKV + (size_t)((L) & 1) * WL_STRIDE))
#define W_O_D(L) ((bf16_t*)(ws + WL_WO_D + (size_t)((L) & 1) * WL_STRIDE))

namespace pg8 {
#define PG8_LAS __attribute__((address_space(3)))
typedef short bf16x8 __attribute__((ext_vector_type(8)));
typedef float f32x4 __attribute__((ext_vector_type(4)));
typedef unsigned u32x4 __attribute__((ext_vector_type(4)));
typedef unsigned u32x2 __attribute__((ext_vector_type(2)));
constexpr int BM = 256, BK = 64, HALF = 128, HTB = HALF * BK * 2  , STAGE_BYTES = 8 * HTB, NXCD = 8, WGM = 8;

__device__ __forceinline__ int lds_byte(int r, int c) { const int st = (r >> 4) * 2 + (c >> 5), rr = r & 15, cc = c & 31, ob = rr * 64 + cc * 2; return st * 1024 + (ob ^ (((ob >> 9) & 1) << 5)); }
__device__ __forceinline__ void stage_rc(int b, int& R, int& C) { const int st = b / 1024, sb = b % 1024, swz = sb ^ (((sb >> 9) & 1) << 5); R = (st >> 1) * 16 + swz / 64; C = (st & 1) * 32 + (swz % 64) / 2; }
__device__ __forceinline__ int perm32(int rho) { const int n = rho >> 4, i = rho & 15; return 8 * (i >> 2) + 4 * n + (i & 3); }

struct Unit { int pm, pn; };
enum { EPI_F32 = 0, EPI_RESID = 1, EPI_BF16 = 2, EPI_SWIGLU = 3, EPI_QKVH = 4 };
struct GemmDesc {
    const bf16_t* A; const bf16_t* Bt; const int* rowtok; const int* tilee; void* out; const void* aux;
    size_t btile, bexp; unsigned lda2, acol2, ldb2; int K, nM, nN, epi, ldc; float alpha; int pad;
};
struct Order {
    int nM, nN, nwg, G, c;
    __device__ __forceinline__ bool next(int i, Unit& u) const {
        const long L = (long)i * G + c; if (L >= nwg) return false;
        int wgid = (int)L; { const int q = nwg / NXCD, r = nwg % NXCD, xcd = wgid % NXCD, off = wgid / NXCD; wgid = (xcd < r ? xcd * (q + 1) : r * (q + 1) + (xcd - r) * q) + off; }
        const int nig = WGM * nN, gid = wgid / nig, fm = gid * WGM, gsz = (nM - fm) < WGM ? (nM - fm) : WGM;
        u.pm = fm + ((wgid % nig) % gsz); u.pn = (wgid % nig) / gsz; return true;
    }
};
__device__ __forceinline__ unsigned arow_off(const GemmDesc& d, const Unit& u, int r) { const int row = u.pm * BM + r; return (unsigned)(d.rowtok ? d.rowtok[row] : row) * d.lda2 + (unsigned)u.pn * d.acol2; }
__device__ __forceinline__ const char* bptr(const GemmDesc& d, const Unit& u) { return (const char*)d.Bt + (d.tilee ? (size_t)__builtin_amdgcn_readfirstlane(ld_mut(d.tilee + u.pm)) * d.bexp : (size_t)0) + (size_t)u.pn * d.btile; }

__device__ __forceinline__ unsigned cvt_pk_bf16(float lo, float hi) { unsigned r; asm volatile("v_cvt_pk_bf16_f32 %0, %1, %2" : "=v"(r) : "v"(lo), "v"(hi)); return r; }

__device__ __forceinline__ void epi_f32(const f32x4 (&acc)[2][2][4][2], const Unit& u, int wr, int wc, int fr, int fq, float* C, int ldc) {
    const int row0 = u.pm * BM + wr * 64 + fr, col0 = u.pn * BM + wc * 32 + 4 * fq;
#pragma unroll
    for (int ai = 0; ai < 2; ++ai)
#pragma unroll
        for (int m = 0; m < 4; ++m) { float* rowp = C + (size_t)(row0 + ai * HALF + m * 16) * ldc + col0;
#pragma unroll
            for (int bj = 0; bj < 2; ++bj)
#pragma unroll
                for (int n = 0; n < 2; ++n) *(f32x4*)(rowp + bj * HALF + n * 16) = acc[ai][bj][m][n]; }
}
__device__ __forceinline__ void epi_resid(const f32x4 (&acc)[2][2][4][2], const Unit& u, int wr, int wc, int fr, int fq, bf16_t* C, const bf16_t* X, int ldc, float alpha) {
    const int row0 = u.pm * BM + wr * 64 + fr, col0 = u.pn * BM + wc * 32 + 8 * fq;
    u32x4 xv[2][4][2];
#pragma unroll
    for (int ai = 0; ai < 2; ++ai)
#pragma unroll
        for (int m = 0; m < 4; ++m)
#pragma unroll
            for (int bj = 0; bj < 2; ++bj) xv[ai][m][bj] = *(const u32x4*)(X + (size_t)(row0 + ai * HALF + m * 16) * ldc + col0 + bj * HALF);
#pragma unroll
    for (int ai = 0; ai < 2; ++ai)
#pragma unroll
        for (int m = 0; m < 4; ++m) { const size_t ro = (size_t)(row0 + ai * HALF + m * 16) * ldc + col0;
#pragma unroll
            for (int bj = 0; bj < 2; ++bj) { const u32x4 xr = xv[ai][m][bj]; const f32x4 a0 = acc[ai][bj][m][0], a1 = acc[ai][bj][m][1];
                u32x4 w;
                w.x = cvt_pk_bf16(alpha * __uint_as_float(xr.x << 16) + a0[0], alpha * __uint_as_float(xr.x & 0xffff0000u) + a0[1]);
                w.y = cvt_pk_bf16(alpha * __uint_as_float(xr.y << 16) + a0[2], alpha * __uint_as_float(xr.y & 0xffff0000u) + a0[3]);
                w.z = cvt_pk_bf16(alpha * __uint_as_float(xr.z << 16) + a1[0], alpha * __uint_as_float(xr.z & 0xffff0000u) + a1[1]);
                w.w = cvt_pk_bf16(alpha * __uint_as_float(xr.w << 16) + a1[2], alpha * __uint_as_float(xr.w & 0xffff0000u) + a1[3]);
                *(u32x4*)(C + ro + bj * HALF) = w; } }
}
__device__ __forceinline__ void epi_bf16(const f32x4 (&acc)[2][2][4][2], const Unit& u, int wr, int wc, int fr, int fq, bf16_t* O, int ldc) {
    const int row0 = u.pm * BM + wr * 64 + fr, col0 = u.pn * BM + wc * 32 + 8 * fq;
#pragma unroll
    for (int ai = 0; ai < 2; ++ai)
#pragma unroll
        for (int m = 0; m < 4; ++m) { bf16_t* rowp = O + (size_t)(row0 + ai * HALF + m * 16) * ldc + col0;
#pragma unroll
            for (int bj = 0; bj < 2; ++bj) { const f32x4 v0 = acc[ai][bj][m][0], v1 = acc[ai][bj][m][1];
                u32x4 w; w.x = cvt_pk_bf16(v0[0], v0[1]); w.y = cvt_pk_bf16(v0[2], v0[3]); w.z = cvt_pk_bf16(v1[0], v1[1]); w.w = cvt_pk_bf16(v1[2], v1[3]);
                *(u32x4*)(rowp + bj * HALF) = w; } }
}
__device__ __forceinline__ void epi_swiglu(const f32x4 (&acc)[2][2][4][2], const Unit& u, int wr, int wc, int fr, int fq, bf16_t* Hd, const float* rowgate) {
    const int row0 = u.pm * BM + wr * 64 + fr, col0 = u.pn * HALF + wc * 32 + 8 * fq;
    float gwv[2][4];
#pragma unroll
    for (int ai = 0; ai < 2; ++ai)
#pragma unroll
        for (int m = 0; m < 4; ++m) gwv[ai][m] = rowgate[row0 + ai * HALF + m * 16];
#pragma unroll
    for (int ai = 0; ai < 2; ++ai)
#pragma unroll
        for (int m = 0; m < 4; ++m) { const int row = row0 + ai * HALF + m * 16; const float gw = gwv[ai][m];
            float h[8];
#pragma unroll
            for (int n = 0; n < 2; ++n)
#pragma unroll
                for (int e = 0; e < 4; ++e) { const float g = acc[ai][0][m][n][e], uu = acc[ai][1][m][n][e]; h[n * 4 + e] = g / (1.f + __expf(-g)) * uu * gw; }
            u32x4 w; w.x = cvt_pk_bf16(h[0], h[1]); w.y = cvt_pk_bf16(h[2], h[3]); w.z = cvt_pk_bf16(h[4], h[5]); w.w = cvt_pk_bf16(h[6], h[7]);
            *(u32x4*)(Hd + (size_t)row * 512 + col0) = w; }
}
__device__ __forceinline__ void epi_qkvh(const f32x4 (&acc)[2][2][4][2], const Unit& u, int wr, int wc, int fr, int fq, bf16_t* O) {
    const int row0 = u.pm * BM + wr * 64 + fr;
#pragma unroll
    for (int ai = 0; ai < 2; ++ai)
#pragma unroll
        for (int m = 0; m < 4; ++m) { const int row = row0 + ai * HALF + m * 16, b = row >> 12, t = row & 4095;
#pragma unroll
            for (int bj = 0; bj < 2; ++bj) { const int col = u.pn * BM + bj * HALF + wc * 32 + 8 * fq, which = col >> 11, head = (col >> 7) & 15, dim = col & 127;
                const f32x4 v0 = acc[ai][bj][m][0], v1 = acc[ai][bj][m][1];
                u32x4 w; w.x = cvt_pk_bf16(v0[0], v0[1]); w.y = cvt_pk_bf16(v0[2], v0[3]); w.z = cvt_pk_bf16(v1[0], v1[1]); w.w = cvt_pk_bf16(v1[2], v1[3]);
                *(u32x4*)(O + ((size_t)((which * 64 + b * 16 + head) * 4096 + t)) * 128 + dim) = w; } }
}
__device__ __forceinline__ void epi_any(const f32x4 (&acc)[2][2][4][2], const Unit& u, int wr, int wc, int fr, int fq, const GemmDesc& d) {
    if (d.epi == EPI_F32) epi_f32(acc, u, wr, wc, fr, fq, (float*)d.out, d.ldc);
    else if (d.epi == EPI_RESID) epi_resid(acc, u, wr, wc, fr, fq, (bf16_t*)d.out, (const bf16_t*)d.aux, d.ldc, d.alpha);
    else if (d.epi == EPI_BF16) epi_bf16(acc, u, wr, wc, fr, fq, (bf16_t*)d.out, d.ldc);
    else if (d.epi == EPI_QKVH) epi_qkvh(acc, u, wr, wc, fr, fq, (bf16_t*)d.out);
    else epi_swiglu(acc, u, wr, wc, fr, fq, (bf16_t*)d.out, (const float*)d.aux);
}

template <bool ALIGN_EPI = true, bool SP2 = true>
__device__ __forceinline__ void gemm_run(PG8_LAS unsigned char* lds, const GemmDesc& d) {
    Order S; S.nM = d.nM; S.nN = d.nN; S.nwg = d.nM * d.nN; S.G = (int)gridDim.x; S.c = (int)blockIdx.x;
    const unsigned ldb2 = d.ldb2; const bool perm = d.epi != EPI_F32;
    int tid_l = mk_tid(); asm volatile("" : "+v"(tid_l));
    const int tid = tid_l, wid = __builtin_amdgcn_readfirstlane(tid >> 6), lane = tid & 63, wr = wid >> 2, wc = wid & 3, fr = lane & 15, fq = lane >> 4;
    const int K = d.K, nt = K / BK;
    int RA[2]; unsigned CA2[2], voffB[2];
#pragma unroll
    for (int i = 0; i < 2; ++i) { int R, C; stage_rc(tid * 16 + i * 8192, R, C); const int Rb = perm ? ((R & ~31) + perm32(R & 31)) : R;
        RA[i] = R; CA2[i] = (unsigned)C * 2u; voffB[i] = (unsigned)Rb * ldb2 + (unsigned)C * 2u; }
    const size_t kstep = (size_t)(BK * 2);
    const size_t hstepB = (size_t)HALF * ldb2;
    const unsigned ldsw = (unsigned)wid * 1024u;
    const int aoff = lds_byte(wr * 64 + fr, fq * 8), boff = lds_byte(wc * 32 + fr, fq * 8);
#define PG8_SA(b, h) (((b) * 2 + (h)) * HTB)
#define PG8_SB(b, h) ((4 + (b) * 2 + (h)) * HTB)
#define PG8_STAGE(bufoff, gbase, voff) do { _Pragma("unroll") for (int _i = 0; _i < 2; ++_i) \
        __builtin_amdgcn_global_load_lds((const unsigned*)((const char*)(gbase) + (voff)[_i]), (PG8_LAS unsigned*)(lds + (bufoff) + ldsw + _i * 8192), 16, 0, 0); } while (0)
#define PG8_STAGEA(bufoff, gbase, v0, v1) do { \
        __builtin_amdgcn_global_load_lds((const unsigned*)((const char*)(gbase) + (v0)), (PG8_LAS unsigned*)(lds + (bufoff) + ldsw), 16, 0, 0); \
        __builtin_amdgcn_global_load_lds((const unsigned*)((const char*)(gbase) + (v1)), (PG8_LAS unsigned*)(lds + (bufoff) + ldsw + 8192), 16, 0, 0); } while (0)
#define PG8_LDA(dst, b, h) do { _Pragma("unroll") for (int m = 0; m < 4; ++m) _Pragma("unroll") for (int k = 0; k < 2; ++k) dst[m][k] = *(const PG8_LAS bf16x8*)(lds + PG8_SA(b, h) + aoff + m * 2048 + k * 1024); } while (0)
#define PG8_LDB(dst, b, h) do { _Pragma("unroll") for (int n = 0; n < 2; ++n) _Pragma("unroll") for (int k = 0; k < 2; ++k) dst[n][k] = *(const PG8_LAS bf16x8*)(lds + PG8_SB(b, h) + boff + n * 2048 + k * 1024); } while (0)
#define PG8_MMA(ai, bj, At, Bt) do { __builtin_amdgcn_s_setprio(1); _Pragma("unroll") for (int m = 0; m < 4; ++m) _Pragma("unroll") for (int n = 0; n < 2; ++n) _Pragma("unroll") for (int k = 0; k < 2; ++k) \
        acc[ai][bj][m][n] = __builtin_amdgcn_mfma_f32_16x16x32_bf16(Bt[n][k], At[m][k], acc[ai][bj][m][n], 0, 0, 0); __builtin_amdgcn_s_setprio(0); } while (0)
#define PG8_WAIT_V(n) asm volatile("s_waitcnt vmcnt(" #n ")" ::: "memory")
#define PG8_WAIT_L(n) asm volatile("s_waitcnt lgkmcnt(" #n ")" ::: "memory")
#define PG8_BAR __builtin_amdgcn_s_barrier()
#define PG8_SCHED __builtin_amdgcn_sched_barrier(0)
    Unit cur, nxt; int ui = 0;
    if (!S.next(0, cur)) return;
    f32x4 acc[2][2][4][2];
#pragma unroll
    for (int a = 0; a < 2; ++a)
#pragma unroll
        for (int b = 0; b < 2; ++b)
#pragma unroll
            for (int m = 0; m < 4; ++m)
#pragma unroll
                for (int n = 0; n < 2; ++n) acc[a][b][m][n] = (f32x4){0.f, 0.f, 0.f, 0.f};
    bf16x8 At[4][2], B0[2][2], B1[2][2];
    unsigned c00 = arow_off(d, cur, RA[0]) + CA2[0], c01 = arow_off(d, cur, RA[1]) + CA2[1], c10 = arow_off(d, cur, HALF + RA[0]) + CA2[0], c11 = arow_off(d, cur, HALF + RA[1]) + CA2[1];
    unsigned n00 = c00, n01 = c01, n10 = c10, n11 = c11;
    const char* const gA = (const char*)d.A;
    const char* cB = bptr(d, cur);
    if constexpr (SP2) {
        PG8_STAGE(PG8_SB(0, 0), cB, voffB); PG8_STAGE(PG8_SB(0, 1), cB + hstepB, voffB); PG8_STAGEA(PG8_SA(0, 0), gA, c00, c01); PG8_STAGEA(PG8_SA(0, 1), gA, c10, c11);
        if (wr == 1) PG8_BAR;
        PG8_WAIT_V(2); PG8_BAR;
        PG8_STAGE(PG8_SB(1, 0), cB + kstep, voffB); PG8_STAGEA(PG8_SA(1, 0), gA + kstep, c00, c01); PG8_STAGE(PG8_SB(1, 1), cB + hstepB + kstep, voffB);
        PG8_WAIT_V(6); PG8_BAR;
    } else {
        PG8_STAGE(PG8_SB(0, 0), cB, voffB); PG8_STAGEA(PG8_SA(0, 0), gA, c00, c01); PG8_STAGE(PG8_SB(0, 1), cB + hstepB, voffB); PG8_STAGEA(PG8_SA(0, 1), gA, c10, c11);
        if (wr == 1) PG8_BAR;
        PG8_WAIT_V(4); PG8_BAR;
        PG8_STAGE(PG8_SB(1, 0), cB + kstep, voffB); PG8_STAGEA(PG8_SA(1, 0), gA + kstep, c00, c01); PG8_STAGE(PG8_SB(1, 1), cB + hstepB + kstep, voffB);
        PG8_WAIT_V(6); PG8_BAR;
    }
    for (;;) {
        const bool has_next = S.next(ui + 1, nxt);
        const char* nB = cB;
        if (has_next) {
            int tl = tid; asm volatile("" : "+v"(tl)); int R0, C0, R1, C1; stage_rc(tl * 16, R0, C0); stage_rc(tl * 16 + 8192, R1, C1);
            n00 = arow_off(d, nxt, R0) + (unsigned)C0 * 2u; n01 = arow_off(d, nxt, R1) + (unsigned)C1 * 2u; n10 = arow_off(d, nxt, HALF + R0) + (unsigned)C0 * 2u; n11 = arow_off(d, nxt, HALF + R1) + (unsigned)C1 * 2u; nB = bptr(d, nxt); }
        else { n00 = c00; n01 = c01; n10 = c10; n11 = c11; }
        for (int t = 0; t < nt; t += 2) {
            const bool last = (t == nt - 2);
            const char* a1 = gA + (size_t)(t + 1) * kstep;
            const char* a2 = last ? gA : gA + (size_t)(t + 2) * kstep; const char* b2 = last ? nB : cB + (size_t)(t + 2) * kstep;
            const char* a3 = a2 + kstep; const char* b3 = b2 + kstep;
            const unsigned s00 = last ? n00 : c00, s01 = last ? n01 : c01, s10 = last ? n10 : c10, s11 = last ? n11 : c11;
            if constexpr (SP2) {
            PG8_LDB(B0, 0, 0); PG8_LDB(B1, 0, 1); PG8_SCHED; PG8_LDA(At, 0, 0); PG8_STAGEA(PG8_SA(1, 1), a1, c10, c11);
            PG8_WAIT_V(8); PG8_WAIT_L(0); PG8_BAR; PG8_MMA(0, 0, At, B0); PG8_MMA(0, 1, At, B1); PG8_BAR; PG8_SCHED;
            PG8_LDA(At, 0, 1); PG8_STAGE(PG8_SB(0, 0), b2, voffB); PG8_STAGE(PG8_SB(0, 1), b2 + hstepB, voffB); PG8_STAGEA(PG8_SA(0, 0), a2, s00, s01);
            PG8_WAIT_V(8); PG8_WAIT_L(0); PG8_BAR; PG8_MMA(1, 0, At, B0); PG8_MMA(1, 1, At, B1); PG8_BAR; PG8_SCHED;
            PG8_LDB(B0, 1, 0); PG8_LDB(B1, 1, 1); PG8_SCHED; PG8_LDA(At, 1, 0); PG8_STAGEA(PG8_SA(0, 1), a2, s10, s11);
            PG8_WAIT_V(8); PG8_WAIT_L(0); PG8_BAR; PG8_MMA(0, 0, At, B0); PG8_MMA(0, 1, At, B1); PG8_BAR; PG8_SCHED;
            PG8_LDA(At, 1, 1); PG8_STAGE(PG8_SB(1, 0), b3, voffB); PG8_STAGE(PG8_SB(1, 1), b3 + hstepB, voffB); PG8_STAGEA(PG8_SA(1, 0), a3, s00, s01);
            PG8_WAIT_V(8); PG8_WAIT_L(0); PG8_BAR; PG8_MMA(1, 0, At, B0); PG8_MMA(1, 1, At, B1); PG8_BAR; PG8_SCHED;
            } else {
            PG8_LDB(B0, 0, 0); PG8_SCHED; PG8_LDA(At, 0, 0); PG8_STAGEA(PG8_SA(1, 1), a1, c10, c11);
            PG8_WAIT_L(8); PG8_BAR; PG8_WAIT_L(0); PG8_MMA(0, 0, At, B0); PG8_BAR; PG8_SCHED;
            PG8_LDB(B1, 0, 1); PG8_STAGE(PG8_SB(0, 0), b2, voffB);
            PG8_BAR; PG8_WAIT_L(0); PG8_MMA(0, 1, At, B1); PG8_BAR;
            PG8_LDA(At, 0, 1); PG8_STAGEA(PG8_SA(0, 0), a2, s00, s01);
            PG8_BAR; PG8_WAIT_L(0); PG8_MMA(1, 0, At, B0); PG8_BAR; PG8_SCHED;
            PG8_STAGE(PG8_SB(0, 1), b2 + hstepB, voffB);
            PG8_WAIT_V(6); PG8_BAR; PG8_MMA(1, 1, At, B1); PG8_BAR;
            PG8_LDB(B0, 1, 0); PG8_SCHED; PG8_LDA(At, 1, 0); PG8_STAGEA(PG8_SA(0, 1), a2, s10, s11);
            PG8_WAIT_L(8); PG8_BAR; PG8_WAIT_L(0); PG8_MMA(0, 0, At, B0); PG8_BAR; PG8_SCHED;
            PG8_LDB(B1, 1, 1); PG8_STAGE(PG8_SB(1, 0), b3, voffB);
            PG8_BAR; PG8_WAIT_L(0); PG8_MMA(0, 1, At, B1); PG8_BAR;
            PG8_LDA(At, 1, 1); PG8_STAGEA(PG8_SA(1, 0), a3, s00, s01);
            PG8_BAR; PG8_WAIT_L(0); PG8_MMA(1, 0, At, B0); PG8_BAR; PG8_SCHED;
            PG8_STAGE(PG8_SB(1, 1), b3 + hstepB, voffB);
            PG8_WAIT_V(6); PG8_BAR; PG8_MMA(1, 1, At, B1); PG8_BAR;
            }
        }
        if constexpr (ALIGN_EPI) { if (wr == 0) PG8_BAR; }
        { int tl = tid; asm volatile("" : "+v"(tl)); const int wid_ = __builtin_amdgcn_readfirstlane(tl >> 6), ln_ = tl & 63;
          epi_any(acc, cur, wid_ >> 2, wid_ & 3, ln_ & 15, ln_ >> 4, d); }
        if (!has_next) break;
#pragma unroll
        for (int a = 0; a < 2; ++a)
#pragma unroll
            for (int b = 0; b < 2; ++b)
#pragma unroll
                for (int m = 0; m < 4; ++m)
#pragma unroll
                    for (int n = 0; n < 2; ++n) acc[a][b][m][n] = (f32x4){0.f, 0.f, 0.f, 0.f};
        cur = nxt; cB = nB; c00 = n00; c01 = n01; c10 = n10; c11 = n11; ++ui;
        if constexpr (ALIGN_EPI) { if (wr == 1) PG8_BAR; }
    }
    PG8_WAIT_V(0);
    if constexpr (!ALIGN_EPI) { if (wr == 0) PG8_BAR; }
    PG8_BAR;
#undef PG8_SA
#undef PG8_SB
#undef PG8_STAGE
#undef PG8_STAGEA
#undef PG8_LDA
#undef PG8_LDB
#undef PG8_MMA
#undef PG8_WAIT_V
#undef PG8_WAIT_L
#undef PG8_BAR
#undef PG8_SCHED
}
}

template <class RF>
__device__ __forceinline__ void cvt_block(const float* W, int ldw, int nvalid, int k0, int n0, bf16_t* WT, float scale, RF rowoff, float* scr, int lane) {
    const int c4 = 4 * (lane & 15), r4 = lane >> 4;
    const bool ok = (n0 + c4) < nvalid;
    float4 v[16];
#pragma unroll
    for (int i = 0; i < 16; ++i) { pg8::f32x4 t4 = {0.f, 0.f, 0.f, 0.f};
        if (ok) t4 = __builtin_nontemporal_load((const pg8::f32x4*)(W + (size_t)(k0 + 4 * i + r4) * ldw + n0 + c4));
        v[i] = make_float4(t4[0], t4[1], t4[2], t4[3]); }
#pragma unroll
    for (int i = 0; i < 16; ++i) { float* d = scr + (4 * i + r4) * 65 + c4; d[0] = v[i].x * scale; d[1] = v[i].y * scale; d[2] = v[i].z * scale; d[3] = v[i].w * scale; }
    asm volatile("s_waitcnt lgkmcnt(0)" ::: "memory");
    const int c = lane & 7;
#pragma unroll
    for (int jj = 0; jj < 8; ++jj) { const int n = (lane >> 3) + 8 * jj; const float* s = scr + (8 * c) * 65 + n;
        uint4 o; o.x = (unsigned)f2bf(s[0]) | ((unsigned)f2bf(s[65]) << 16); o.y = (unsigned)f2bf(s[2 * 65]) | ((unsigned)f2bf(s[3 * 65]) << 16);
        o.z = (unsigned)f2bf(s[4 * 65]) | ((unsigned)f2bf(s[5 * 65]) << 16); o.w = (unsigned)f2bf(s[6 * 65]) | ((unsigned)f2bf(s[7 * 65]) << 16);
        __builtin_nontemporal_store((pg8::u32x4){o.x, o.y, o.z, o.w}, (pg8::u32x4*)(WT + rowoff(n0 + n) + k0 + 8 * c)); }
    asm volatile("s_waitcnt lgkmcnt(0)" ::: "memory");
}
__device__ __noinline__ int cvt_matrix(const float* W, size_t wstride, int nbatch, int K, int N, int nvalid, int ldw, bf16_t* WT, float scale, int rb, int sh, int rs, int mask, int r0, int ldt, int c1,
                                       unsigned* counter, int seg_lo, int pending) {
    const int tid = mk_tid(), lane = tid & 63, wave = tid >> 6, gw = blockIdx.x * NWAVES + wave, NGW = gridDim.x * NWAVES;
    float* scr = (float*)lds_raw + wave * (64 * 65);
    const int nkb = K / 64, nnb = N / 64, per = nkb * nnb, total = per * nbatch;
    if (counter == nullptr) {
        for (int it = gw; it < total; it += NGW) { const int b = it / per, r = it % per, kb = r / nnb, nb = r % nnb;
            cvt_block(W + (size_t)b * wstride, ldw, nvalid, kb * 64, nb * 64, WT, scale, [=](int n) { return (size_t)(b * rb + (n >> sh) * rs + (n & mask) + r0) * ldt + (b & 1) * c1; }, scr, lane); }
        return 0;
    }
    const int seg_hi = seg_lo + (total + 3) / 4;
    int idx = pending;
    for (;;) {
        if (idx < 0) { unsigned v = 0; if (lane == 0) v = __hip_atomic_fetch_add(counter, 1u, __ATOMIC_RELAXED, __HIP_MEMORY_SCOPE_AGENT); idx = (int)__builtin_amdgcn_readfirstlane(v); }
        if (idx >= seg_hi) return idx;
        const int c0 = (idx - seg_lo) * 4, c1e = (c0 + 4 < total) ? c0 + 4 : total;
        for (int it = c0; it < c1e; ++it) { const int b = it / per, r = it % per, kb = r / nnb, nb = r % nnb;
            cvt_block(W + (size_t)b * wstride, ldw, nvalid, kb * 64, nb * 64, WT, scale, [=](int n) { return (size_t)(b * rb + (n >> sh) * rs + (n & mask) + r0) * ldt + (b & 1) * c1; }, scr, lane); }
        idx = -1;
    }
}
__device__ __noinline__ void ph_pre(const float* x, const float* rel_bias, unsigned char* ws) {
    const int tid = mk_tid(), lane = tid & 63, wave = tid >> 6, gw = blockIdx.x * NWAVES + wave, NGW = gridDim.x * NWAVES; float* ldsf = (float*)lds_raw;
    (void)lane; (void)wave; (void)gw; (void)NGW; (void)ldsf;
        {
            const size_t stride = (size_t)gridDim.x * NTHR, n4 = (size_t)M * D / 4;
            for (size_t i = (size_t)blockIdx.x * NTHR + tid; i < n4; i += 4 * stride) {
                float4 v[4];
#pragma unroll
                for (int q = 0; q < 4; ++q) { const size_t i4 = (i + q * stride < n4) ? i + q * stride : i; const pg8::f32x4 t_ = __builtin_nontemporal_load((const pg8::f32x4*)x + i4); v[q] = make_float4(t_[0], t_[1], t_[2], t_[3]); }
#pragma unroll
                for (int q = 0; q < 4; ++q) if (i + q * stride < n4) { uint2 o; o.x = (unsigned)f2bf(v[q].x) | ((unsigned)f2bf(v[q].y) << 16); o.y = (unsigned)f2bf(v[q].z) | ((unsigned)f2bf(v[q].w) << 16); ((uint2*)XB)[i + q * stride] = o; }
            }
        }
        for (int i = blockIdx.x * NTHR + tid; i < 4096 * 16; i += gridDim.x * NTHR) { const int d = i >> 4, h = i & 15; BIAS_T[i] = rel_bias[t5_bucket(d) * 16 + h]; }
}

__device__ __noinline__ void ph_prep_dsa_fold(const float* w_uq, const float* w_uk, bf16_t* wq, bf16_t* wuv) {
    const int tid = mk_tid(); float* ldsf = (float*)lds_raw;
    for (int i = blockIdx.x * NTHR + tid; i < HW * 32; i += gridDim.x * NTHR) { const int row = i >> 5, ch = i & 31, h = row >> 7; *(uint4*)(wuv + (size_t)row * 512 + ((h & 1) ^ 1) * 256 + ch * 8) = make_uint4(0u, 0u, 0u, 0u); }
    gemm_naive(ldsf, H, KVL, QL, HD,
        [=](int h, int c, int d) { return w_uk[((size_t)h * HD + d) * KVL + c]; },
        [=](int h, int d, int k) { return w_uq[(size_t)k * HW + h * HD + d]; },
        [=](int h, int c, int k, float v) { wq[(size_t)(h * KVL + c) * QL + k] = f2bf(v * 0.08838834764831845f); });
}

__device__ __noinline__ void ph_dsa_norms(const float* qn, const float* kn, unsigned char* ws) {
    const int tid = mk_tid(), lane = tid & 63, wave = tid >> 6, gw = blockIdx.x * NWAVES + wave, NGW = gridDim.x * NWAVES; float* ldsf = (float*)lds_raw;
    (void)lane; (void)wave; (void)gw; (void)NGW; (void)ldsf;
                for (int m = gw; m < M; m += NGW) {
                    const float* p = PRAW + (size_t)m * 1024;
                    float v[8]; float s = 0.f;
#pragma unroll
                    for (int i = 0; i < 8; ++i) { v[i] = p[lane + 64 * i]; s += v[i] * v[i]; }
                    float r = rsqrtf(wave_sum(s) * (1.f / QL) + EPS);
#pragma unroll
                    for (int i = 0; i < 8; ++i) CQ[(size_t)m * QL + lane + 64 * i] = f2bf(v[i] * r * qn[lane + 64 * i]);
                    s = 0.f;
#pragma unroll
                    for (int i = 0; i < 4; ++i) { v[i] = p[QL + lane + 64 * i]; s += v[i] * v[i]; }
                    r = rsqrtf(wave_sum(s) * (1.f / KVL) + EPS);
#pragma unroll
                    for (int i = 0; i < 4; ++i) CKV[(size_t)m * KVL + lane + 64 * i] = f2bf(v[i] * r * kn[lane + 64 * i]);
                    KIDX[(size_t)m * IDM + lane] = f2bf(p[QL + KVL + lane]);
                    if (lane < IH) WIDX[(size_t)m * IH + lane] = p[QL + KVL + IDM + lane] * 0.25f;
                }
}

typedef short s16x8 __attribute__((ext_vector_type(8)));
typedef float f32x16 __attribute__((ext_vector_type(16)));
__device__ __forceinline__ void topk_attn_pair(unsigned char* ws, int bq, int p);
__device__ __forceinline__ void ph_dsa_index(unsigned char* ws) {
    LAS unsigned char* lds = (LAS unsigned char*)lds_raw;
    const bf16_t* qall = QALL; const bf16_t* kidx = KIDX; const float* widx = WIDX; float* scb = SC;
    for (int unit = blockIdx.x; unit < NB_ * 64; unit += gridDim.x) {
        const int b = unit & 3, p = unit >> 2;
#pragma unroll 1
        for (int half = 0; half < 2; ++half) {
            int tid_ = mk_tid(); asm volatile("" : "+v"(tid_));
            const int tid = tid_, lane = tid & 63, wave = __builtin_amdgcn_readfirstlane(tid >> 6);
            const int qb = half ? p : 127 - p;
            const size_t qrow0 = (size_t)b * T + (size_t)qb * 32;
            __syncthreads();
#pragma unroll
            for (int i = 0; i < 8; ++i) { const int item = tid + 512 * i, q = item >> 7, hc = item & 127, h = hc >> 3, c = hc & 7;
                const uint4 v = *(const uint4*)(qall + (qrow0 + q) * QALD + 4096 + h * 64 + c * 8);
                *(LAS pg8::u32x4*)(lds + ((h * 4 + (c >> 1)) * 64 + q + 32 * (c & 1)) * 16) = (pg8::u32x4){v.x, v.y, v.z, v.w}; }
            if (tid < 256) {
                const int q = tid >> 3, c = tid & 7; float acc8[8];
#pragma unroll
                for (int e2 = 0; e2 < 8; ++e2) acc8[e2] = 0.f;
#pragma unroll 4
                for (int h = 0; h < 16; ++h) { const float w = widx[(qrow0 + q) * 16 + h]; const uint4 v = *(const uint4*)(qall + (qrow0 + q) * QALD + 4096 + h * 64 + c * 8); const unsigned w4[4] = {v.x, v.y, v.z, v.w};
#pragma unroll
                    for (int e2 = 0; e2 < 4; ++e2) { acc8[2 * e2] = fmaf(w, __uint_as_float(w4[e2] << 16), acc8[2 * e2]); acc8[2 * e2 + 1] = fmaf(w, __uint_as_float(w4[e2] & 0xffff0000u), acc8[2 * e2 + 1]); } }
                pg8::u32x4 o; o.x = (unsigned)f2bf(acc8[0]) | ((unsigned)f2bf(acc8[1]) << 16); o.y = (unsigned)f2bf(acc8[2]) | ((unsigned)f2bf(acc8[3]) << 16);
                o.z = (unsigned)f2bf(acc8[4]) | ((unsigned)f2bf(acc8[5]) << 16); o.w = (unsigned)f2bf(acc8[6]) | ((unsigned)f2bf(acc8[7]) << 16);
                *(LAS pg8::u32x4*)(lds + ((16 * 4 + (c >> 1)) * 64 + q + 32 * (c & 1)) * 16) = o;
            }
            if (tid < 512) { const int h = tid >> 5, q = tid & 31; *(LAS float*)(lds + 69632 + (h * 32 + q) * 4) = widx[(qrow0 + q) * 16 + h]; }
            __syncthreads();
            float* const scq = scb + (size_t)b * SC_PER_B + (size_t)512 * qb * (qb + 1) + (size_t)(lane & 31) * (32 * (qb + 1)) + 4 * (lane >> 5);
#pragma unroll 1
            for (int kb = wave; kb <= qb; kb += NWAVES) {
                s16x8 ka[4];
                { const bf16_t* kp = kidx + ((size_t)b * T + kb * 32 + (lane & 31)) * IDM + 8 * (lane >> 5);
#pragma unroll
                  for (int s = 0; s < 4; ++s) ka[s] = *(const s16x8*)(kp + 16 * s); }
                f32x16 acc;
                {
                    const f32x16 z = {0.f, 0.f, 0.f, 0.f, 0.f, 0.f, 0.f, 0.f, 0.f, 0.f, 0.f, 0.f, 0.f, 0.f, 0.f, 0.f};
                    acc = __builtin_amdgcn_mfma_f32_32x32x16_bf16(ka[0], *(const LAS s16x8*)(lds + ((16 * 4 + 0) * 64 + lane) * 16), z, 0, 0, 0);
#pragma unroll
                    for (int s = 1; s < 4; ++s) acc = __builtin_amdgcn_mfma_f32_32x32x16_bf16(ka[s], *(const LAS s16x8*)(lds + ((16 * 4 + s) * 64 + lane) * 16), acc, 0, 0, 0);
                }
#pragma unroll 2
                for (int h = 0; h < 16; ++h) {
                    const f32x16 z = {0.f, 0.f, 0.f, 0.f, 0.f, 0.f, 0.f, 0.f, 0.f, 0.f, 0.f, 0.f, 0.f, 0.f, 0.f, 0.f};
                    f32x16 sv = __builtin_amdgcn_mfma_f32_32x32x16_bf16(ka[0], *(const LAS s16x8*)(lds + ((h * 4 + 0) * 64 + lane) * 16), z, 0, 0, 0);
#pragma unroll
                    for (int s = 1; s < 4; ++s) sv = __builtin_amdgcn_mfma_f32_32x32x16_bf16(ka[s], *(const LAS s16x8*)(lds + ((h * 4 + s) * 64 + lane) * 16), sv, 0, 0, 0);
                    const float w = *(const LAS float*)(lds + 69632 + (h * 32 + (lane & 31)) * 4);
#pragma unroll
                    for (int r = 0; r < 16; ++r) acc[r] = fmaf(__builtin_fabsf(sv[r]), w, acc[r]);
                }
#pragma unroll
                for (int g = 0; g < 4; ++g) *(float4*)(scq + kb * 32 + 8 * g) = make_float4(acc[4 * g], acc[4 * g + 1], acc[4 * g + 2], acc[4 * g + 3]);
            }
        }
        asm volatile("s_waitcnt vmcnt(0)" ::: "memory");
        __syncthreads();
        topk_attn_pair(ws, b, p);
    }
    __syncthreads();
}


typedef float f32x4v __attribute__((ext_vector_type(4)));

__device__ __forceinline__ void topk_attn_pair(unsigned char* ws, int bq, int p) {
    int tid_ = mk_tid(); asm volatile("" : "+v"(tid_));
    const int tid = tid_, lane = tid & 63, wave = __builtin_amdgcn_readfirstlane(tid >> 6), n16 = lane & 15, g4 = lane >> 4;
    LAS unsigned char* lds = (LAS unsigned char*)lds_raw;
    float* sw = (float*)lds_raw + wave * 4096;
    LAS unsigned char* kvb = lds + wave * 16384;
    LAS int* sl = (LAS int*)(lds + 131072 + wave * 1024);
    LAS int* sell = sl;
    const bf16_t* qall = QALL; const bf16_t* ckv = CKV; const float* biasT = BIAS_T; bf16_t* olat = OLAT;
    const float NINF = -__builtin_inff(), PINF = __builtin_inff();
    typedef __attribute__((address_space(1))) const pg8::f32x4 gf4;
    const int nrows = 64;
    LAS int* qctr = (LAS int*)(lds + LDS_MISC + 3072);
    __syncthreads();
    if (tid == 0) *qctr = NWAVES;
    __syncthreads();
    auto row_of = [&](int j) -> int { return bq * T + ((j < 32) ? (127 - p) * 32 + 31 - j : p * 32 + 63 - j); };
    pg8::f32x4 xs[16];
    auto fetch = [&](int j) {
        if (j < nrows) { const int m = row_of(j), b = m / T, t = m % T, n = t + 1;
            if (n > TOPK) { const int nq = (n + 255) >> 8; gf4* sg = (gf4*)(SC + sc_off(b, t)) + lane;
#pragma unroll
                for (int i = 0; i < 16; ++i) xs[i] = (i < nq) ? __builtin_nontemporal_load(sg + 64 * i) : (pg8::f32x4){NINF, NINF, NINF, NINF}; } }
    };
    int jcur = wave;
    fetch(jcur);
    while (jcur < nrows) {
        const int m = row_of(jcur);
        int jn; { int tkv = 0; if (lane == 0) tkv = __hip_atomic_fetch_add(qctr, 1, __ATOMIC_RELAXED, __HIP_MEMORY_SCOPE_WORKGROUP); jn = __builtin_amdgcn_readfirstlane(tkv); }
        jcur = jn;
        const int b = m / T, t = m % T, n = t + 1;
        float zf = 0.f; asm volatile("" : "+v"(zf));
        s16x8 qf[8];
        { const bf16_t* qrow = qall + (size_t)m * QALD + n16 * KVL + 8 * g4;
#pragma unroll
          for (int s = 0; s < 8; ++s) qf[s] = *(const s16x8*)(qrow + 32 * s); }
        int nsel;
        if (n <= TOPK) {
            int l3 = tid; asm volatile("" : "+v"(l3)); l3 &= 63;
#pragma unroll
            for (int i = 0; i < 4; ++i) { const int k = l3 + 64 * i; sl[k] = (k < n) ? k : 0; }
            nsel = n;
        } else {
            const int nq = (n + 255) >> 8;
            float mn = PINF, mx = NINF;
            {
#pragma unroll
                for (int i = 0; i < 16; ++i) { const int k0 = 4 * (lane + 64 * i); float4 x = make_float4(xs[i][0], xs[i][1], xs[i][2], xs[i][3]);
                    x.x = (k0 + 0 < n) ? x.x : NINF; x.y = (k0 + 1 < n) ? x.y : NINF; x.z = (k0 + 2 < n) ? x.z : NINF; x.w = (k0 + 3 < n) ? x.w : NINF;
                    *(float4*)(sw + k0) = x;
                    mx = fmaxf(fmaxf(mx, x.x), fmaxf(x.y, fmaxf(x.z, x.w)));
                    mn = fminf(mn, x.x == NINF ? PINF : x.x); mn = fminf(mn, x.y == NINF ? PINF : x.y); mn = fminf(mn, x.z == NINF ? PINF : x.z); mn = fminf(mn, x.w == NINF ? PINF : x.w); }
            }
            float lo_v = wave_min_dpp(mn), hi_v = wave_max_dpp(mx);
            int c_lo = n, c_hi = 1;
#pragma unroll 1
            for (int it = 0; it < 96; ++it) {
                if (c_lo == TOPK) break;
                float f = 0.5f;
                if ((it & 1) == 0) { f = ((float)(c_lo - TOPK) + 0.5f) / (float)(c_lo - c_hi); f = fminf(fmaxf(f, 0.03f), 0.97f); }
                float mid = lo_v + (hi_v - lo_v) * f;
                if (!(mid > lo_v && mid < hi_v)) { mid = lo_v + (hi_v - lo_v) * 0.5f; if (!(mid > lo_v && mid < hi_v)) break; }
                int c = 0;
#pragma unroll 1
                for (int i0 = 0; i0 < nq; i0 += 8) {
                    float4 x8[8];
#pragma unroll
                    for (int j = 0; j < 8; ++j) x8[j] = *(const float4*)(sw + 4 * (lane + 64 * (i0 + j)));
#pragma unroll
                    for (int j = 0; j < 8; ++j) c += (x8[j].x >= mid) + (x8[j].y >= mid) + (x8[j].z >= mid) + (x8[j].w >= mid);
                }
                c = wave_sum_dpp(c);
                if (c >= TOPK) { lo_v = mid; c_lo = c; } else { hi_v = mid; c_hi = c; }
            }
            float Tv = lo_v;
            int lgt = 0, leq = 0;
#pragma unroll 4
            for (int i = 0; i < nq; ++i) { const float4 x = *(const float4*)(sw + 4 * (lane + 64 * i));
                lgt += (x.x > Tv) + (x.y > Tv) + (x.z > Tv) + (x.w > Tv); leq += (x.x == Tv) + (x.y == Tv) + (x.z == Tv) + (x.w == Tv); }
            int sgt = wave_scan_dpp(lgt), seq = wave_scan_dpp(leq);
            int cgt = __builtin_amdgcn_readlane(sgt, 63), ceq = __builtin_amdgcn_readlane(seq, 63);
            if (cgt > TOPK) {
                Tv = hi_v; lgt = 0; leq = 0;
#pragma unroll 4
                for (int i = 0; i < nq; ++i) { const float4 x = *(const float4*)(sw + 4 * (lane + 64 * i)); leq += (x.x == Tv) + (x.y == Tv) + (x.z == Tv) + (x.w == Tv); }
                cgt = 0; sgt = 0; seq = wave_scan_dpp(leq); ceq = __builtin_amdgcn_readlane(seq, 63);
            }
            const int need = TOPK - cgt;
            int p = sgt - lgt, q = cgt + seq - leq;
            const bool all_ties = (ceq <= need);
#pragma unroll 2
            for (int i = 0; i < nq; ++i) {
                const int k0 = 4 * (lane + 64 * i); const float4 x = *(const float4*)(sw + k0); const float xv[4] = {x.x, x.y, x.z, x.w};
#pragma unroll
                for (int e2 = 0; e2 < 4; ++e2) { if (xv[e2] > Tv) sl[p++] = k0 + e2; else if (all_ties && xv[e2] == Tv) sl[q++] = k0 + e2; }
            }
            if (!all_ties) {
                int taken_below = -1;
                _Pragma("unroll 1") for (int i2 = 0; i2 < need; ++i2) {
                    int best = 0x7fffffff;
                    _Pragma("unroll 1") for (int i = 0; i < nq; ++i) { const int k0 = 4 * (lane + 64 * i); const float4 x = *(const float4*)(sw + k0); const float xv[4] = {x.x, x.y, x.z, x.w};
#pragma unroll
                        for (int e2 = 0; e2 < 4; ++e2) { const int key = k0 + e2; if (xv[e2] == Tv && key > taken_below && key < best) best = key; } }
                    best = wave_min_i(best);
                    if (lane == 0) sl[cgt + i2] = best;
                    taken_below = best;
                }
            }
            nsel = TOPK;
        }
        fetch(jn);
        f32x4v o[16];
#pragma unroll
        for (int cb = 0; cb < 16; ++cb) o[cb] = (f32x4v){zf, zf, zf, zf};
        float m_run = -1e30f, l_run = 0.f;
        const int nch = (nsel + 31) >> 5;
        const size_t rowb = (size_t)b * T;
#pragma unroll 1
        for (int ch = 0; ch < nch; ++ch) {
            asm volatile("s_waitcnt lgkmcnt(0)" ::: "memory");
#pragma unroll
            for (int i = 0; i < 16; ++i) { const int row = 2 * i + (lane >> 5), key = sell[ch * 32 + row], c = (lane & 31) ^ (row & 15);
                __builtin_amdgcn_global_load_lds((const unsigned*)(ckv + (rowb + key) * KVL + c * 8), (LAS unsigned*)(kvb + i * 1024), 16, 0, 0); }
            const pg8::u32x4 k0 = *(const LAS pg8::u32x4*)(sell + ch * 32 + 4 * g4), k1 = *(const LAS pg8::u32x4*)(sell + ch * 32 + 16 + 4 * g4);
            float bia[8];
            bia[0] = biasT[(t - (int)k0.x) * 16 + n16]; bia[1] = biasT[(t - (int)k0.y) * 16 + n16]; bia[2] = biasT[(t - (int)k0.z) * 16 + n16]; bia[3] = biasT[(t - (int)k0.w) * 16 + n16];
            bia[4] = biasT[(t - (int)k1.x) * 16 + n16]; bia[5] = biasT[(t - (int)k1.y) * 16 + n16]; bia[6] = biasT[(t - (int)k1.z) * 16 + n16]; bia[7] = biasT[(t - (int)k1.w) * 16 + n16];
            asm volatile("s_waitcnt vmcnt(0)" ::: "memory");
            f32x4v s0 = (f32x4v){0.f, 0.f, 0.f, 0.f}, s1 = (f32x4v){0.f, 0.f, 0.f, 0.f};
#pragma unroll
            for (int s = 0; s < 8; ++s) {
                const int cs = ((4 * s + g4) ^ n16) * 16;
                const s16x8 a0 = *(const LAS s16x8*)(kvb + n16 * 512 + cs), a1 = *(const LAS s16x8*)(kvb + (16 + n16) * 512 + cs);
                s0 = __builtin_amdgcn_mfma_f32_16x16x32_bf16(a0, qf[s], s0, 0, 0, 0); s1 = __builtin_amdgcn_mfma_f32_16x16x32_bf16(a1, qf[s], s1, 0, 0, 0);
            }
            float sc[8]; float tmax = -__builtin_inff();
#pragma unroll
            for (int r = 0; r < 4; ++r) { sc[r] = (ch * 32 + 4 * g4 + r < nsel) ? s0[r] + bia[r] : -__builtin_inff(); sc[4 + r] = (ch * 32 + 16 + 4 * g4 + r < nsel) ? s1[r] + bia[4 + r] : -__builtin_inff(); }
#pragma unroll
            for (int r = 0; r < 8; ++r) tmax = fmaxf(tmax, sc[r]);
            tmax = fmaxf(tmax, __shfl_xor(tmax, 16)); tmax = fmaxf(tmax, __shfl_xor(tmax, 32));
            if (__any(tmax > m_run + 6.f)) {
                const float mnew = fmaxf(m_run, tmax), alpha = __expf(m_run - mnew);
#pragma unroll
                for (int cb = 0; cb < 16; ++cb) o[cb] *= alpha;
                l_run *= alpha; m_run = mnew;
            }
            float p[8]; float psum = 0.f;
#pragma unroll
            for (int r = 0; r < 8; ++r) { p[r] = __expf(sc[r] - m_run); psum += p[r]; }
            l_run += psum;
            s16x8 pb;
            { const unsigned w0 = pg8::cvt_pk_bf16(p[0], p[1]), w1 = pg8::cvt_pk_bf16(p[2], p[3]), w2 = pg8::cvt_pk_bf16(p[4], p[5]), w3 = pg8::cvt_pk_bf16(p[6], p[7]);
              pb[0] = (short)(w0 & 0xffff); pb[1] = (short)(w0 >> 16); pb[2] = (short)(w1 & 0xffff); pb[3] = (short)(w1 >> 16); pb[4] = (short)(w2 & 0xffff); pb[5] = (short)(w2 >> 16); pb[6] = (short)(w3 & 0xffff); pb[7] = (short)(w3 >> 16); }
            {
                const int q4 = n16 >> 2, p4 = n16 & 3, x = 4 * g4 + q4;
                const LAS unsigned char* vb = kvb + x * 512 + (p4 & 1) * 8;
                const int yo = (p4 >> 1) ^ (x & 1), xe = x & 14;
#pragma unroll
                for (int cq = 0; cq < 4; ++cq) {
                    typedef short s16x4 __attribute__((ext_vector_type(4)));
                    s16x4 lo[4], hi4[4];
#pragma unroll
                    for (int u = 0; u < 4; ++u) { const int cb = 4 * cq + u; const int co = (((2 * cb) ^ xe) + yo) * 16;
                        lo[u] = __builtin_bit_cast(s16x4, __builtin_amdgcn_ds_read_tr16_b64_v4i16((LAS s16x4*)(vb + co)));
                        hi4[u] = __builtin_bit_cast(s16x4, __builtin_amdgcn_ds_read_tr16_b64_v4i16((LAS s16x4*)(vb + 16 * 512 + co))); }
#pragma unroll
                    for (int u = 0; u < 4; ++u) { const int cb = 4 * cq + u;
                        s16x8 va; va[0] = lo[u][0]; va[1] = lo[u][1]; va[2] = lo[u][2]; va[3] = lo[u][3]; va[4] = hi4[u][0]; va[5] = hi4[u][1]; va[6] = hi4[u][2]; va[7] = hi4[u][3];
                        o[cb] = __builtin_amdgcn_mfma_f32_16x16x32_bf16(va, pb, o[cb], 0, 0, 0); }
                }
            }
        }
        {
            float lt = l_run; lt += __shfl_xor(lt, 16); lt += __shfl_xor(lt, 32);
            const float inv = 1.f / lt;
            bf16_t* orow = olat + (size_t)m * 4096 + n16 * KVL + 4 * g4;
#pragma unroll
            for (int cb = 0; cb < 16; ++cb) { pg8::u32x2 w; w.x = pg8::cvt_pk_bf16(o[cb][0] * inv, o[cb][1] * inv); w.y = pg8::cvt_pk_bf16(o[cb][2] * inv, o[cb][3] * inv); *(pg8::u32x2*)(orow + 16 * cb) = w; }
        }
    }
}

__device__ __forceinline__ void ph_dil_attn(unsigned char* ws, unsigned* qbase) {
    int tid_ = mk_tid(); asm volatile("" : "+v"(tid_));
    const int tid = tid_, lane = tid & 63, wave = __builtin_amdgcn_readfirstlane(tid >> 6), qi = lane & 31, hi = lane >> 5;
    LAS unsigned char* lds = (LAS unsigned char*)lds_raw;
    LAS unsigned char* kbuf = lds + wave * 16384;
    LAS unsigned char* vbuf = kbuf + 8192;
    const int drow = lane >> 4, kc0 = ((lane & 15) ^ drow) * 8, kc1 = ((lane & 15) ^ (4 + drow)) * 8, vc = ((lane & 15) ^ (drow << 2)) * 8;
    LAS float* btab = (LAS float*)(lds + 131072);
    const bf16_t* qkv = QKV; bf16_t* ob = OB; const float* biasT = BIAS_T;
    bf16_t* stb = (bf16_t*)(ws + AR_DST) + (size_t)blockIdx.x * (512 * 128);
    float* mlb = (float*)(ws + AR_DML) + (size_t)blockIdx.x * (512 * 4);
    const int xq = (int)blockIdx.x & 7, nfirst = (int)gridDim.x >> 3;
    LAS int* tkw = (LAS int*)(lds + LDS_MISC + 3072);
    for (int j = (int)blockIdx.x >> 3; j < 64; ) {
        float zf = 0.f; asm volatile("" : "+v"(zf));
        const f32x16 zero16 = {zf, zf, zf, zf, zf, zf, zf, zf, zf, zf, zf, zf, zf, zf, zf, zf};
        const int bhi = (j < 56) ? j / 7 : j - 56, span = (j < 56) ? 1 + j % 7 : 0;
        const int x = xq, u = 8 * bhi + span, bh = x + 8 * (u >> 3), h = bh & 15, s0 = (u & 7) * 512;
        __syncthreads();
        if (tid == 0) *tkw = nfirst + (int)__hip_atomic_fetch_add(qbase + 16 * xq, 1u, __ATOMIC_RELAXED, __HIP_MEMORY_SCOPE_AGENT);
        { int t2 = tid; asm volatile("" : "+v"(t2));
          if (t2 < 387) { const int br = t2 / 129, m = t2 - br * 129, dl = (br == 0) ? 1 : (br == 1 ? 4 : 16); btab[br * 132 + m] = biasT[(dl * m) * 16 + h] * 1.4426950408889634f; } }
        __syncthreads();
        const bf16_t* qbase = qkv + (size_t)bh * T * HD + 8 * hi;
        const bf16_t* kbase = qkv + (size_t)(64 + bh) * T * HD;
        const bf16_t* vbase = qkv + (size_t)(128 + bh) * T * HD;
        s16x8 qf[8], kf[8];
        f32x16 o0 = zero16, o1 = zero16, o2 = zero16, o3 = zero16;
        float m_run = -1e30f, l_run = 0.f;
        int br = 0, gi = 0, kt = 0, tb = s0 + 32 * wave, tq = 0;
        while (tb + (-128 + 32 * kt + 31) < 0) ++kt;
        bool fresh = true;
        {
            const int J0 = -128 + 32 * kt;
#pragma unroll
            for (int i = 0; i < 8; ++i) { int tk = tb + (J0 + 4 * i + drow); tk = tk < 0 ? 0 : tk;
                __builtin_amdgcn_global_load_lds((const unsigned*)(kbase + (size_t)tk * HD + ((i & 1) ? kc1 : kc0)), (LAS unsigned*)(kbuf + i * 1024), 16, 0, 0); }
#pragma unroll
            for (int i = 0; i < 8; ++i) { int tv = tb + (J0 + 4 * i + drow); tv = tv < 0 ? 0 : tv;
                __builtin_amdgcn_global_load_lds((const unsigned*)(vbase + (size_t)tv * HD + vc), (LAS unsigned*)(vbuf + i * 1024), 16, 0, 0); }
        }
#pragma unroll 1
        for (;;) {
            const int shift = 2 * br, J0 = -128 + 32 * kt;
            if (fresh) {
                tq = tb + (qi << shift);
                if (br > 0 && gi == 0) { asm volatile("s_waitcnt vmcnt(0)" ::: "memory"); __syncthreads(); }
                const bf16_t* qrow = qbase + (size_t)tq * HD;
#pragma unroll
                for (int s = 0; s < 8; ++s) qf[s] = *(const s16x8*)(qrow + 16 * s);
                if (br == 0) { o0 = zero16; o1 = zero16; o2 = zero16; o3 = zero16; m_run = -1e30f; l_run = 0.f; }
                else {
                    const int ql = (tq - s0) * 2 + hi;
                    const pg8::u32x4* sp = (const pg8::u32x4*)(stb + (size_t)ql * 64);
                    const float2 ml = *(const float2*)(mlb + ql * 2); m_run = ml.x; l_run = ml.y;
#define DIL_LD(O, DB) { const pg8::u32x4 w0 = sp[2 * (DB)], w1 = sp[2 * (DB) + 1]; \
                        O[0] = __uint_as_float(w0.x << 16); O[1] = __uint_as_float(w0.x & 0xffff0000u); O[2] = __uint_as_float(w0.y << 16); O[3] = __uint_as_float(w0.y & 0xffff0000u); \
                        O[4] = __uint_as_float(w0.z << 16); O[5] = __uint_as_float(w0.z & 0xffff0000u); O[6] = __uint_as_float(w0.w << 16); O[7] = __uint_as_float(w0.w & 0xffff0000u); \
                        O[8] = __uint_as_float(w1.x << 16); O[9] = __uint_as_float(w1.x & 0xffff0000u); O[10] = __uint_as_float(w1.y << 16); O[11] = __uint_as_float(w1.y & 0xffff0000u); \
                        O[12] = __uint_as_float(w1.z << 16); O[13] = __uint_as_float(w1.z & 0xffff0000u); O[14] = __uint_as_float(w1.w << 16); O[15] = __uint_as_float(w1.w & 0xffff0000u); }
                    DIL_LD(o0, 0) DIL_LD(o1, 1) DIL_LD(o2, 2) DIL_LD(o3, 3)
#undef DIL_LD
                }
            }
            const int mmax = min(128, tq >> shift);
            int nbr = br, ngi = gi, nkt = kt + 1, ntb = tb;
            if (nkt == 5) {
                ++ngi; if (ngi == 2) { ngi = 0; ++nbr; }
                nkt = 0;
                if (nbr < 3) { const int g = wave + 8 * ngi, ndl = 1 << (2 * nbr);
                    ntb = s0 + ((nbr == 0) ? 32 * g : (nbr == 1) ? 128 * (g >> 2) + (g & 3) : g);
                    while (ntb + (-128 + 32 * nkt + 31) * ndl < 0) ++nkt; }
            }
            const bool more = nbr < 3, glast = (kt == 4);
            const int mb = qi - J0 - 4 * hi;
            const LAS float* bt = btab + br * 132;
            float bv[16];
#pragma unroll
            for (int r = 0; r < 16; ++r) { const int m = mb - ((r & 3) + 8 * (r >> 2)); bv[r] = bt[min(max(m, 0), 128)]; }
            asm volatile("s_waitcnt vmcnt(8)" ::: "memory");
#pragma unroll
            for (int s = 0; s < 8; ++s) kf[s] = *(const LAS s16x8*)(kbuf + qi * 256 + (((2 * s + hi) ^ (qi & 7)) * 16));
            asm volatile("s_waitcnt lgkmcnt(0)" ::: "memory");
            if (more) {
                const int ndl = 1 << (2 * nbr), nJ0 = -128 + 32 * nkt;
#pragma unroll
                for (int i = 0; i < 8; ++i) { int tk = ntb + (nJ0 + 4 * i + drow) * ndl; tk = tk < 0 ? 0 : tk;
                    __builtin_amdgcn_global_load_lds((const unsigned*)(kbase + (size_t)tk * HD + ((i & 1) ? kc1 : kc0)), (LAS unsigned*)(kbuf + i * 1024), 16, 0, 0); }
            }
            f32x16 sc = __builtin_amdgcn_mfma_f32_32x32x16_bf16(kf[0], qf[0], (f32x16){0.f, 0.f, 0.f, 0.f, 0.f, 0.f, 0.f, 0.f, 0.f, 0.f, 0.f, 0.f, 0.f, 0.f, 0.f, 0.f}, 0, 0, 0);
#pragma unroll
            for (int s = 1; s < 8; ++s) sc = __builtin_amdgcn_mfma_f32_32x32x16_bf16(kf[s], qf[s], sc, 0, 0, 0);
            float tmax = -__builtin_inff();
#pragma unroll
            for (int r = 0; r < 16; ++r) { const int m = mb - ((r & 3) + 8 * (r >> 2));
                sc[r] = ((unsigned)m <= (unsigned)mmax) ? sc[r] + bv[r] : -__builtin_inff(); tmax = fmaxf(tmax, sc[r]); }
            tmax = fmaxf(tmax, __shfl_xor(tmax, 32));
            if (__any(tmax > m_run + 8.f)) {
                const float mnew = fmaxf(m_run, tmax), alpha = __builtin_amdgcn_exp2f(m_run - mnew);
                o0 *= alpha; o1 *= alpha; o2 *= alpha; o3 *= alpha; l_run *= alpha; m_run = mnew;
            }
            float psum = 0.f; unsigned pk[8];
#pragma unroll
            for (int r = 0; r < 16; r += 2) { const float p0 = __builtin_amdgcn_exp2f(sc[r] - m_run), p1 = __builtin_amdgcn_exp2f(sc[r + 1] - m_run); psum += p0 + p1; pk[r >> 1] = pg8::cvt_pk_bf16(p0, p1); }
            l_run += psum;
            if (more) asm volatile("s_waitcnt vmcnt(8)" ::: "memory"); else asm volatile("s_waitcnt vmcnt(0)" ::: "memory");
            {
                const int G4 = lane >> 4, q4 = (lane & 15) >> 2, p4 = lane & 3;
                const LAS unsigned char* vb = vbuf + (4 * (G4 >> 1) + q4) * 256 + (2 * (G4 & 1) + (p4 >> 1)) * 16 + (p4 & 1) * 8;
#pragma unroll
                for (int s2 = 0; s2 < 2; ++s2) {
                    s16x8 pb; pb[0] = (short)(pk[4 * s2] & 0xffff); pb[1] = (short)(pk[4 * s2] >> 16); pb[2] = (short)(pk[4 * s2 + 1] & 0xffff); pb[3] = (short)(pk[4 * s2 + 1] >> 16);
                    pb[4] = (short)(pk[4 * s2 + 2] & 0xffff); pb[5] = (short)(pk[4 * s2 + 2] >> 16); pb[6] = (short)(pk[4 * s2 + 3] & 0xffff); pb[7] = (short)(pk[4 * s2 + 3] >> 16);
                    typedef short s16x4 __attribute__((ext_vector_type(4)));
                    s16x4 lo[4], hi4[4];
#pragma unroll
                    for (int db = 0; db < 4; ++db) { const int sw = (db ^ q4) * 64;
                        lo[db] = __builtin_bit_cast(s16x4, __builtin_amdgcn_ds_read_tr16_b64_v4i16((LAS s16x4*)(vb + (16 * s2) * 256 + sw)));
                        hi4[db] = __builtin_bit_cast(s16x4, __builtin_amdgcn_ds_read_tr16_b64_v4i16((LAS s16x4*)(vb + (16 * s2 + 8) * 256 + sw))); }
#pragma unroll
                    for (int db = 0; db < 4; ++db) {
                        s16x8 va; va[0] = lo[db][0]; va[1] = lo[db][1]; va[2] = lo[db][2]; va[3] = lo[db][3]; va[4] = hi4[db][0]; va[5] = hi4[db][1]; va[6] = hi4[db][2]; va[7] = hi4[db][3];
                        if (db == 0) o0 = __builtin_amdgcn_mfma_f32_32x32x16_bf16(va, pb, o0, 0, 0, 0);
                        else if (db == 1) o1 = __builtin_amdgcn_mfma_f32_32x32x16_bf16(va, pb, o1, 0, 0, 0);
                        else if (db == 2) o2 = __builtin_amdgcn_mfma_f32_32x32x16_bf16(va, pb, o2, 0, 0, 0);
                        else o3 = __builtin_amdgcn_mfma_f32_32x32x16_bf16(va, pb, o3, 0, 0, 0);
                    }
                }
            }
            if (glast) {
                if (br < 2) {
                    const int ql = (tq - s0) * 2 + hi;
                    pg8::u32x4* sp = (pg8::u32x4*)(stb + (size_t)ql * 64);
                    float2 ml; ml.x = m_run; ml.y = l_run; *(float2*)(mlb + ql * 2) = ml;
#define DIL_ST(O, DB) { pg8::u32x4 w0, w1; \
                        w0.x = pg8::cvt_pk_bf16(O[0], O[1]); w0.y = pg8::cvt_pk_bf16(O[2], O[3]); w0.z = pg8::cvt_pk_bf16(O[4], O[5]); w0.w = pg8::cvt_pk_bf16(O[6], O[7]); \
                        w1.x = pg8::cvt_pk_bf16(O[8], O[9]); w1.y = pg8::cvt_pk_bf16(O[10], O[11]); w1.z = pg8::cvt_pk_bf16(O[12], O[13]); w1.w = pg8::cvt_pk_bf16(O[14], O[15]); \
                        sp[2 * (DB)] = w0; sp[2 * (DB) + 1] = w1; }
                    DIL_ST(o0, 0) DIL_ST(o1, 1) DIL_ST(o2, 2) DIL_ST(o3, 3)
#undef DIL_ST
                } else {
                    const float l_tot = l_run + __shfl_xor(l_run, 32), inv = 1.f / l_tot;
                    bf16_t* orow = ob + ((size_t)(bh >> 4) * T + tq) * HW + h * HD + 4 * hi;
#pragma unroll
                    for (int g = 0; g < 4; ++g) {
                        pg8::u32x2 w;
                        w.x = pg8::cvt_pk_bf16(o0[4 * g] * inv, o0[4 * g + 1] * inv); w.y = pg8::cvt_pk_bf16(o0[4 * g + 2] * inv, o0[4 * g + 3] * inv); *(pg8::u32x2*)(orow + 0 + 8 * g) = w;
                        w.x = pg8::cvt_pk_bf16(o1[4 * g] * inv, o1[4 * g + 1] * inv); w.y = pg8::cvt_pk_bf16(o1[4 * g + 2] * inv, o1[4 * g + 3] * inv); *(pg8::u32x2*)(orow + 32 + 8 * g) = w;
                        w.x = pg8::cvt_pk_bf16(o2[4 * g] * inv, o2[4 * g + 1] * inv); w.y = pg8::cvt_pk_bf16(o2[4 * g + 2] * inv, o2[4 * g + 3] * inv); *(pg8::u32x2*)(orow + 64 + 8 * g) = w;
                        w.x = pg8::cvt_pk_bf16(o3[4 * g] * inv, o3[4 * g + 1] * inv); w.y = pg8::cvt_pk_bf16(o3[4 * g + 2] * inv, o3[4 * g + 3] * inv); *(pg8::u32x2*)(orow + 96 + 8 * g) = w;
                    }
                }
            }
            if (!more) break;
            asm volatile("s_waitcnt lgkmcnt(0)" ::: "memory");
            {
                const int ndl = 1 << (2 * nbr), nJ0 = -128 + 32 * nkt;
#pragma unroll
                for (int i = 0; i < 8; ++i) { int tv = ntb + (nJ0 + 4 * i + drow) * ndl; tv = tv < 0 ? 0 : tv;
                    __builtin_amdgcn_global_load_lds((const unsigned*)(vbase + (size_t)tv * HD + vc), (LAS unsigned*)(vbuf + i * 1024), 16, 0, 0); }
            }
            fresh = glast; br = nbr; gi = ngi; kt = nkt; tb = ntb;
        }
        j = __builtin_amdgcn_readfirstlane(*tkw);
    }
    __syncthreads();
}

__device__ __forceinline__ void route_token(const float (&lgt)[16], const float* router_b, int& i1, int& i2, float& g1, float& g2) {
    float mx = lgt[0];
#pragma unroll
    for (int e = 1; e < 16; ++e) mx = fmaxf(mx, lgt[e]);
    float pr[16], sm = 0.f;
#pragma unroll
    for (int e = 0; e < 16; ++e) { pr[e] = __expf(lgt[e] - mx); sm += pr[e]; }
    const float inv = 1.f / sm;
    float sl[16];
#pragma unroll
    for (int e = 0; e < 16; ++e) { pr[e] *= inv; sl[e] = pr[e] + router_b[e]; }
    int bg = 0; float bgs = -__builtin_inff();
#pragma unroll
    for (int g = 0; g < NG; ++g) {
        const float a0 = sl[g * 4], a1 = sl[g * 4 + 1], a2 = sl[g * 4 + 2], a3 = sl[g * 4 + 3];
        const float h1 = fmaxf(a0, a1), l1 = fminf(a0, a1), h2 = fmaxf(a2, a3), l2 = fminf(a2, a3);
        const float gs = fmaxf(h1, h2) + fmaxf(fminf(h1, h2), fmaxf(l1, l2));
        const bool better = gs > bgs; bgs = better ? gs : bgs; bg = better ? g : bg;
    }
    float sg[4], pg[4];
#pragma unroll
    for (int i = 0; i < 4; ++i) { sg[i] = (bg == 0) ? sl[i] : (bg == 1) ? sl[4 + i] : (bg == 2) ? sl[8 + i] : sl[12 + i]; pg[i] = (bg == 0) ? pr[i] : (bg == 1) ? pr[4 + i] : (bg == 2) ? pr[8 + i] : pr[12 + i]; }
    int l1i = 0; float v1 = sg[0], p1 = pg[0];
#pragma unroll
    for (int i = 1; i < 4; ++i) { const bool b = sg[i] > v1; v1 = b ? sg[i] : v1; p1 = b ? pg[i] : p1; l1i = b ? i : l1i; }
    int l2i = 0; float v2 = -__builtin_inff(), p2 = 0.f;
#pragma unroll
    for (int i = 0; i < 4; ++i) { const bool b = (i != l1i) && (sg[i] > v2); v2 = b ? sg[i] : v2; p2 = b ? pg[i] : p2; l2i = b ? i : l2i; }
    i1 = bg * 4 + l1i; i2 = bg * 4 + l2i;
    const float gsum = p1 + p2; g1 = p1 / gsum; g2 = p2 / gsum;
}
__device__ __forceinline__ float reduce16(float (&v)[16], int lane) {
#pragma unroll
    for (int i = 0; i < 8; ++i) { const bool up = lane & 1; const float keep = up ? v[i + 8] : v[i], send = up ? v[i] : v[i + 8]; v[i] = keep + __shfl_xor(send, 1); }
#pragma unroll
    for (int i = 0; i < 4; ++i) { const bool up = lane & 2; const float keep = up ? v[i + 4] : v[i], send = up ? v[i] : v[i + 4]; v[i] = keep + __shfl_xor(send, 2); }
#pragma unroll
    for (int i = 0; i < 2; ++i) { const bool up = lane & 4; const float keep = up ? v[i + 2] : v[i], send = up ? v[i] : v[i + 2]; v[i] = keep + __shfl_xor(send, 4); }
    { const bool up = lane & 8; const float keep = up ? v[1] : v[0], send = up ? v[0] : v[1]; v[0] = keep + __shfl_xor(send, 8); }
    float r = v[0]; r += __shfl_xor(r, 16); r += __shfl_xor(r, 32); return r;
}
__device__ __forceinline__ void route_pair(float x, int lane, const float* router_b, int m, int* expid, float* gatew, int* lh) {
    const int E = lane & 15;
    float mx = x; mx = fmaxf(mx, __shfl_xor(mx, 1)); mx = fmaxf(mx, __shfl_xor(mx, 2)); mx = fmaxf(mx, __shfl_xor(mx, 4)); mx = fmaxf(mx, __shfl_xor(mx, 8));
    const float p = __expf(x - mx);
    float sm = p; sm += __shfl_xor(sm, 1); sm += __shfl_xor(sm, 2); sm += __shfl_xor(sm, 4); sm += __shfl_xor(sm, 8);
    const float pr = p * (1.f / sm), sl = pr + router_b[E];
    const float a = __shfl_xor(sl, 1), h1 = fmaxf(sl, a), l1 = fminf(sl, a), bh = __shfl_xor(h1, 2), bl = __shfl_xor(l1, 2);
    float gs = fmaxf(h1, bh) + fmaxf(fminf(h1, bh), fmaxf(l1, bl));
    int g = E >> 2;
    { const float og = __shfl_xor(gs, 4); const int oi = __shfl_xor(g, 4); const bool t = (og > gs) || (og == gs && oi < g); gs = t ? og : gs; g = t ? oi : g; }
    { const float og = __shfl_xor(gs, 8); const int oi = __shfl_xor(g, 8); const bool t = (og > gs) || (og == gs && oi < g); gs = t ? og : gs; g = t ? oi : g; }
    const bool inb = (E >> 2) == g;
    int rank = 0;
#pragma unroll
    for (int d = 1; d < 4; ++d) { const float os = __shfl_xor(sl, d); const int oe = E ^ d; rank += ((os > sl) || (os == sl && oe < E)) ? 1 : 0; }
    const unsigned long long b1 = __ballot(inb && rank == 0), b2 = __ballot(inb && rank == 1);
    const int pri = __float_as_int(pr);
#pragma unroll
    for (int q = 0; q < 2; ++q) {
        const int i1 = __builtin_ctz(((unsigned)(b1 >> (16 * q)) & 0xffffu) | 0x10000u), i2 = __builtin_ctz(((unsigned)(b2 >> (16 * q)) & 0xffffu) | 0x10000u);
        const float p1 = __int_as_float(__builtin_amdgcn_readlane(pri, 16 * q + (i1 & 15))), p2 = __int_as_float(__builtin_amdgcn_readlane(pri, 16 * q + (i2 & 15)));
        const float gsum = p1 + p2;
        if (lane == 0) { expid[(m + q) * 2] = i1 & 15; expid[(m + q) * 2 + 1] = i2 & 15; gatew[(m + q) * 2] = p1 / gsum; gatew[(m + q) * 2 + 1] = p2 / gsum; atomicAdd(&lh[i1 & 15], 1); atomicAdd(&lh[i2 & 15], 1); }
    }
}
__device__ __forceinline__ void ph_ln1_router(const float* g1, const float* b1, const float* router_w, const float* router_b, unsigned char* ws) {
    int tid_ = mk_tid(); asm volatile("" : "+v"(tid_));
    const int tid = tid_, lane = tid & 63, wave = __builtin_amdgcn_readfirstlane(tid >> 6);
    LAS unsigned char* lds = (LAS unsigned char*)lds_raw;
    LAS float* stat = (LAS float*)(lds + 131072);
    LAS pg8::f32x4* dpart = (LAS pg8::f32x4*)(lds + 131072 + 1024);
    int* lh = (int*)((unsigned char*)lds_raw + LDS_MISC + 256);
    LAS float* gbl = (LAS float*)(lds + 147456);
    __syncthreads();
    { const float4 gv = *(const float4*)(g1 + 4 * tid), bv = *(const float4*)(b1 + 4 * tid);
      *(LAS pg8::f32x4*)(gbl + 4 * tid) = (pg8::f32x4){gv.x, gv.y, gv.z, gv.w}; *(LAS pg8::f32x4*)(gbl + 2048 + 4 * tid) = (pg8::f32x4){bv.x, bv.y, bv.z, bv.w}; }
    {
        float4 w0[8], w1[8];
#pragma unroll
        for (int q = 0; q < 8; ++q) { const int p = tid + NTHR * q, k = (p >> 2) * 2, e4 = (p & 3) * 4; w0[q] = *(const float4*)(router_w + k * 16 + e4); w1[q] = *(const float4*)(router_w + (k + 1) * 16 + e4); }
#pragma unroll
        for (int q = 0; q < 8; ++q) { const int p = tid + NTHR * q, k = (p >> 2) * 2, e4 = (p & 3) * 4, ks = k >> 5, gg = (k >> 3) & 3, j = k & 7;
            const float a[4] = {w0[q].x, w0[q].y, w0[q].z, w0[q].w}, b[4] = {w1[q].x, w1[q].y, w1[q].z, w1[q].w};
#pragma unroll
            for (int i = 0; i < 4; ++i) { const bf16_t ah = f2bf(a[i]), bh = f2bf(b[i]), al = f2bf(a[i] - bf2f(ah)), bl = f2bf(b[i] - bf2f(bh));
                const int off = ks * 1024 + (e4 + i + 16 * gg) * 16 + j * 2;
                *(LAS unsigned*)(lds + off) = (unsigned)ah | ((unsigned)bh << 16); *(LAS unsigned*)(lds + 65536 + off) = (unsigned)al | ((unsigned)bl << 16); } }
    }
    for (int c = blockIdx.x; c < NCHUNK; c += gridDim.x) {
        __syncthreads();
        if (tid < 16) lh[tid] = 0;
        const int tb = wave >> 1, kh = wave & 1, t = lane & 15, g = lane >> 4, tl = 16 * tb + t, m = c * CHUNK + tl;
        const bf16_t* xrow = XPRE + (size_t)m * D + kh * 1024 + 8 * g;
#define LN1_UNPACK(R, X) { X[0] = __uint_as_float(R.x << 16); X[1] = __uint_as_float(R.x & 0xffff0000u); X[2] = __uint_as_float(R.y << 16); X[3] = __uint_as_float(R.y & 0xffff0000u); \
                           X[4] = __uint_as_float(R.z << 16); X[5] = __uint_as_float(R.z & 0xffff0000u); X[6] = __uint_as_float(R.w << 16); X[7] = __uint_as_float(R.w & 0xffff0000u); }
        float s = 0.f, q2 = 0.f;
#pragma unroll 1
        for (int k16 = 0; k16 < 32; k16 += 16) {
            pg8::u32x4 raw[16];
#pragma unroll
            for (int i = 0; i < 16; ++i) raw[i] = *(const pg8::u32x4*)(xrow + 32 * (k16 + i));
#pragma unroll
            for (int i = 0; i < 16; ++i) { float x[8]; LN1_UNPACK(raw[i], x); s += ((x[0] + x[1]) + (x[2] + x[3])) + ((x[4] + x[5]) + (x[6] + x[7]));
#pragma unroll
                for (int j = 0; j < 8; ++j) q2 = fmaf(x[j], x[j], q2); }
        }
        s += __shfl_xor(s, 16); s += __shfl_xor(s, 32); q2 += __shfl_xor(q2, 16); q2 += __shfl_xor(q2, 32);
        if (g == 0) { stat[kh * 64 + tl] = s; stat[128 + kh * 64 + tl] = q2; }
        __syncthreads();
        const float mu = (stat[tl] + stat[64 + tl]) * (1.f / D);
        const float rstd = rsqrtf(fmaxf((stat[128 + tl] + stat[192 + tl]) * (1.f / D) - mu * mu, 0.f) + EPS);
        pg8::f32x4 acc = {0.f, 0.f, 0.f, 0.f};
        {
            const LAS float* gp = gbl + kh * 1024 + 8 * g; const LAS float* bp = gbl + 2048 + kh * 1024 + 8 * g;
            bf16_t* orow = XB + (size_t)m * D + kh * 1024 + 8 * g;
            const LAS unsigned char* wf = lds + (kh * 32) * 1024 + lane * 16;
            pg8::u32x4 rn[4];
#pragma unroll
            for (int i = 0; i < 4; ++i) rn[i] = *(const pg8::u32x4*)(xrow + 32 * i);
#pragma unroll 1
            for (int k4 = 0; k4 < 32; k4 += 4) {
                pg8::u32x4 raw[4];
#pragma unroll
                for (int i = 0; i < 4; ++i) raw[i] = rn[i];
                if (k4 + 4 < 32) {
#pragma unroll
                    for (int i = 0; i < 4; ++i) rn[i] = *(const pg8::u32x4*)(xrow + 32 * (k4 + 4 + i));
                }
#pragma unroll
                for (int i = 0; i < 4; ++i) {
                    const int ks = k4 + i;
                    float x[8]; LN1_UNPACK(raw[i], x);
                    const pg8::f32x4 ga = *(const LAS pg8::f32x4*)(gp + 32 * ks), gb = *(const LAS pg8::f32x4*)(gp + 32 * ks + 4), ba = *(const LAS pg8::f32x4*)(bp + 32 * ks), bb = *(const LAS pg8::f32x4*)(bp + 32 * ks + 4);
                    const float gm[8] = {ga[0], ga[1], ga[2], ga[3], gb[0], gb[1], gb[2], gb[3]}, bt[8] = {ba[0], ba[1], ba[2], ba[3], bb[0], bb[1], bb[2], bb[3]};
                    float y[8];
#pragma unroll
                    for (int j = 0; j < 8; ++j) y[j] = (x[j] - mu) * rstd * gm[j] + bt[j];
                    pg8::u32x4 hi, lo;
                    hi.x = pg8::cvt_pk_bf16(y[0], y[1]); hi.y = pg8::cvt_pk_bf16(y[2], y[3]); hi.z = pg8::cvt_pk_bf16(y[4], y[5]); hi.w = pg8::cvt_pk_bf16(y[6], y[7]);
                    *(pg8::u32x4*)(orow + 32 * ks) = hi;
                    lo.x = pg8::cvt_pk_bf16(y[0] - __uint_as_float(hi.x << 16), y[1] - __uint_as_float(hi.x & 0xffff0000u));
                    lo.y = pg8::cvt_pk_bf16(y[2] - __uint_as_float(hi.y << 16), y[3] - __uint_as_float(hi.y & 0xffff0000u));
                    lo.z = pg8::cvt_pk_bf16(y[4] - __uint_as_float(hi.z << 16), y[5] - __uint_as_float(hi.z & 0xffff0000u));
                    lo.w = pg8::cvt_pk_bf16(y[6] - __uint_as_float(hi.w << 16), y[7] - __uint_as_float(hi.w & 0xffff0000u));
                    const s16x8 wh = *(const LAS s16x8*)(wf + ks * 1024), wl = *(const LAS s16x8*)(wf + 65536 + ks * 1024);
                    const s16x8 yh = __builtin_bit_cast(s16x8, hi), yl = __builtin_bit_cast(s16x8, lo);
                    acc = __builtin_amdgcn_mfma_f32_16x16x32_bf16(wh, yh, acc, 0, 0, 0);
                    acc = __builtin_amdgcn_mfma_f32_16x16x32_bf16(wh, yl, acc, 0, 0, 0);
                    acc = __builtin_amdgcn_mfma_f32_16x16x32_bf16(wl, yh, acc, 0, 0, 0);
                }
            }
        }
#undef LN1_UNPACK
        if (kh == 1) dpart[tb * 64 + lane] = acc;
        __syncthreads();
        if (kh == 0) {
            const pg8::f32x4 o = dpart[tb * 64 + lane];
            const float x0 = acc[0] + o[0], x1 = acc[1] + o[1], x2 = acc[2] + o[2], x3 = acc[3] + o[3];
            float mx = fmaxf(fmaxf(x0, x1), fmaxf(x2, x3)); mx = fmaxf(mx, __shfl_xor(mx, 16)); mx = fmaxf(mx, __shfl_xor(mx, 32));
            const float p0 = __expf(x0 - mx), p1 = __expf(x1 - mx), p2 = __expf(x2 - mx), p3 = __expf(x3 - mx);
            float sm = (p0 + p1) + (p2 + p3); sm += __shfl_xor(sm, 16); sm += __shfl_xor(sm, 32);
            const float inv = 1.f / sm;
            const float pr[4] = {p0 * inv, p1 * inv, p2 * inv, p3 * inv};
            const float4 rb4 = *(const float4*)(router_b + 4 * g);
            const float sl[4] = {pr[0] + rb4.x, pr[1] + rb4.y, pr[2] + rb4.z, pr[3] + rb4.w};
            const float h1 = fmaxf(sl[0], sl[1]), l1 = fminf(sl[0], sl[1]), h2 = fmaxf(sl[2], sl[3]), l2 = fminf(sl[2], sl[3]);
            float bgs = fmaxf(h1, h2) + fmaxf(fminf(h1, h2), fmaxf(l1, l2));
            int bg = g;
            { const float og = __shfl_xor(bgs, 16); const int oi = __shfl_xor(bg, 16); const bool tk = (og > bgs) || (og == bgs && oi < bg); bgs = tk ? og : bgs; bg = tk ? oi : bg; }
            { const float og = __shfl_xor(bgs, 32); const int oi = __shfl_xor(bg, 32); const bool tk = (og > bgs) || (og == bgs && oi < bg); bgs = tk ? og : bgs; bg = tk ? oi : bg; }
            if (bg == g) {
                int l1i = 0; float v1 = sl[0], q1 = pr[0];
#pragma unroll
                for (int i = 1; i < 4; ++i) { const bool b = sl[i] > v1; v1 = b ? sl[i] : v1; q1 = b ? pr[i] : q1; l1i = b ? i : l1i; }
                int l2i = 0; float v2 = -__builtin_inff(), q2b = 0.f;
#pragma unroll
                for (int i = 0; i < 4; ++i) { const bool b = (i != l1i) && (sl[i] > v2); v2 = b ? sl[i] : v2; q2b = b ? pr[i] : q2b; l2i = b ? i : l2i; }
                const int i1 = 4 * g + l1i, i2 = 4 * g + l2i; const float gsum = q1 + q2b;
                EXPID[m * 2] = i1; EXPID[m * 2 + 1] = i2; GATEW[m * 2] = q1 / gsum; GATEW[m * 2 + 1] = q2b / gsum;
                atomicAdd(&lh[i1], 1); atomicAdd(&lh[i2], 1);
            }
        }
        __syncthreads();
        { int t3 = tid; asm volatile("" : "+v"(t3)); if (t3 < 16) HIST[c * 16 + t3] = lh[t3]; }
    }
}

__device__ __noinline__ void ph_route_pos(unsigned char* ws) {
    const int tid = mk_tid(), lane = tid & 63, wave = tid >> 6, gw = blockIdx.x * NWAVES + wave, NGW = gridDim.x * NWAVES; float* ldsf = (float*)lds_raw;
    (void)lane; (void)wave; (void)gw; (void)NGW; (void)ldsf;
            int* hl = (int*)ldsf;
            int* tot = hl + NCHUNK * 16;
            int* seg = tot + 16;
            __syncthreads();
            for (int i = tid; i < NCHUNK * 16; i += NTHR) hl[i] = HIST[i];
            __syncthreads();
            if (tid < 16) { int run = 0; for (int c = 0; c < NCHUNK; ++c) { const int h = hl[c * 16 + tid]; hl[c * 16 + tid] = run; run += h; } tot[tid] = run; }
            __syncthreads();
            if (tid == 0) { int s = 0; for (int e = 0; e < 16; ++e) { seg[e] = s; s += (tot[e] + 255) & ~255; } seg[16] = s; }
            __syncthreads();
            for (int c = blockIdx.x; c < NCHUNK; c += gridDim.x) {
                if (wave == 0) {
                    const int m = c * CHUNK + lane;
                    const int e0 = EXPID[m * 2], e1 = EXPID[m * 2 + 1];
                    const unsigned long long lt = (1ull << lane) - 1ull;
                    int r0 = 0, r1 = 0;
                    for (int e = 0; e < 16; ++e) {
                        const unsigned long long m0 = __ballot(e0 == e), m1 = __ballot(e1 == e);
                        const int below = __popcll(m0 & lt) + __popcll(m1 & lt);
                        if (e0 == e) r0 = below;
                        if (e1 == e) r1 = below;
                    }
                    const int p0 = seg[e0] + hl[c * 16 + e0] + r0, p1 = seg[e1] + hl[c * 16 + e1] + r1;
                    POS[m * 2] = p0; POS[m * 2 + 1] = p1;
                    ROWTOK[p0] = m; ROWTOK[p1] = m; ROWGATE[p0] = GATEW[m * 2]; ROWGATE[p1] = GATEW[m * 2 + 1];
                }
            }
            if (blockIdx.x == 0) {
                for (int e = 0; e < 16; ++e) { for (int r = seg[e] + tot[e] + tid; r < seg[e + 1]; r += NTHR) { ROWTOK[r] = 0; ROWGATE[r] = 0.f; } }
                if (tid < 160) { int e = 0; const int row = tid * 256; for (int q = 0; q < 16; ++q) if (row >= seg[q]) e = q; TILEE[tid] = e; }
                __syncthreads();
                if (tid == 0) TILEE[159] = seg[16] / 256;
            }
}

__device__ __forceinline__ void ph_ln2(const float* g2, const float* b2, float* out, int last, unsigned char* ws) {
    int tid_ = mk_tid(); asm volatile("" : "+v"(tid_));
    const int tid = tid_, lane = tid & 63, wave = tid >> 6, gw = blockIdx.x * NWAVES + wave, NGW = gridDim.x * NWAVES; float* ldsf = (float*)lds_raw;
    (void)lane; (void)wave; (void)gw; (void)NGW; (void)ldsf;
            int m = gw;
            if (m >= M) return;
            uint2 xr[8], y0[8], y1[8];
            int np0 = 0, np1 = 0;
            { const int p0 = POS[m * 2], p1 = POS[m * 2 + 1];
#pragma unroll
              for (int jj = 0; jj < 8; ++jj) { { const pg8::u32x2 t_ = __builtin_nontemporal_load((const pg8::u32x2*)(XB + (size_t)m * D + 4 * lane + 256 * jj)); xr[jj] = make_uint2(t_.x, t_.y); } { const pg8::u32x2 t_ = __builtin_nontemporal_load((const pg8::u32x2*)(YS + (size_t)p0 * D + 4 * lane + 256 * jj)); y0[jj] = make_uint2(t_.x, t_.y); } { const pg8::u32x2 t_ = __builtin_nontemporal_load((const pg8::u32x2*)(YS + (size_t)p1 * D + 4 * lane + 256 * jj)); y1[jj] = make_uint2(t_.x, t_.y); } }
              if (m + NGW < M) { np0 = POS[(m + NGW) * 2]; np1 = POS[(m + NGW) * 2 + 1]; } }
#pragma unroll 1
            for (; m < M; m += NGW) {
                float4 v[8];
#pragma unroll
                for (int jj = 0; jj < 8; ++jj) {
                    v[jj].x = ALPHA * __uint_as_float(xr[jj].x << 16) + __uint_as_float(y0[jj].x << 16) + __uint_as_float(y1[jj].x << 16);
                    v[jj].y = ALPHA * __uint_as_float(xr[jj].x & 0xffff0000u) + __uint_as_float(y0[jj].x & 0xffff0000u) + __uint_as_float(y1[jj].x & 0xffff0000u);
                    v[jj].z = ALPHA * __uint_as_float(xr[jj].y << 16) + __uint_as_float(y0[jj].y << 16) + __uint_as_float(y1[jj].y << 16);
                    v[jj].w = ALPHA * __uint_as_float(xr[jj].y & 0xffff0000u) + __uint_as_float(y0[jj].y & 0xffff0000u) + __uint_as_float(y1[jj].y & 0xffff0000u);
                }
                const int mn = m + NGW;
                if (mn < M) {
                    const int p0 = np0, p1 = np1;
#pragma unroll
                    for (int jj = 0; jj < 8; ++jj) { { const pg8::u32x2 t_ = __builtin_nontemporal_load((const pg8::u32x2*)(XB + (size_t)mn * D + 4 * lane + 256 * jj)); xr[jj] = make_uint2(t_.x, t_.y); } { const pg8::u32x2 t_ = __builtin_nontemporal_load((const pg8::u32x2*)(YS + (size_t)p0 * D + 4 * lane + 256 * jj)); y0[jj] = make_uint2(t_.x, t_.y); } { const pg8::u32x2 t_ = __builtin_nontemporal_load((const pg8::u32x2*)(YS + (size_t)p1 * D + 4 * lane + 256 * jj)); y1[jj] = make_uint2(t_.x, t_.y); } }
                    if (mn + NGW < M) { np0 = POS[(mn + NGW) * 2]; np1 = POS[(mn + NGW) * 2 + 1]; }
                }
                ln_row(v, g2, b2, lane);
                if (last) {
#pragma unroll
                    for (int jj = 0; jj < 8; ++jj) __builtin_nontemporal_store((pg8::f32x4){v[jj].x, v[jj].y, v[jj].z, v[jj].w}, (pg8::f32x4*)(out + (size_t)m * D + 4 * lane + 256 * jj));
                } else store_row_bf16(XB + (size_t)m * D, v, lane);
            }
}

__global__ void __launch_bounds__(NTHR, 2) mega_fwd(Args a) {
    const int tid0 = threadIdx.x;
    unsigned* ctl = (unsigned*)(a.ws + WS_CTL);
    volatile LAS unsigned* misc = (volatile LAS unsigned*)((LAS unsigned char*)lds_raw + LDS_MISC);
    if (tid0 < 64) misc[tid0] = 0u;
    if (MK_SINGLE && blockIdx.x == 0 && tid0 >= 1 && tid0 < DEPTH) (void)__hip_atomic_fetch_add(ctl + 8192 + 64 * tid0, gridDim.x * 4u < 1024u ? gridDim.x * 4u : 1024u, __ATOMIC_RELAXED, __HIP_MEMORY_SCOPE_AGENT);
    if ((tid0 & 63) == 0) ((volatile LAS int*)((LAS unsigned char*)lds_raw + MK_TID_TABLE))[(unsigned)__builtin_amdgcn_s_getreg((5 << 11) | 4) & 63u] = tid0 >> 6;
    __syncthreads();
#if MK_SINGLE
    XcdBarrier bar = xcd_barrier_post(ctl + 4096, misc + 8);
#define GRID_BAR() xcd_barrier(bar)
#else
    (void)ctl;
#define GRID_BAR() do { } while (0)
#endif
    const int lo = a.ph_lo, hi = a.ph_hi;
    for (int pc = lo; pc < hi; ++pc) {
        bool ran = true, is_gemm = false; int do_prep = 0;
        pg8::GemmDesc d{};
        const __attribute__((address_space(4))) Args* ap = (const __attribute__((address_space(4))) Args*)__builtin_amdgcn_kernarg_segment_ptr();
        asm volatile("" : "+s"(ap));
#define a (*ap)
        unsigned char* ws = ap->ws;
        if (pc == 0) ph_pre(a.x, a.rel_bias, ws);
        else {
            const int q = pc - 1, L = q / 14, s = q % 14, j = L >> 1; const bool dsa = (L & 1) == 0;
            switch (s) {
            case 0:
                if (L == 0) do_prep = 1; else if (dsa) ph_prep_dsa_fold(a.a_w_uq + (size_t)j * QL * HW, a.a_w_uk + (size_t)j * H * HD * KVL, W_Q(L), W_UV(L)); else ran = false;
                break;
            case 1: is_gemm = true;
                if (dsa) { d.A = XB; d.Bt = W_IN(L); d.K = D; d.lda2 = D * 2; d.ldb2 = D * 2; d.btile = (size_t)256 * D * 2; d.nM = M / 256; d.nN = 4; d.epi = pg8::EPI_F32; d.out = PRAW; d.ldc = 1024; }
                else     { d.A = XB; d.Bt = W_QKV(L); d.K = D; d.lda2 = D * 2; d.ldb2 = D * 2; d.btile = (size_t)256 * D * 2; d.nM = M / 256; d.nN = 3 * HW / 256; d.epi = pg8::EPI_QKVH; d.out = QKV; d.ldc = 3 * HW; }
                break;
            case 2: if (dsa) ph_dsa_norms(a.a_q_norm + (size_t)j * QL, a.a_kv_norm + (size_t)j * KVL, ws); else ran = false; break;
            case 3: if (dsa) { is_gemm = true; d.A = CQ; d.Bt = W_Q(L); d.K = QL; d.lda2 = QL * 2; d.ldb2 = QL * 2; d.btile = (size_t)256 * QL * 2; d.nM = M / 256; d.nN = QALD / 256; d.epi = pg8::EPI_BF16; d.out = QALL; d.ldc = QALD; }
                    else ran = false; break;
            case 4: if (dsa) ph_dsa_index(ws); else ran = false; break;
            case 5: ran = false; break;
            case 6: if (dsa) ran = false; else ph_dil_attn(ws, (unsigned*)(ws + WS_CTL) + 12288 + 128 * L); break;
            case 7: if (dsa) { is_gemm = true; d.A = OLAT; d.Bt = W_UV(L); d.K = 512; d.lda2 = 4096 * 2; d.acol2 = 512 * 2; d.ldb2 = 512 * 2; d.btile = (size_t)256 * 512 * 2; d.nM = M / 256; d.nN = HW / 256;
                               d.epi = pg8::EPI_BF16; d.out = OB; d.ldc = HW; }
                    else ran = false; break;
            case 8: is_gemm = true; d.A = OB; d.Bt = dsa ? W_O(L) : W_O_D(L); d.K = HW; d.lda2 = HW * 2; d.ldb2 = HW * 2; d.btile = (size_t)256 * HW * 2; d.nM = M / 256; d.nN = D / 256;
                    d.epi = pg8::EPI_RESID; d.out = XPRE; d.aux = XB; d.ldc = D; d.alpha = ALPHA; break;
            case 9: ph_ln1_router(a.ln1_g + (size_t)L * D, a.ln1_b + (size_t)L * D, a.router_w, a.router_b, ws); break;
            case 10: ph_route_pos(ws); break;
            case 11: is_gemm = true; d.A = XB; d.Bt = W_GU(L); d.K = D; d.lda2 = D * 2; d.ldb2 = D * 2; d.btile = (size_t)256 * D * 2; d.bexp = (size_t)1024 * D * 2; d.nM = __builtin_amdgcn_readfirstlane(ld_mut(TILEE + 159)); d.nN = 4;
                     d.rowtok = ROWTOK; d.tilee = TILEE; d.epi = pg8::EPI_SWIGLU; d.out = HID; d.aux = ROWGATE; d.ldc = DE; if (L + 1 < DEPTH) do_prep = 2; break;
            case 12: is_gemm = true; d.A = HID; d.Bt = W_DN(L); d.K = DE; d.lda2 = DE * 2; d.ldb2 = DE * 2; d.btile = (size_t)256 * DE * 2; d.bexp = (size_t)D * DE * 2; d.nM = __builtin_amdgcn_readfirstlane(ld_mut(TILEE + 159)); d.nN = D / 256;
                     d.tilee = TILEE; d.epi = pg8::EPI_BF16; d.out = YS; d.ldc = D; if (L + 1 < DEPTH) do_prep = 2; break;
            default: ph_ln2(a.ln2_g + (size_t)L * D, a.ln2_b + (size_t)L * D, a.out, L == DEPTH - 1 ? 1 : 0, ws); break;
            }
        }
#undef a
        if (is_gemm) pg8::gemm_run((PG8_LAS unsigned char*)lds_raw, d);
#define a (*ap)
        if (do_prep) {
            const int Lp = (do_prep == 1) ? 0 : (pc - 1) / 14 + 1, jp = Lp >> 1; const bool pdsa = (Lp & 1) == 0;
            unsigned* cnt = (do_prep == 1) ? nullptr : (unsigned*)(ap->ws + WS_CTL) + 8192 + 64 * Lp;
            int pend = -1, seg = 0;
            bool handed_out = false;
            const bool gu_phase = do_prep == 2 && ((pc - 1) % 14) == 11;
            if (do_prep == 2 && !gu_phase) handed_out = (unsigned)__builtin_amdgcn_readfirstlane((int)__hip_atomic_load(cnt, __ATOMIC_RELAXED, __HIP_MEMORY_SCOPE_AGENT)) >= (pdsa ? 3520u : 4096u);
            const int cw = __builtin_amdgcn_readfirstlane(mk_tid() >> 6);
            if (do_prep == 2 && cw >= 4) handed_out = true;
            if (gu_phase && MK_SINGLE && cw < 4 && (int)blockIdx.x * 4 + cw < 1024) pend = (int)blockIdx.x * 4 + cw;
            if (!handed_out) {
            const float* wg = a.moe_w_gate + (size_t)Lp * NE * D * DE; const float* wu = a.moe_w_up + (size_t)Lp * NE * D * DE; const float* wd = a.moe_w_down + (size_t)Lp * NE * DE * D;
            pend = cvt_matrix(wg, (size_t)D * DE, NE, D, DE, DE, DE, W_GU(Lp), 1.f, 1024, 7, 256, 127, 0, D, 0, cnt, seg, pend); seg += 1024;
            pend = cvt_matrix(wu, (size_t)D * DE, NE, D, DE, DE, DE, W_GU(Lp), 1.f, 1024, 7, 256, 127, 128, D, 0, cnt, seg, pend); seg += 1024;
            pend = cvt_matrix(wd, (size_t)DE * D, NE, DE, D, D, D, W_DN(Lp), 1.f, D, 31, 0, 0x7fffffff, 0, DE, 0, cnt, seg, pend); seg += 1024;
            if (pdsa) {
                const float* w_in = a.a_w_in + (size_t)jp * D * AIN; const float* w_uqi = a.a_w_uq_idx + (size_t)jp * QL * IH * IDM; const float* w_uv = a.a_w_uv + (size_t)jp * H * KVL * HD; const float* w_o = a.a_w_o + (size_t)jp * HW * D;
                pend = cvt_matrix(w_in, 0, 1, D, 1024, AIN, AIN, W_IN(Lp), 1.f, 0, 31, 0, 0x7fffffff, 0, D, 0, cnt, seg, pend); seg += 128;
                pend = cvt_matrix(w_uqi, 0, 1, QL, IH * IDM, IH * IDM, IH * IDM, W_Q(Lp), 0.125f, 0, 31, 0, 0x7fffffff, 4096, QL, 0, cnt, seg, pend); seg += 32;
                pend = cvt_matrix(w_o, 0, 1, HW, D, D, D, W_O(Lp), 1.f, 0, 31, 0, 0x7fffffff, 0, HW, 0, cnt, seg, pend); seg += 256;
                pend = cvt_matrix(w_uv, (size_t)KVL * HD, H, KVL, HD, HD, HD, W_UV(Lp), 1.f, HD, 31, 0, 0x7fffffff, 0, 512, 256, cnt, seg, pend); seg += 32;
                if (do_prep == 1) ph_prep_dsa_fold(a.a_w_uq + (size_t)jp * QL * HW, a.a_w_uk + (size_t)jp * H * HD * KVL, W_Q(Lp), W_UV(Lp));
            } else {
                const float* w_in = a.b_w_in + (size_t)jp * D * 3 * HW; const float* w_o = a.b_w_o + (size_t)jp * HW * D;
                pend = cvt_matrix(w_in, 0, 1, D, HW, HW, 3 * HW, W_QKV(Lp), 0.12751743082459868f  , 0, 31, 0, 0x7fffffff, 0, D, 0, cnt, seg, pend); seg += 256;
                pend = cvt_matrix(w_in + HW, 0, 1, D, 2 * HW, 2 * HW, 3 * HW, W_QKV(Lp), 1.f, 0, 31, 0, 0x7fffffff, HW, D, 0, cnt, seg, pend); seg += 512;
                pend = cvt_matrix(w_o, 0, 1, HW, D, D, D, W_O_D(Lp), 1.f, 0, 31, 0, 0x7fffffff, 0, HW, 0, cnt, seg, pend); seg += 256;
            }
            }
        }
#undef a
        bool skipbar = false;
        if (MK_SINGLE) { if (pc == 0) skipbar = true; else { const int q2 = pc - 1, L2_ = q2 / 14, s2 = q2 % 14; if (s2 == 13 && (L2_ & 1) == 1 && L2_ + 1 < DEPTH) skipbar = true; } }
        if (ran && !skipbar && pc + 1 < hi) GRID_BAR();
    }
}
constexpr int N_PHASES = 1 + DEPTH * 14;
}

extern "C" void kernel_launch(void* const* d_in, const int* in_sizes, int n_in, void* d_out, int out_size, void* d_ws, size_t ws_size, hipStream_t stream) {
    static int grid = 0;
    if (grid == 0) {
        if (n_in != 21 || in_sizes[0] != M * D || out_size != M * D || ws_size < WS_END) {
            fprintf(stderr, "kernel_launch: unexpected shapes: n_in %d in0 %d out %d ws %zu (need %zu)\n", n_in, n_in > 0 ? in_sizes[0] : -1, out_size, ws_size, (size_t)WS_END);
            grid = -1; return; }
        int dev = 0, cus = 0, per_cu = 0;
        if (hipGetDevice(&dev) != hipSuccess || hipDeviceGetAttribute(&cus, hipDeviceAttributeMultiprocessorCount, dev) != hipSuccess) { grid = -1; return; }
        if (hipFuncSetAttribute((const void*)mega_fwd, hipFuncAttributeMaxDynamicSharedMemorySize, LDS_BYTES) != hipSuccess) { fprintf(stderr, "kernel_launch: hipFuncSetAttribute failed\n"); grid = -1; return; }
        if (hipOccupancyMaxActiveBlocksPerMultiprocessor(&per_cu, (const void*)mega_fwd, NTHR, LDS_BYTES) != hipSuccess || per_cu < 1)
            fprintf(stderr, "kernel_launch: occupancy query reports %d workgroups per CU\n", per_cu);
        (void)hipGetLastError();
        grid = cus;
    }
    if (grid < 0) return;
    if (hipMemsetAsync((char*)d_ws + WS_CTL, 0, CTL_BYTES, stream) != hipSuccess) return;
    Args a{};
    a.x = (const float*)d_in[0]; a.rel_bias = (const float*)d_in[1]; a.router_w = (const float*)d_in[2]; a.router_b = (const float*)d_in[3];
    a.a_w_in = (const float*)d_in[4]; a.a_q_norm = (const float*)d_in[5]; a.a_kv_norm = (const float*)d_in[6]; a.a_w_uq = (const float*)d_in[7]; a.a_w_uq_idx = (const float*)d_in[8];
    a.a_w_uk = (const float*)d_in[9]; a.a_w_uv = (const float*)d_in[10]; a.a_w_o = (const float*)d_in[11]; a.b_w_in = (const float*)d_in[12]; a.b_w_o = (const float*)d_in[13];
    a.ln1_g = (const float*)d_in[14]; a.ln1_b = (const float*)d_in[15]; a.ln2_g = (const float*)d_in[16]; a.ln2_b = (const float*)d_in[17];
    a.moe_w_gate = (const float*)d_in[18]; a.moe_w_up = (const float*)d_in[19]; a.moe_w_down = (const float*)d_in[20];
    a.out = (float*)d_out; a.ws = (unsigned char*)d_ws;
#if MK_SINGLE
    a.ph_lo = 0; a.ph_hi = N_PHASES;
    hipLaunchKernelGGL(mega_fwd, dim3(grid), dim3(NTHR), LDS_BYTES, stream, a);
#else
    for (int p = 0; p < N_PHASES; ++p) { a.ph_lo = p; a.ph_hi = p + 1; hipLaunchKernelGGL(mega_fwd, dim3(grid), dim3(NTHR), LDS_BYTES, stream, a); }
#endif
}
```
